# Optimizing an MI355X kernel written in HIP

```python
import jax, jax.numpy as jnp
from jax import lax
import numpy as np

D_MODEL = 1024
BATCH = 4
SEQ = 8192
DEPTH = 4

HEAD_DIM = 64
N_HEADS_A = 8
N_HEADS_B = 8
N_KV_B = 2
GQA_GROUP = N_HEADS_B // N_KV_B
DILATED_BRANCHES = ((128, 1), (512, 4), (2048, 16))
SWA_WINDOW = 128
BLK = 128
ROPE_THETA = 10000.0
D_FF = 3584
N_EXPERTS = 8
TOP_K = 2
RMS_EPS = 1e-5
WIDTH_A = N_HEADS_A * HEAD_DIM
WIDTH_B = N_HEADS_B * HEAD_DIM
KV_WIDTH_B = N_KV_B * HEAD_DIM
MIX_WIDTH = WIDTH_A + WIDTH_B
IN_SIZES = (WIDTH_A, WIDTH_A, WIDTH_A, WIDTH_B, KV_WIDTH_B, KV_WIDTH_B)
IN_WIDTH = sum(IN_SIZES)
IN_SPLITS = tuple(int(c) for c in np.cumsum(IN_SIZES)[:-1])
N_DENSE = (DEPTH + 1) // 2
N_MOE = DEPTH // 2

kernel_name = "hybrid_dilated_swa_sink_moe_trunk"


def rmsnorm(x, g):
    xf = x.astype(jnp.float32)
    y = xf * lax.rsqrt(jnp.mean(xf * xf, axis=-1, keepdims=True) + RMS_EPS)
    return (y * g.astype(jnp.float32)).astype(x.dtype)


def rope_tables(positions):
    inv = ROPE_THETA ** (-jnp.arange(0, HEAD_DIM, 2, dtype=jnp.float32) / HEAD_DIM)
    ang = positions.astype(jnp.float32)[:, None] * inv[None, :]
    ang = jnp.concatenate([ang, ang], axis=-1)
    return jnp.cos(ang), jnp.sin(ang)


def apply_rope(t, cos, sin):
    t1, t2 = jnp.split(t, 2, axis=-1)
    rot = jnp.concatenate([-t2, t1], axis=-1)
    return t * cos.astype(t.dtype) + rot * sin.astype(t.dtype)


def banded_attention(q, k, v, max_dist, sink=None):
    *lead, G, L, Dh = q.shape
    nb = L // BLK
    qb = q.reshape(*lead, G, nb, BLK, Dh)

    def band(t):
        tb = t.reshape(*lead, nb, BLK, Dh)
        prev = jnp.concatenate([jnp.zeros_like(tb[..., :1, :, :]), tb[..., :-1, :, :]], axis=-3)
        return jnp.concatenate([prev, tb], axis=-2)

    s = jnp.einsum('...gnqd,...nkd->...gnqk', qb, band(k),
                   preferred_element_type=jnp.float32) * (Dh ** -0.5)
    dist = (BLK + jnp.arange(BLK))[:, None] - jnp.arange(2 * BLK)[None, :]
    in_band = (dist >= 0) & (dist <= max_dist)
    has_prev = (jnp.arange(nb) > 0)[:, None, None] | (jnp.arange(2 * BLK) >= BLK)[None, None, :]
    mask = in_band[None] & has_prev
    s = jnp.where(mask, s, -jnp.inf)
    m = jnp.max(s, axis=-1)
    if sink is not None:
        sk = sink.astype(jnp.float32)[..., None, None]
        m = jnp.maximum(m, sk)
    p = jnp.exp(s - m[..., None])
    l = jnp.sum(p, axis=-1)
    if sink is not None:
        l = l + jnp.exp(sk - m)
    o = jnp.einsum('...gnqk,...nkd->...gnqd', p.astype(v.dtype), band(v),
                   preferred_element_type=jnp.float32) / l[..., None]
    lse = m + jnp.log(l)
    return o.reshape(*lead, G, L, Dh).astype(q.dtype), lse.reshape(*lead, G, L)


def dilated_branch(q, k, v, window, dilation):
    B, H, S, Dh = q.shape
    seg = dilation * BLK
    Sp = -(-S // seg) * seg

    def by_stride(t):
        t = jnp.pad(t, ((0, 0), (0, 0), (0, Sp - S), (0, 0)))
        return t.reshape(B, H, Sp // dilation, dilation, Dh).transpose(0, 1, 3, 2, 4)

    o, lse = banded_attention(by_stride(q)[..., None, :, :], by_stride(k), by_stride(v),
                              max_dist=window // dilation)
    o = o[:, :, :, 0].transpose(0, 1, 3, 2, 4).reshape(B, H, Sp, Dh)[:, :, :S]
    lse = lse[:, :, :, 0].transpose(0, 1, 3, 2).reshape(B, H, Sp)[:, :, :S]
    return o, lse


def dilated_mixer(q, k, v):
    outs, lses = zip(*[dilated_branch(q, k, v, w, d) for (w, d) in DILATED_BRANCHES])
    wts = jax.nn.softmax(jnp.stack(lses, axis=0), axis=0)
    o = jnp.einsum('rbhs,rbhsd->bhsd', wts, jnp.stack(outs, axis=0).astype(jnp.float32))
    return o.astype(q.dtype)


def swiglu(h, wg, wu, wd):
    return (jax.nn.silu(h @ wg) * (h @ wu)) @ wd


def moe_swiglu(h, router, wg, wu, wd):
    logits = (h @ router).astype(jnp.float32)
    top_vals, top_idx = lax.top_k(logits, TOP_K)
    gates = jax.nn.softmax(top_vals, axis=-1)
    gate_e = jnp.sum(jax.nn.one_hot(top_idx, N_EXPERTS, dtype=jnp.float32) * gates[..., None], axis=-2)
    gate_e = gate_e.astype(h.dtype)
    out = jnp.zeros_like(h)
    for e in range(N_EXPERTS):
        out = out + gate_e[..., e:e + 1] * swiglu(h, wg[e], wu[e], wd[e])
    return out


def heads(t, n):
    B, S, _ = t.shape
    return t.reshape(B, S, n, HEAD_DIM).transpose(0, 2, 1, 3)


def merge_heads(t):
    B, H, S, Dh = t.shape
    return t.transpose(0, 2, 1, 3).reshape(B, S, H * Dh)


def setup_inputs(seed: int = 0) -> dict:
    key = jax.random.key(seed)
    ks = jax.random.split(key, 20)
    f32 = jnp.float32
    nrm = lambda k, shape, fan_in: jax.random.normal(k, shape, f32) * (fan_in ** -0.5)
    gain = lambda k, shape: 1.0 + 0.02 * jax.random.normal(k, shape, f32)
    return {
        "x": jax.random.normal(ks[0], (BATCH, SEQ, D_MODEL), f32),
        "positions": jnp.arange(SEQ, dtype=jnp.int32),
        "attn_norm": gain(ks[1], (DEPTH, D_MODEL)),
        "w_in": nrm(ks[2], (DEPTH, D_MODEL, IN_WIDTH), D_MODEL),
        "mix_norm_a": gain(ks[3], (DEPTH, WIDTH_A)),
        "mix_norm_b": gain(ks[4], (DEPTH, WIDTH_B)),
        "sinks": 0.5 * jax.random.normal(ks[5], (DEPTH, N_HEADS_B), f32),
        "w_out": nrm(ks[6], (DEPTH, MIX_WIDTH, D_MODEL), MIX_WIDTH) * 0.5,
        "ffn_norm": gain(ks[7], (DEPTH, D_MODEL)),
        "dense_w_gate": nrm(ks[8], (N_DENSE, D_MODEL, D_FF), D_MODEL),
        "dense_w_up": nrm(ks[9], (N_DENSE, D_MODEL, D_FF), D_MODEL),
        "dense_w_down": nrm(ks[10], (N_DENSE, D_FF, D_MODEL), D_FF) * 0.5,
        "router": nrm(ks[11], (N_MOE, D_MODEL, N_EXPERTS), D_MODEL),
        "moe_w_gate": nrm(ks[12], (N_MOE, N_EXPERTS, D_MODEL, D_FF), D_MODEL),
        "moe_w_up": nrm(ks[13], (N_MOE, N_EXPERTS, D_MODEL, D_FF), D_MODEL),
        "moe_w_down": nrm(ks[14], (N_MOE, N_EXPERTS, D_FF, D_MODEL), D_FF) * 0.5,
        "final_norm": gain(ks[15], (D_MODEL,)),
    }


def reference(x, positions, attn_norm, w_in, mix_norm_a, mix_norm_b, sinks, w_out,
              ffn_norm, dense_w_gate, dense_w_up, dense_w_down, router,
              moe_w_gate, moe_w_up, moe_w_down, final_norm):
    B, S, _ = x.shape
    cos, sin = rope_tables(positions)
    for i in range(DEPTH):
        h = rmsnorm(x, attn_norm[i])
        proj = h @ w_in[i]
        qa, ka, va, qb, kb, vb = jnp.split(proj, IN_SPLITS, axis=-1)
        qa = apply_rope(heads(qa, N_HEADS_A), cos, sin)
        ka = apply_rope(heads(ka, N_HEADS_A), cos, sin)
        oa = dilated_mixer(qa, ka, heads(va, N_HEADS_A))
        qb = apply_rope(heads(qb, N_HEADS_B), cos, sin).reshape(B, N_KV_B, GQA_GROUP, S, HEAD_DIM)
        kb = apply_rope(heads(kb, N_KV_B), cos, sin)
        ob, _ = banded_attention(qb, kb, heads(vb, N_KV_B), SWA_WINDOW - 1,
                                 sink=sinks[i].reshape(N_KV_B, GQA_GROUP))
        ob = ob.reshape(B, N_HEADS_B, S, HEAD_DIM)
        mix = jnp.concatenate([rmsnorm(merge_heads(oa), mix_norm_a[i]),
                               rmsnorm(merge_heads(ob), mix_norm_b[i])], axis=-1)
        x = x + mix @ w_out[i]
        h = rmsnorm(x, ffn_norm[i])
        j = i // 2
        if i % 2 == 0:
            x = x + swiglu(h, dense_w_gate[j], dense_w_up[j], dense_w_down[j])
        else:
            x = x + moe_swiglu(h, router[j], moe_w_gate[j], moe_w_up[j], moe_w_down[j])
    return rmsnorm(x, final_norm)
```

```cpp
#include <hip/hip_runtime.h>
#include <cstdio>
#include <cstdint>

namespace cfg {
constexpr int D = 1024, NB = 4, S = 8192, M = NB * S, DEPTH = 4, HD = 64, INW = 2304, FF = 3584, NE = 8;
constexpr int QA_OFF = 0, KA_OFF = 512, VA_OFF = 1024, QB_OFF = 1536, KB_OFF = 2048, VB_OFF = 2176;
constexpr float EPS = 1e-5f;
constexpr float LOG2E = 1.4426950408889634f;
constexpr float C2 = 0.125f * LOG2E;
constexpr int MAXROWS = 2 * M + NE * 256;
}

namespace pg8 {
#define PG8_LAS __attribute__((address_space(3)))
typedef unsigned short bf16_t;
typedef short bf16x8 __attribute__((ext_vector_type(8)));
typedef float f32x4 __attribute__((ext_vector_type(4)));
typedef unsigned u32x4 __attribute__((ext_vector_type(4)));
constexpr int BM = 256, BK = 64, HALF = 128, HTB = HALF * BK * 2  , STAGE_BYTES = 8 * HTB, NXCD = 8, WGM = 8;

__host__ __device__ __forceinline__ int lds_byte(int r, int c) { const int st = (r >> 4) * 2 + (c >> 5), rr = r & 15, cc = c & 31, ob = rr * 64 + cc * 2; return st * 1024 + (ob ^ (((ob >> 9) & 1) << 5)); }
__host__ __device__ __forceinline__ void stage_rc(int b, int& R, int& C) { const int st = b / 1024, sb = b % 1024, swz = sb ^ (((sb >> 9) & 1) << 5); R = (st >> 1) * 16 + swz / 64; C = (st & 1) * 32 + (swz % 64) / 2; }
__host__ __device__ __forceinline__ int perm32(int rho) { const int n = rho >> 4, i = rho & 15; return 8 * (i >> 2) + 4 * n + (i & 3); }

struct Unit { int pm, pn, eb; };
struct Gemm { const bf16_t* A; const bf16_t* Bt; int M, N, K; size_t bstride; };

struct StaticOrder {
    int nM, nN, nwg, G, c;
    __host__ __device__ void init(int M, int N, int G_, int c_) { nM = M / BM; nN = N / BM; nwg = nM * nN; G = G_; c = c_; }
    __host__ __device__ bool next(int i, Unit& u) const {
        const long L = (long)i * G + c; if (L >= nwg) return false;
        int wgid = (int)L; { const int q = nwg / NXCD, r = nwg % NXCD, xcd = wgid % NXCD, off = wgid / NXCD; wgid = (xcd < r ? xcd * (q + 1) : r * (q + 1) + (xcd - r) * q) + off; }
        const int nig = WGM * nN, gid = wgid / nig, fm = gid * WGM, gsz = (nM - fm) < WGM ? (nM - fm) : WGM;
        u.pm = fm + ((wgid % nig) % gsz); u.pn = (wgid % nig) / gsz; u.eb = 0; return true;
    }
    __device__ __forceinline__ void a_ready(const Unit&) const {}
    __device__ __forceinline__ void done(const Unit&) const {}
};


__device__ __forceinline__ unsigned cvt_pk_bf16(float lo, float hi) { unsigned r; asm volatile("v_cvt_pk_bf16_f32 %0, %1, %2" : "=v"(r) : "v"(lo), "v"(hi)); return r; }
typedef unsigned u32x2 __attribute__((ext_vector_type(2)));
__device__ __forceinline__ void row_rs8(const float* ssq, int row0, int fq, float (&rs)[2][4]) {
#pragma unroll
    for (int ai = 0; ai < 2; ++ai)
#pragma unroll
        for (int m = 0; m < 4; ++m) { const f32x4 p = *(const f32x4*)(ssq + (size_t)(row0 + ai * HALF + m * 16) * 16 + 4 * fq);
            float s = (p[0] + p[1]) + (p[2] + p[3]); s += __shfl_xor(s, 16); s += __shfl_xor(s, 32);
            rs[ai][m] = __builtin_amdgcn_rsqf(s * (1.0f / cfg::D) + cfg::EPS); }
}
struct EpiRope {
    static constexpr bool PERM = true, AFTER_DRAIN = false;
    bf16_t* O; const float* ssq; const float* rope;
    __device__ __forceinline__ void operator()(const f32x4 (&acc)[2][2][4][2], const Unit& u, int wr, int wc, int fr, int fq) const {
        const int row0 = u.pm * BM + wr * 64 + fr;
        float rs[2][4]; row_rs8(ssq, row0, fq, rs);
        const int q8 = (wc & 1) * 4 + fq;
#pragma unroll
        for (int bj = 0; bj < 2; ++bj) {
            const int hb = u.pn * 4 + bj * 2 + (wc >> 1);
            const bool roped = (hb < 16) || (hb >= 24 && hb < 34);
            const bool isq = (hb < 8) || (hb >= 24 && hb < 32);
            const float sc = isq ? cfg::C2 : 1.0f;
#pragma unroll
            for (int ai = 0; ai < 2; ++ai)
#pragma unroll
                for (int m = 0; m < 4; ++m) {
                    const int r = row0 + ai * HALF + m * 16; const float f = rs[ai][m] * sc;
                    f32x4 v0 = acc[ai][bj][m][0] * f, v1 = acc[ai][bj][m][1] * f;
                    if (roped) {
                        const float* cs = rope + ((size_t)(r & (cfg::S - 1)) * 32 + 4 * q8) * 2;
                        const f32x4 c01 = *(const f32x4*)cs, c23 = *(const f32x4*)(cs + 4);
                        const f32x4 co = {c01[0], c01[2], c23[0], c23[2]}, si = {c01[1], c01[3], c23[1], c23[3]};
                        const f32x4 o0 = v0 * co - v1 * si, o1 = v1 * co + v0 * si; v0 = o0; v1 = o1;
                    }
                    bf16_t* p = O + (size_t)r * cfg::INW + hb * 64 + 4 * q8;
                    u32x2 w0, w1; w0.x = cvt_pk_bf16(v0[0], v0[1]); w0.y = cvt_pk_bf16(v0[2], v0[3]); w1.x = cvt_pk_bf16(v1[0], v1[1]); w1.y = cvt_pk_bf16(v1[2], v1[3]);
                    *(u32x2*)p = w0; *(u32x2*)(p + 32) = w1;
                }
        }
    }
};
struct EpiResid {
    static constexpr bool PERM = false, AFTER_DRAIN = false;
    const float* base; float* out; bf16_t* xn; float* ssq;
    __device__ __forceinline__ void operator()(const f32x4 (&acc)[2][2][4][2], const Unit& u, int wr, int wc, int fr, int fq) const {
        const int row0 = u.pm * BM + wr * 64 + fr, col0 = u.pn * BM + wc * 32 + 4 * fq;
#pragma unroll
        for (int ai = 0; ai < 2; ++ai)
#pragma unroll
            for (int m = 0; m < 4; ++m) { const int r = row0 + ai * HALF + m * 16; const size_t off = (size_t)r * cfg::D + col0; float s = 0.f;
#pragma unroll
                for (int bj = 0; bj < 2; ++bj)
#pragma unroll
                    for (int n = 0; n < 2; ++n) { const size_t o2 = off + bj * HALF + n * 16; const f32x4 b = *(const f32x4*)(base + o2); const f32x4 o = b + acc[ai][bj][m][n];
                        *(f32x4*)(out + o2) = o; s += (o[0] * o[0] + o[1] * o[1]) + (o[2] * o[2] + o[3] * o[3]);
                        u32x2 w; w.x = cvt_pk_bf16(o[0], o[1]); w.y = cvt_pk_bf16(o[2], o[3]); *(u32x2*)(xn + o2) = w; }
                s += __shfl_xor(s, 16); s += __shfl_xor(s, 32);
                if (fq == 0) ssq[(size_t)r * 16 + u.pn * 4 + wc] = s; }
    }
};
__device__ __forceinline__ float silu_mul(float g, float u) { return g * u * __builtin_amdgcn_rcpf(1.0f + __builtin_amdgcn_exp2f(-cfg::LOG2E * g)); }
template <bool RS> struct EpiSwiglu {
    static constexpr bool PERM = true, AFTER_DRAIN = false;
    bf16_t* H; const float* ssq;
    __device__ __forceinline__ void operator()(const f32x4 (&acc)[2][2][4][2], const Unit& u, int wr, int wc, int fr, int fq) const {
        const int row0 = u.pm * BM + wr * 64 + fr, col0 = u.pn * HALF + wc * 32 + 8 * fq;
        float rs[2][4];
        if (RS) row_rs8(ssq, row0, fq, rs);
#pragma unroll
        for (int ai = 0; ai < 2; ++ai)
#pragma unroll
            for (int m = 0; m < 4; ++m) { const int r = row0 + ai * HALF + m * 16; const float f = RS ? rs[ai][m] : 1.0f;
                const f32x4 g0 = acc[ai][0][m][0] * f, g1 = acc[ai][0][m][1] * f, u0 = acc[ai][1][m][0] * f, u1 = acc[ai][1][m][1] * f;
                u32x4 w; w.x = cvt_pk_bf16(silu_mul(g0[0], u0[0]), silu_mul(g0[1], u0[1])); w.y = cvt_pk_bf16(silu_mul(g0[2], u0[2]), silu_mul(g0[3], u0[3]));
                w.z = cvt_pk_bf16(silu_mul(g1[0], u1[0]), silu_mul(g1[1], u1[1])); w.w = cvt_pk_bf16(silu_mul(g1[2], u1[2]), silu_mul(g1[3], u1[3]));
                *(u32x4*)(H + (size_t)r * cfg::FF + col0) = w; }
    }
};
struct EpiY {
    static constexpr bool PERM = true, AFTER_DRAIN = false;
    bf16_t* Y; const float* gate;
    __device__ __forceinline__ void operator()(const f32x4 (&acc)[2][2][4][2], const Unit& u, int wr, int wc, int fr, int fq) const {
        const int row0 = u.pm * BM + wr * 64 + fr, col0 = u.pn * BM + wc * 32 + 8 * fq;
#pragma unroll
        for (int ai = 0; ai < 2; ++ai)
#pragma unroll
            for (int m = 0; m < 4; ++m) { const int r = row0 + ai * HALF + m * 16; const float f = gate[r];
#pragma unroll
                for (int bj = 0; bj < 2; ++bj) { const f32x4 v0 = acc[ai][bj][m][0] * f, v1 = acc[ai][bj][m][1] * f;
                    u32x4 w; w.x = cvt_pk_bf16(v0[0], v0[1]); w.y = cvt_pk_bf16(v0[2], v0[3]); w.z = cvt_pk_bf16(v1[0], v1[1]); w.w = cvt_pk_bf16(v1[2], v1[3]);
                    *(u32x4*)(Y + (size_t)r * cfg::D + col0 + bj * HALF) = w; } }
    }
};
struct GroupedOrder : StaticOrder {
    const PG8_LAS int* segb;
    __device__ __forceinline__ bool next(int i, Unit& u) const {
        if (!StaticOrder::next(i, u)) return false;
        const int r = u.pm * BM; int e = 0;
#pragma unroll
        for (int k = 1; k < 8; ++k) e += (r >= segb[k]) ? 1 : 0;
        u.eb = e; return true;
    }
};

template <class Epi, class Sched, bool ALIGN_EPI = false, bool SP2 = false>
__device__ __forceinline__ void gemm_phase(PG8_LAS unsigned char* lds, const Gemm g, const Sched& S, const Epi& E) {
    int tid_l = threadIdx.x; asm volatile("" : "+v"(tid_l)); const int tid = tid_l, wid = __builtin_amdgcn_readfirstlane(tid >> 6), lane = tid & 63, wr = wid >> 2, wc = wid & 3, fr = lane & 15, fq = lane >> 4;
    const int K = g.K, nt = K / BK;
    unsigned voffA[2], voffB[2];
#pragma unroll
    for (int i = 0; i < 2; ++i) { int R, C; stage_rc(tid * 16 + i * 8192, R, C); const int Rb = Epi::PERM ? ((R & ~31) + perm32(R & 31)) : R;
        voffA[i] = (unsigned)(R * K + C) * 2u; voffB[i] = (unsigned)(Rb * K + C) * 2u; }
    const size_t kstep = (size_t)(BK * 2);
    const size_t hstep = (size_t)HALF * K * 2;
    const size_t tstep = 2 * hstep;
    const unsigned ldsw = (unsigned)wid * 1024u;
    const int aoff = lds_byte(wr * 64 + fr, fq * 8), boff = lds_byte(wc * 32 + fr, fq * 8);
#define PG8_SA(b, h) (((b) * 2 + (h)) * HTB)
#define PG8_SB(b, h) ((4 + (b) * 2 + (h)) * HTB)
#define PG8_STAGE(bufoff, gbase, voff) do { _Pragma("unroll") for (int _i = 0; _i < 2; ++_i) \
        __builtin_amdgcn_global_load_lds((const unsigned*)((const char*)(gbase) + (voff)[_i]), (PG8_LAS unsigned*)(lds + (bufoff) + ldsw + _i * 8192), 16, 0, 0); } while (0)
#define PG8_LDA(dst, b, h) do { _Pragma("unroll") for (int m = 0; m < 4; ++m) _Pragma("unroll") for (int k = 0; k < 2; ++k) dst[m][k] = *(const PG8_LAS bf16x8*)(lds + PG8_SA(b, h) + aoff + m * 2048 + k * 1024); } while (0)
#define PG8_LDB(dst, b, h) do { _Pragma("unroll") for (int n = 0; n < 2; ++n) _Pragma("unroll") for (int k = 0; k < 2; ++k) dst[n][k] = *(const PG8_LAS bf16x8*)(lds + PG8_SB(b, h) + boff + n * 2048 + k * 1024); } while (0)
#define PG8_MMA(ai, bj, At, Bt) do { __builtin_amdgcn_s_setprio(1); _Pragma("unroll") for (int m = 0; m < 4; ++m) _Pragma("unroll") for (int n = 0; n < 2; ++n) _Pragma("unroll") for (int k = 0; k < 2; ++k) \
        acc[ai][bj][m][n] = __builtin_amdgcn_mfma_f32_16x16x32_bf16(Bt[n][k], At[m][k], acc[ai][bj][m][n], 0, 0, 0); __builtin_amdgcn_s_setprio(0); } while (0)
#define PG8_WAIT_V(n) asm volatile("s_waitcnt vmcnt(" #n ")" ::: "memory")
#define PG8_WAIT_L(n) asm volatile("s_waitcnt lgkmcnt(" #n ")" ::: "memory")
#define PG8_BAR __builtin_amdgcn_s_barrier()
#define PG8_SCHED __builtin_amdgcn_sched_barrier(0)
    Unit cur, nxt; int ui = 0;
    if (!S.next(0, cur)) return;
    f32x4 acc[2][2][4][2];
#pragma unroll
    for (int a = 0; a < 2; ++a)
#pragma unroll
        for (int b = 0; b < 2; ++b)
#pragma unroll
            for (int m = 0; m < 4; ++m)
#pragma unroll
                for (int n = 0; n < 2; ++n) acc[a][b][m][n] = (f32x4){0.f, 0.f, 0.f, 0.f};
    bf16x8 At[4][2], B0[2][2], B1[2][2];
    const char* cA = (const char*)g.A + (size_t)cur.pm * tstep; const char* cB = (const char*)g.Bt + (size_t)cur.eb * g.bstride + (size_t)cur.pn * tstep;
    S.a_ready(cur);
    if constexpr (SP2) {
        PG8_STAGE(PG8_SB(0, 0), cB, voffB); PG8_STAGE(PG8_SB(0, 1), cB + hstep, voffB); PG8_STAGE(PG8_SA(0, 0), cA, voffA); PG8_STAGE(PG8_SA(0, 1), cA + hstep, voffA);
        if (wr == 1) PG8_BAR;
        PG8_WAIT_V(2); PG8_BAR;
        PG8_STAGE(PG8_SB(1, 0), cB + kstep, voffB); PG8_STAGE(PG8_SA(1, 0), cA + kstep, voffA); PG8_STAGE(PG8_SB(1, 1), cB + hstep + kstep, voffB);
        PG8_WAIT_V(6); PG8_BAR;
    } else {
        PG8_STAGE(PG8_SB(0, 0), cB, voffB); PG8_STAGE(PG8_SA(0, 0), cA, voffA); PG8_STAGE(PG8_SB(0, 1), cB + hstep, voffB); PG8_STAGE(PG8_SA(0, 1), cA + hstep, voffA);
        if (wr == 1) PG8_BAR;
        PG8_WAIT_V(4); PG8_BAR;
        PG8_STAGE(PG8_SB(1, 0), cB + kstep, voffB); PG8_STAGE(PG8_SA(1, 0), cA + kstep, voffA); PG8_STAGE(PG8_SB(1, 1), cB + hstep + kstep, voffB);
        PG8_WAIT_V(6); PG8_BAR;
    }
    for (;;) {
        const bool has_next = S.next(ui + 1, nxt);
        const char* nA = has_next ? (const char*)g.A + (size_t)nxt.pm * tstep : cA; const char* nB = has_next ? (const char*)g.Bt + (size_t)nxt.eb * g.bstride + (size_t)nxt.pn * tstep : cB;
        for (int t = 0; t < nt; t += 2) {
            const bool last = (t == nt - 2);
            const char* a1 = cA + (size_t)(t + 1) * kstep;
            const char* a2 = last ? nA : cA + (size_t)(t + 2) * kstep; const char* b2 = last ? nB : cB + (size_t)(t + 2) * kstep;
            const char* a3 = a2 + kstep; const char* b3 = b2 + kstep;
            if (last && has_next) S.a_ready(nxt);
            if constexpr (SP2) {
            PG8_LDB(B0, 0, 0); PG8_LDB(B1, 0, 1); PG8_SCHED; PG8_LDA(At, 0, 0); PG8_STAGE(PG8_SA(1, 1), a1 + hstep, voffA);
            PG8_WAIT_V(8); PG8_WAIT_L(0); PG8_BAR; PG8_MMA(0, 0, At, B0); PG8_MMA(0, 1, At, B1); PG8_BAR; PG8_SCHED;
            PG8_LDA(At, 0, 1); PG8_STAGE(PG8_SB(0, 0), b2, voffB); PG8_STAGE(PG8_SB(0, 1), b2 + hstep, voffB); PG8_STAGE(PG8_SA(0, 0), a2, voffA);
            PG8_WAIT_V(8); PG8_WAIT_L(0); PG8_BAR; PG8_MMA(1, 0, At, B0); PG8_MMA(1, 1, At, B1); PG8_BAR; PG8_SCHED;
            PG8_LDB(B0, 1, 0); PG8_LDB(B1, 1, 1); PG8_SCHED; PG8_LDA(At, 1, 0); PG8_STAGE(PG8_SA(0, 1), a2 + hstep, voffA);
            PG8_WAIT_V(8); PG8_WAIT_L(0); PG8_BAR; PG8_MMA(0, 0, At, B0); PG8_MMA(0, 1, At, B1); PG8_BAR; PG8_SCHED;
            PG8_LDA(At, 1, 1); PG8_STAGE(PG8_SB(1, 0), b3, voffB); PG8_STAGE(PG8_SB(1, 1), b3 + hstep, voffB); PG8_STAGE(PG8_SA(1, 0), a3, voffA);
            PG8_WAIT_V(8); PG8_WAIT_L(0); PG8_BAR; PG8_MMA(1, 0, At, B0); PG8_MMA(1, 1, At, B1); PG8_BAR; PG8_SCHED;
            } else {
            PG8_LDB(B0, 0, 0); PG8_SCHED; PG8_LDA(At, 0, 0); PG8_STAGE(PG8_SA(1, 1), a1 + hstep, voffA);
            PG8_WAIT_L(8); PG8_BAR; PG8_WAIT_L(0); PG8_MMA(0, 0, At, B0); PG8_BAR; PG8_SCHED;
            PG8_LDB(B1, 0, 1); PG8_STAGE(PG8_SB(0, 0), b2, voffB);
            PG8_BAR; PG8_WAIT_L(0); PG8_MMA(0, 1, At, B1); PG8_BAR;
            PG8_LDA(At, 0, 1); PG8_STAGE(PG8_SA(0, 0), a2, voffA);
            PG8_BAR; PG8_WAIT_L(0); PG8_MMA(1, 0, At, B0); PG8_BAR; PG8_SCHED;
            PG8_STAGE(PG8_SB(0, 1), b2 + hstep, voffB);
            PG8_WAIT_V(6); PG8_BAR; PG8_MMA(1, 1, At, B1); PG8_BAR;
            PG8_LDB(B0, 1, 0); PG8_SCHED; PG8_LDA(At, 1, 0); PG8_STAGE(PG8_SA(0, 1), a2 + hstep, voffA);
            PG8_WAIT_L(8); PG8_BAR; PG8_WAIT_L(0); PG8_MMA(0, 0, At, B0); PG8_BAR; PG8_SCHED;
            PG8_LDB(B1, 1, 1); PG8_STAGE(PG8_SB(1, 0), b3, voffB);
            PG8_BAR; PG8_WAIT_L(0); PG8_MMA(0, 1, At, B1); PG8_BAR;
            PG8_LDA(At, 1, 1); PG8_STAGE(PG8_SA(1, 0), a3, voffA);
            PG8_BAR; PG8_WAIT_L(0); PG8_MMA(1, 0, At, B0); PG8_BAR; PG8_SCHED;
            PG8_STAGE(PG8_SB(1, 1), b3 + hstep, voffB);
            PG8_WAIT_V(6); PG8_BAR; PG8_MMA(1, 1, At, B1); PG8_BAR;
            }
        }
        if constexpr (ALIGN_EPI) { if (wr == 0) PG8_BAR; }
        if constexpr (!Epi::AFTER_DRAIN) { E(acc, cur, wr, wc, fr, fq); S.done(cur); }
        if (!has_next) break;
#pragma unroll
        for (int a = 0; a < 2; ++a)
#pragma unroll
            for (int b = 0; b < 2; ++b)
#pragma unroll
                for (int m = 0; m < 4; ++m)
#pragma unroll
                    for (int n = 0; n < 2; ++n) acc[a][b][m][n] = (f32x4){0.f, 0.f, 0.f, 0.f};
        cur = nxt; cA = nA; cB = nB; ++ui;
        if constexpr (ALIGN_EPI) { if (wr == 1) PG8_BAR; }
    }
    PG8_WAIT_V(0);
    if constexpr (!ALIGN_EPI) { if (wr == 0) PG8_BAR; }
    PG8_BAR;
    if constexpr (Epi::AFTER_DRAIN) { E.fused(acc, cur, wr, wc, fr, fq, lds, wid, lane); S.done(cur); }
#undef PG8_SA
#undef PG8_SB
#undef PG8_STAGE
#undef PG8_LDA
#undef PG8_LDB
#undef PG8_MMA
#undef PG8_WAIT_V
#undef PG8_WAIT_L
#undef PG8_BAR
#undef PG8_SCHED
}
}


using namespace cfg;
constexpr size_t MiB = 1u << 20;
constexpr size_t WS_CTL = 0, CTL_ZERO_BYTES = 1 * MiB;
constexpr size_t WS_ROPE = 1 * MiB;
constexpr size_t WS_SSQA = 3 * MiB;
constexpr size_t WS_SSQF = 5 * MiB;
constexpr size_t WS_ROUTE = 7 * MiB;
constexpr size_t WS_BLKCNT = 8 * MiB;
constexpr size_t WS_ROWGATE = 9 * MiB;
constexpr size_t WS_WIN = 16 * MiB;
constexpr size_t WS_WOUT = 34 * MiB;
constexpr size_t WS_WGU = 42 * MiB;
constexpr size_t WS_WDN = 70 * MiB;
constexpr size_t WS_MGU = 84 * MiB;
constexpr size_t WS_MDN = 196 * MiB;
constexpr size_t WS_XN = 252 * MiB;
constexpr size_t WS_PROJ = 316 * MiB;
constexpr size_t WS_OPART = 460 * MiB;
constexpr size_t WS_LSE = 588 * MiB;
constexpr size_t WS_MIX = 592 * MiB;
constexpr size_t WS_H = 316 * MiB;
constexpr size_t WS_AP = 778 * MiB;
constexpr size_t WS_END = 910 * MiB;
static_assert(WS_H + (size_t)MAXROWS * FF * 2 <= WS_AP && WS_AP + (size_t)MAXROWS * D * 2 <= WS_END && WS_MIX + (size_t)M * D * 2 <= WS_AP, "d_ws map");
static_assert(WS_ROWGATE + (size_t)MAXROWS * 4 <= WS_WIN && WS_LSE + (size_t)3 * M * 8 * 4 <= WS_MIX, "d_ws map 2");
constexpr int CW_BAR = 4096;
constexpr int RING_OFF = 0, RING_BYTES = 131072;
constexpr int LDSCTL_OFF = RING_BYTES, MISC_OFF = LDSCTL_OFF + 320;
constexpr int LDS_BYTES = 147456;
constexpr int NWAVES = 8;

#define GAS __attribute__((address_space(1)))
#define LAS __attribute__((address_space(3)))
typedef unsigned short bf16;
typedef unsigned v4u __attribute__((ext_vector_type(4)));
typedef float f32x4 __attribute__((ext_vector_type(4)));
typedef short bf16x8 __attribute__((ext_vector_type(8)));
typedef GAS unsigned gu32;
typedef GAS unsigned long long gu64;
#define RLX_AGENT __ATOMIC_RELAXED, __HIP_MEMORY_SCOPE_AGENT
#define LDS_WAIT() asm volatile("s_waitcnt lgkmcnt(0)" ::: "memory")
#define VM_WAIT() asm volatile("s_waitcnt vmcnt(0)" ::: "memory")
__device__ __forceinline__ unsigned long long rt() { return __builtin_amdgcn_s_memrealtime(); }
__device__ __forceinline__ unsigned f2bf(float f) { unsigned u = __builtin_bit_cast(unsigned, f); return (u + 0x7fffu + ((u >> 16) & 1u)) >> 16; }
__device__ __forceinline__ unsigned pk2(float lo, float hi) { return f2bf(lo) | (f2bf(hi) << 16); }

#define XB_TMO      128
#define XB_XCNT(j)  (256  + 64 * (j))
#define XB_XSUB(j)  (1280 + 64 * (j))
#define XB_XGEN(j)  (2304 + 64 * (j))
#define XB_TOP      3328
#define XB_TOPGEN   3392
#define XCD_BAR_WORDS 3456
#define XB_SPIN_CAP (1u << 18)

__device__ __forceinline__ unsigned xb_ld(unsigned* p)              { return __hip_atomic_load(p, __ATOMIC_RELAXED, __HIP_MEMORY_SCOPE_AGENT); }
__device__ __forceinline__ unsigned xb_add(unsigned* p, unsigned v) { return __hip_atomic_fetch_add(p, v, __ATOMIC_RELAXED, __HIP_MEMORY_SCOPE_AGENT); }
__device__ __forceinline__ unsigned xb_xcc_id() { return (unsigned)__builtin_amdgcn_s_getreg((3 << 11) | 20) & 0xFu; }
#define XB_SPIN(cond, bar) do { unsigned _sp = 0; while (cond) { __builtin_amdgcn_s_sleep(1); \
    if ((++_sp & 255u) == 0u) { if (xb_ld(&(bar)[XB_TMO])) break; if (_sp > XB_SPIN_CAP) { atomicAdd(&(bar)[XB_TMO], 1u); break; } } } } while (0)

struct XcdBarrier {
    unsigned* bar; unsigned x;
    volatile LAS unsigned* st;
};

__device__ __forceinline__ XcdBarrier xcd_barrier_post(unsigned* bar, volatile LAS unsigned* st) {
    XcdBarrier b; b.bar = bar; b.x = xb_xcc_id(); b.st = st;
    if (threadIdx.x == 0) (void)xb_add(&bar[XB_XCNT(b.x)], 1u);
    return b;
}
__device__ __forceinline__ void xcd_barrier_complete(unsigned* bar, unsigned x, unsigned& nloc, unsigned& nx) {
    const unsigned G = gridDim.x * gridDim.y * gridDim.z;
    unsigned sum, cnt, mine, sp = 0u;
    for (;;) {
        sum = 0u; cnt = 0u; mine = 0u;
#pragma unroll
        for (unsigned j = 0; j < 16; ++j) { const unsigned c = xb_ld(&bar[XB_XCNT(j)]); sum += c; cnt += (c > 0u) ? 1u : 0u; mine = (j == x) ? c : mine; }
        if (sum == G) break;
        __builtin_amdgcn_s_sleep(1);
        if ((++sp & 255u) == 0u) { if (xb_ld(&bar[XB_TMO])) break; if (sp > XB_SPIN_CAP) { atomicAdd(&bar[XB_TMO], 1u); break; } }
    }
    nloc = mine > 0u ? mine : 1u; nx = cnt > 0u ? cnt : 1u;
}

__device__ __forceinline__ void xcd_barrier(const XcdBarrier& b) {
    asm volatile("s_waitcnt vmcnt(0)" ::: "memory");
    __syncthreads();
    if (threadIdx.x == 0) {
        unsigned* bar = b.bar;
        __builtin_amdgcn_s_waitcnt(0);
        unsigned nloc = b.st[0], nx = b.st[1];
        if (nloc == 0u) { xcd_barrier_complete(bar, b.x, nloc, nx); b.st[0] = nloc; b.st[1] = nx; }
        const unsigned old = xb_add(&bar[XB_XSUB(b.x)], 1u);
        const unsigned gen = old / nloc;
        if (old + 1u == (gen + 1u) * nloc) {
            __builtin_amdgcn_fence(__ATOMIC_RELEASE, "agent");
            asm volatile("s_waitcnt vmcnt(0)" ::: "memory");
            const unsigned og = xb_add(&bar[XB_TOP], 1u);
            const unsigned tg = og / nx;
            if (og + 1u == (tg + 1u) * nx) xb_add(&bar[XB_TOPGEN], 1u);
            else XB_SPIN(xb_ld(&bar[XB_TOPGEN]) == tg, bar);
            __builtin_amdgcn_fence(__ATOMIC_ACQUIRE, "agent");
            xb_add(&bar[XB_XGEN(b.x)], 1u);
            asm volatile("s_waitcnt vmcnt(0)" ::: "memory");
        } else {
            XB_SPIN(xb_ld(&bar[XB_XGEN(b.x)]) == gen, bar);
            __builtin_amdgcn_fence(__ATOMIC_ACQUIRE, "agent");
            asm volatile("s_waitcnt vmcnt(0)" ::: "memory");
        }
    }
    __syncthreads();
}


__device__ __forceinline__ float wave_sum(float v) {
#pragma unroll
    for (int o = 1; o < 64; o <<= 1) v += __shfl_xor(v, o);
    return v;
}
__device__ __forceinline__ int wave_sum_i(int v) {
#pragma unroll
    for (int o = 1; o < 64; o <<= 1) v += __shfl_xor(v, o);
    return v;
}
__device__ __forceinline__ float bf2f(unsigned short b) { return __builtin_bit_cast(float, (unsigned)b << 16); }
__device__ __forceinline__ float bflo(unsigned w) { return __builtin_bit_cast(float, w << 16); }
__device__ __forceinline__ float bfhi(unsigned w) { return __builtin_bit_cast(float, w & 0xffff0000u); }
typedef unsigned u32x2v __attribute__((ext_vector_type(2)));

struct Ctx { LAS unsigned char* lds; int tid, lane, wave, gw, ngw; };

__device__ __forceinline__ int rowmap(int mode, int n) {
    if (mode == 1) { const int hb = n >> 6, w = n & 63, nn = w >> 5, i = w & 31; return (hb << 6) + 8 * (i >> 2) + 4 * nn + (i & 3); }
    if (mode == 2) return 256 * (n >> 7) + (n & 127);
    if (mode == 3) return 256 * (n >> 7) + 128 + (n & 127);
    return n;
}
__device__ __forceinline__ void transpose_item(const float* W, int K, int N, bf16* WT, int mode, const float* gain, LAS float* scr, int item, int lane) {
    const int nblk = N / 32, kb = item / nblk, nb = item % nblk, k0 = 64 * kb, n0 = 32 * nb;
#pragma unroll 8
    for (int i = 0; i < 32; ++i) { const int kk = 2 * i + (lane >> 5); float v = W[(size_t)(k0 + kk) * N + n0 + (lane & 31)]; if (gain) v *= gain[k0 + kk]; scr[kk * 33 + (lane & 31)] = v; }
    LDS_WAIT(); asm volatile("" ::: "memory");
    const int c = lane & 7;
#pragma unroll
    for (int j = 0; j < 4; ++j) { const int n = (lane >> 3) + 8 * j; const LAS float* s = scr + (8 * c) * 33 + n;
        v4u o; o.x = pk2(s[0 * 33], s[1 * 33]); o.y = pk2(s[2 * 33], s[3 * 33]); o.z = pk2(s[4 * 33], s[5 * 33]); o.w = pk2(s[6 * 33], s[7 * 33]);
        *(GAS v4u*)(WT + (size_t)rowmap(mode, n0 + n) * K + k0 + 8 * c) = o; }
    LDS_WAIT(); asm volatile("" ::: "memory");
}
__device__ __forceinline__ void convert_matrix(const Ctx& C, const float* W, int K, int N, bf16* WT, int mode, const float* gain) {
    LAS float* scr = (LAS float*)(C.lds + RING_OFF + C.wave * 16384);
    const int nitems = (K / 64) * (N / 32);
    for (int it = C.gw; it < nitems; it += C.ngw) transpose_item(W, K, N, WT, mode, gain, scr, it, C.lane);
}
__device__ __forceinline__ void convert_moe_layer(const Ctx& C, const float* wg, const float* wu, const float* wd, bf16* MGU, bf16* MDN) {
    for (int e = 0; e < NE; ++e) {
        convert_matrix(C, wg + (size_t)e * D * FF, D, FF, MGU + (size_t)e * 2 * FF * D, 2, nullptr);
        convert_matrix(C, wu + (size_t)e * D * FF, D, FF, MGU + (size_t)e * 2 * FF * D, 3, nullptr);
        convert_matrix(C, wd + (size_t)e * FF * D, FF, D, MDN + (size_t)e * D * FF, 0, nullptr);
    }
}

__device__ __forceinline__ void ld16bf(const bf16* p, float (&v)[16]) {
    const v4u a = *(const GAS v4u*)p, b = *(const GAS v4u*)(p + 8);
    v[0] = bflo(a.x); v[1] = bfhi(a.x); v[2] = bflo(a.y); v[3] = bfhi(a.y); v[4] = bflo(a.z); v[5] = bfhi(a.z); v[6] = bflo(a.w); v[7] = bfhi(a.w);
    v[8] = bflo(b.x); v[9] = bfhi(b.x); v[10] = bflo(b.y); v[11] = bfhi(b.y); v[12] = bflo(b.z); v[13] = bfhi(b.z); v[14] = bflo(b.w); v[15] = bfhi(b.w);
}
__device__ __forceinline__ void st16bf(bf16* p, const float (&v)[16], float f) {
    v4u a, b; a.x = pk2(v[0] * f, v[1] * f); a.y = pk2(v[2] * f, v[3] * f); a.z = pk2(v[4] * f, v[5] * f); a.w = pk2(v[6] * f, v[7] * f);
    b.x = pk2(v[8] * f, v[9] * f); b.y = pk2(v[10] * f, v[11] * f); b.z = pk2(v[12] * f, v[13] * f); b.w = pk2(v[14] * f, v[15] * f);
    *(GAS v4u*)p = a; *(GAS v4u*)(p + 8) = b;
}
__device__ __forceinline__ void attn_run(const bf16* PROJ, int rowb, int t, int d, int nk, int kcol, int vcol, const float (&q)[16], float (&o)[16], float& mx, float& l) {
    for (int k = 0; k < nk; ++k) {
        const int j = t - d * k; if (j < 0) break;
        const bf16* kr = PROJ + (size_t)(rowb + j) * INW;
        float kv[16]; ld16bf(kr + kcol, kv);
        float s = 0.f;
#pragma unroll
        for (int i = 0; i < 16; ++i) s += q[i] * kv[i];
        s += __shfl_xor(s, 1); s += __shfl_xor(s, 2);
        if (s > mx) { const float sc = __builtin_amdgcn_exp2f(mx - s); l *= sc;
#pragma unroll
            for (int i = 0; i < 16; ++i) o[i] *= sc;
            mx = s; }
        const float p = __builtin_amdgcn_exp2f(s - mx); l += p;
        float vv[16]; ld16bf(kr + vcol, vv);
#pragma unroll
        for (int i = 0; i < 16; ++i) o[i] += p * vv[i];
    }
}
__device__ __forceinline__ void attn_naive(const Ctx& C, const bf16* PROJ, bf16* OPART, float* LSE, const float* sinks) {
    const int grp = (blockIdx.x * 512 + C.tid) >> 2, sub = C.tid & 3, ngrp = gridDim.x * 128;
    for (int it = grp; it < M * 16; it += ngrp) {
        const int hh = it / M, row = it % M, t = row & (S - 1), rowb = row - t;
        if (hh < 8) {
            float q[16]; ld16bf(PROJ + (size_t)row * INW + QA_OFF + hh * 64 + sub * 16, q);
#pragma unroll 1
            for (int br = 0; br < 3; ++br) {
                const int d = (br == 0) ? 1 : (br == 1) ? 4 : 16;
                float o[16]; float mx = -INFINITY, l = 0.f;
#pragma unroll
                for (int i = 0; i < 16; ++i) o[i] = 0.f;
                attn_run(PROJ, rowb, t, d, 129, KA_OFF + hh * 64 + sub * 16, VA_OFF + hh * 64 + sub * 16, q, o, mx, l);
                st16bf(OPART + ((size_t)br * M + row) * 512 + hh * 64 + sub * 16, o, 1.0f / l);
                if (sub == 0) LSE[((size_t)br * M + row) * 8 + hh] = mx + __builtin_amdgcn_logf(l);
            }
        } else {
            const int hq = hh - 8, kvh = hq >> 2;
            float q[16]; ld16bf(PROJ + (size_t)row * INW + QB_OFF + hq * 64 + sub * 16, q);
            float o[16]; float mx = -INFINITY, l = 0.f;
#pragma unroll
            for (int i = 0; i < 16; ++i) o[i] = 0.f;
            attn_run(PROJ, rowb, t, 1, 128, KB_OFF + kvh * 64 + sub * 16, VB_OFF + kvh * 64 + sub * 16, q, o, mx, l);
            const float sk = sinks[hq] * LOG2E, m2 = fmaxf(mx, sk), sc = __builtin_amdgcn_exp2f(mx - m2);
            l = l * sc + __builtin_amdgcn_exp2f(sk - m2);
            st16bf(OPART + ((size_t)3 * M + row) * 512 + hq * 64 + sub * 16, o, sc / l);
        }
    }
}

__device__ __forceinline__ void ld8bf(const bf16* p, float (&v)[8]) {
    const v4u a = *(const GAS v4u*)p;
    v[0] = bflo(a.x); v[1] = bfhi(a.x); v[2] = bflo(a.y); v[3] = bfhi(a.y); v[4] = bflo(a.z); v[5] = bfhi(a.z); v[6] = bflo(a.w); v[7] = bfhi(a.w);
}
__device__ __forceinline__ void combine_phase(const Ctx& C, const bf16* OPART, const float* LSE, const float* gna, const float* gnb, bf16* MIX) {
    const int h = C.lane >> 3;
    float ga[8], gb[8];
#pragma unroll
    for (int i = 0; i < 8; ++i) { ga[i] = gna[8 * C.lane + i]; gb[i] = gnb[8 * C.lane + i]; }
    for (int row = C.gw; row < M; row += C.ngw) {
        const float l0 = LSE[((size_t)0 * M + row) * 8 + h], l1 = LSE[((size_t)1 * M + row) * 8 + h], l2 = LSE[((size_t)2 * M + row) * 8 + h];
        const float mx = fmaxf(l0, fmaxf(l1, l2));
        float w0 = __builtin_amdgcn_exp2f(l0 - mx), w1 = __builtin_amdgcn_exp2f(l1 - mx), w2 = __builtin_amdgcn_exp2f(l2 - mx);
        const float inv = 1.0f / (w0 + w1 + w2); w0 *= inv; w1 *= inv; w2 *= inv;
        float a0[8], a1[8], a2[8], b[8];
        ld8bf(OPART + ((size_t)0 * M + row) * 512 + 8 * C.lane, a0); ld8bf(OPART + ((size_t)1 * M + row) * 512 + 8 * C.lane, a1);
        ld8bf(OPART + ((size_t)2 * M + row) * 512 + 8 * C.lane, a2); ld8bf(OPART + ((size_t)3 * M + row) * 512 + 8 * C.lane, b);
        float sa = 0.f, sb = 0.f;
#pragma unroll
        for (int i = 0; i < 8; ++i) { a0[i] = w0 * a0[i] + w1 * a1[i] + w2 * a2[i]; sa += a0[i] * a0[i]; sb += b[i] * b[i]; }
        sa = wave_sum(sa); sb = wave_sum(sb);
        const float ra = __builtin_amdgcn_rsqf(sa * (1.0f / 512.0f) + EPS), rb = __builtin_amdgcn_rsqf(sb * (1.0f / 512.0f) + EPS);
        v4u oa, ob;
        oa.x = pk2(a0[0] * ra * ga[0], a0[1] * ra * ga[1]); oa.y = pk2(a0[2] * ra * ga[2], a0[3] * ra * ga[3]); oa.z = pk2(a0[4] * ra * ga[4], a0[5] * ra * ga[5]); oa.w = pk2(a0[6] * ra * ga[6], a0[7] * ra * ga[7]);
        ob.x = pk2(b[0] * rb * gb[0], b[1] * rb * gb[1]); ob.y = pk2(b[2] * rb * gb[2], b[3] * rb * gb[3]); ob.z = pk2(b[4] * rb * gb[4], b[5] * rb * gb[5]); ob.w = pk2(b[6] * rb * gb[6], b[7] * rb * gb[7]);
        *(GAS v4u*)(MIX + (size_t)row * D + 8 * C.lane) = oa; *(GAS v4u*)(MIX + (size_t)row * D + 512 + 8 * C.lane) = ob;
    }
}

__device__ __forceinline__ void row_load(const float* p, int lane, f32x4 (&v)[4]) {
#pragma unroll
    for (int j = 0; j < 4; ++j) v[j] = *(const GAS f32x4*)(p + 4 * lane + 256 * j);
}
__device__ __forceinline__ float row_ssq(const f32x4 (&v)[4]) {
    float s = 0.f;
#pragma unroll
    for (int j = 0; j < 4; ++j) s += (v[j][0] * v[j][0] + v[j][1] * v[j][1]) + (v[j][2] * v[j][2] + v[j][3] * v[j][3]);
    return wave_sum(s);
}
__device__ __forceinline__ void row_store_bf16(bf16* p, int lane, const f32x4 (&v)[4]) {
#pragma unroll
    for (int j = 0; j < 4; ++j) { u32x2v w; w.x = pk2(v[j][0], v[j][1]); w.y = pk2(v[j][2], v[j][3]); *(GAS u32x2v*)(p + 4 * lane + 256 * j) = w; }
}
__device__ __forceinline__ void xn_rows(const Ctx& C, const float* x, bf16* XN, float* ssq) {
    for (int row = C.gw; row < M; row += C.ngw) {
        f32x4 v[4]; row_load(x + (size_t)row * D, C.lane, v);
        const float s = row_ssq(v);
        row_store_bf16(XN + (size_t)row * D, C.lane, v);
        if (C.lane < 16) ssq[(size_t)row * 16 + C.lane] = (C.lane == 0) ? s : 0.f;
    }
}

struct Route { int e0, e1; float g0, g1, rs; int p0, p1, pad; };
__device__ __forceinline__ void router_phase(const Ctx& C, const float* x1, const float* router, const float* gain, Route* RT, int* blkcnt) {
    LAS float* GRt = (LAS float*)(C.lds + RING_OFF);
    LAS unsigned* tokE = (LAS unsigned*)(C.lds + RING_OFF + 32768);
    for (int i = C.tid; i < 1024 * 8; i += 512) { const int c = i >> 3, e = i & 7; GRt[e * 1024 + c] = router[i] * gain[c]; }
    __syncthreads();
    const int tok0 = blockIdx.x * 128 + C.wave * 16;
    for (int tt = 0; tt < 16; ++tt) {
        const int tok = tok0 + tt;
        f32x4 v[4]; row_load(x1 + (size_t)tok * D, C.lane, v);
        float ss = 0.f, lg[8];
#pragma unroll
        for (int e = 0; e < 8; ++e) lg[e] = 0.f;
#pragma unroll
        for (int j = 0; j < 4; ++j) { ss += (v[j][0] * v[j][0] + v[j][1] * v[j][1]) + (v[j][2] * v[j][2] + v[j][3] * v[j][3]);
#pragma unroll
            for (int e = 0; e < 8; ++e) { const f32x4 r = *(const LAS f32x4*)(GRt + e * 1024 + 4 * C.lane + 256 * j); lg[e] += (v[j][0] * r[0] + v[j][1] * r[1]) + (v[j][2] * r[2] + v[j][3] * r[3]); } }
        ss = wave_sum(ss);
        const float rs = __builtin_amdgcn_rsqf(ss * (1.0f / D) + EPS);
#pragma unroll
        for (int e = 0; e < 8; ++e) lg[e] = wave_sum(lg[e]) * rs;
        int e0 = 0; float v0 = lg[0];
#pragma unroll
        for (int e = 1; e < 8; ++e) if (lg[e] > v0) { v0 = lg[e]; e0 = e; }
        int e1 = -1; float v1 = -INFINITY;
#pragma unroll
        for (int e = 0; e < 8; ++e) if (e != e0 && lg[e] > v1) { v1 = lg[e]; e1 = e; }
        const float ex = __expf(v1 - v0), g0 = 1.0f / (1.0f + ex), g1 = ex * g0;
        if (C.lane == 0) { Route r; r.e0 = e0; r.e1 = e1; r.g0 = g0; r.g1 = g1; r.rs = rs; r.p0 = 0; r.p1 = 0; r.pad = 0; RT[tok] = r; tokE[C.wave * 16 + tt] = (unsigned)e0 | ((unsigned)e1 << 8); }
    }
    __syncthreads();
    if (C.tid < 8) { int cnt = 0; for (int t = 0; t < 128; ++t) { const unsigned w = tokE[t]; cnt += ((w & 255u) == (unsigned)C.tid) + ((w >> 8) == (unsigned)C.tid); } blkcnt[blockIdx.x * 8 + C.tid] = cnt; }
    __syncthreads();
}
__device__ __forceinline__ void scatter_phase(const Ctx& C, const float* x1, const float* gain, Route* RT, const int* blkcnt, bf16* AP, float* rowgate, volatile LAS int* SEGB) {
    LAS int* LTOT = (LAS int*)(C.lds + RING_OFF);
    LAS int* LPRE = LTOT + 8;
    LAS unsigned* tokE = (LAS unsigned*)(LTOT + 16);
    LAS int* POS = (LAS int*)(LTOT + 16 + 128);
    { const int e = C.wave; int st = 0, sp = 0;
#pragma unroll
      for (int j = 0; j < 4; ++j) { const int b = C.lane + 64 * j; const int c = blkcnt[b * 8 + e]; st += c; if (b < (int)blockIdx.x) sp += c; }
      st = wave_sum_i(st); sp = wave_sum_i(sp);
      if (C.lane == 0) { LTOT[e] = st; LPRE[e] = sp; } }
    if (C.tid < 128) { const Route r = RT[blockIdx.x * 128 + C.tid]; tokE[C.tid] = (unsigned)r.e0 | ((unsigned)r.e1 << 8); }
    __syncthreads();
    if (C.tid == 0) { int base = 0; for (int e = 0; e < 8; ++e) { SEGB[e] = base; base += (LTOT[e] + 255) & ~255; } SEGB[8] = base; }
    __syncthreads();
    if (C.tid < 8) { const int e = C.tid; int run = SEGB[e] + LPRE[e];
        for (int t = 0; t < 128; ++t) { const unsigned w = tokE[t]; if ((int)(w & 255u) == e) POS[2 * t] = run++; if ((int)(w >> 8) == e) POS[2 * t + 1] = run++; } }
    __syncthreads();
    float gn[4][4];
#pragma unroll
    for (int j = 0; j < 4; ++j) { const f32x4 g = *(const GAS f32x4*)(gain + 4 * C.lane + 256 * j); gn[j][0] = g[0]; gn[j][1] = g[1]; gn[j][2] = g[2]; gn[j][3] = g[3]; }
    for (int tt = 0; tt < 16; ++tt) {
        const int tl = C.wave * 16 + tt, tok = blockIdx.x * 128 + tl;
        const int p0 = POS[2 * tl], p1 = POS[2 * tl + 1];
        const Route r = RT[tok];
        if (C.lane == 0) { RT[tok].p0 = p0; RT[tok].p1 = p1; rowgate[p0] = r.g0; rowgate[p1] = r.g1; }
        f32x4 v[4]; row_load(x1 + (size_t)tok * D, C.lane, v);
#pragma unroll
        for (int j = 0; j < 4; ++j) { v[j][0] *= r.rs * gn[j][0]; v[j][1] *= r.rs * gn[j][1]; v[j][2] *= r.rs * gn[j][2]; v[j][3] *= r.rs * gn[j][3]; }
        row_store_bf16(AP + (size_t)p0 * D, C.lane, v); row_store_bf16(AP + (size_t)p1 * D, C.lane, v);
    }
    if (blockIdx.x < 8) { const int e = blockIdx.x; const int lo = SEGB[e] + LTOT[e], hi = SEGB[e + 1];
        for (int rr = lo + C.wave; rr < hi; rr += NWAVES) {
#pragma unroll
            for (int j = 0; j < 4; ++j) { u32x2v z; z.x = 0u; z.y = 0u; *(GAS u32x2v*)(AP + (size_t)rr * D + 4 * C.lane + 256 * j) = z; }
            if (C.lane == 0) rowgate[rr] = 0.f; } }
    __syncthreads();
}
__device__ __forceinline__ void moe_combine(const Ctx& C, float* xio, const Route* RT, const bf16* Y, bf16* XN, float* ssq, const float* final_gain) {
    for (int row = C.gw; row < M; row += C.ngw) {
        const int p0 = RT[row].p0, p1 = RT[row].p1;
        f32x4 v[4]; row_load(xio + (size_t)row * D, C.lane, v);
#pragma unroll
        for (int j = 0; j < 4; ++j) { const u32x2v a = *(const GAS u32x2v*)(Y + (size_t)p0 * D + 4 * C.lane + 256 * j), b = *(const GAS u32x2v*)(Y + (size_t)p1 * D + 4 * C.lane + 256 * j);
            v[j][0] += bflo(a.x) + bflo(b.x); v[j][1] += bfhi(a.x) + bfhi(b.x); v[j][2] += bflo(a.y) + bflo(b.y); v[j][3] += bfhi(a.y) + bfhi(b.y); }
        const float s = row_ssq(v);
        if (final_gain) {
            const float rs = __builtin_amdgcn_rsqf(s * (1.0f / D) + EPS);
#pragma unroll
            for (int j = 0; j < 4; ++j) { const f32x4 g = *(const GAS f32x4*)(final_gain + 4 * C.lane + 256 * j); *(GAS f32x4*)(xio + (size_t)row * D + 4 * C.lane + 256 * j) = v[j] * rs * g; }
        } else {
#pragma unroll
            for (int j = 0; j < 4; ++j) *(GAS f32x4*)(xio + (size_t)row * D + 4 * C.lane + 256 * j) = v[j];
            row_store_bf16(XN + (size_t)row * D, C.lane, v);
            if (C.lane < 16) ssq[(size_t)row * 16 + C.lane] = (C.lane == 0) ? s : 0.f;
        }
    }
}

struct Args { const void* in[17]; float* out; unsigned char* ws; };
__global__ void __launch_bounds__(NWAVES * 64, 2) trunk_fwd(Args args) {
    extern __shared__ __attribute__((aligned(16))) unsigned char lds[];
    const int G = gridDim.x;
#define MKCTX() Ctx C; { int t_ = threadIdx.x; asm volatile("" : "+v"(t_)); C.lds = (LAS unsigned char*)lds; C.tid = t_; C.lane = t_ & 63; C.wave = __builtin_amdgcn_readfirstlane(t_ >> 6); C.gw = blockIdx.x * NWAVES + C.wave; C.ngw = G * NWAVES; }
    LAS unsigned char* const ldsb = (LAS unsigned char*)lds;
    volatile LAS unsigned* MISC = (volatile LAS unsigned*)(ldsb + MISC_OFF);
    volatile LAS int* SEGB = (volatile LAS int*)(ldsb + MISC_OFF + 64);
    unsigned char* ws = args.ws;
    gu32* ctl = (gu32*)(ws + WS_CTL);
    for (int u = threadIdx.x; u < (LDS_BYTES - LDSCTL_OFF) / 4; u += NWAVES * 64) ((LAS unsigned*)(ldsb + LDSCTL_OFF))[u] = 0u;
    __syncthreads();
    XcdBarrier bar = xcd_barrier_post((unsigned*)(ctl + CW_BAR), MISC + 8);
#define GRID_BAR() do { XcdBarrier b_ = bar; asm volatile("" : "+s"(b_.x)); xcd_barrier(b_); } while (0)

    const float* x_in = (const float*)args.in[0]; const int* positions = (const int*)args.in[1];
    const float* attn_norm = (const float*)args.in[2]; const float* w_in = (const float*)args.in[3];
    const float* mix_norm_a = (const float*)args.in[4]; const float* mix_norm_b = (const float*)args.in[5];
    const float* sinks = (const float*)args.in[6]; const float* w_out = (const float*)args.in[7];
    const float* ffn_norm = (const float*)args.in[8]; const float* dwg = (const float*)args.in[9];
    const float* dwu = (const float*)args.in[10]; const float* dwd = (const float*)args.in[11];
    const float* router = (const float*)args.in[12]; const float* mwg = (const float*)args.in[13];
    const float* mwu = (const float*)args.in[14]; const float* mwd = (const float*)args.in[15];
    const float* final_norm = (const float*)args.in[16];
    float* xout = args.out;
    float* ROPE = (float*)(ws + WS_ROPE); float* SSQA = (float*)(ws + WS_SSQA); float* SSQF = (float*)(ws + WS_SSQF);
    Route* RT = (Route*)(ws + WS_ROUTE); int* BLKCNT = (int*)(ws + WS_BLKCNT); float* ROWGATE = (float*)(ws + WS_ROWGATE);
    bf16* WIN = (bf16*)(ws + WS_WIN); bf16* WOUT = (bf16*)(ws + WS_WOUT); bf16* WGU = (bf16*)(ws + WS_WGU); bf16* WDN = (bf16*)(ws + WS_WDN);
    bf16* MGU = (bf16*)(ws + WS_MGU); bf16* MDN = (bf16*)(ws + WS_MDN); bf16* XN = (bf16*)(ws + WS_XN); bf16* PROJ = (bf16*)(ws + WS_PROJ);
    bf16* OPART = (bf16*)(ws + WS_OPART); float* LSE = (float*)(ws + WS_LSE); bf16* MIX = (bf16*)(ws + WS_MIX); bf16* HB = (bf16*)(ws + WS_H); bf16* AP = (bf16*)(ws + WS_AP);

    { MKCTX();
    for (int l = 0; l < DEPTH; ++l) {
        convert_matrix(C, w_in + (size_t)l * D * INW, D, INW, WIN + (size_t)l * INW * D, 1, attn_norm + l * D);
        convert_matrix(C, w_out + (size_t)l * D * D, D, D, WOUT + (size_t)l * D * D, 0, nullptr);
    }
    for (int j = 0; j < 2; ++j) {
        convert_matrix(C, dwg + (size_t)j * D * FF, D, FF, WGU + (size_t)j * 2 * FF * D, 2, ffn_norm + (2 * j) * D);
        convert_matrix(C, dwu + (size_t)j * D * FF, D, FF, WGU + (size_t)j * 2 * FF * D, 3, ffn_norm + (2 * j) * D);
        convert_matrix(C, dwd + (size_t)j * FF * D, FF, D, WDN + (size_t)j * D * FF, 0, nullptr);
    }
    convert_moe_layer(C, mwg, mwu, mwd, MGU, MDN);
    for (int i = blockIdx.x * 512 + C.tid; i < S * 32; i += G * 512) {
        const int s = i >> 5, f = i & 31;
        const float inv = __builtin_amdgcn_exp2f(-(float)f * (13.287712379549449f / 32.0f));
        const float ang = (float)positions[s] * inv;
        const double rev = (double)ang * 0.15915494309189535; const float fr = (float)(rev - __builtin_rint(rev));
        ROPE[2 * i] = __builtin_amdgcn_cosf(fr); ROPE[2 * i + 1] = __builtin_amdgcn_sinf(fr);
    }
    xn_rows(C, x_in, XN, SSQA); }
    GRID_BAR();

#pragma unroll 1
    for (int l = 0; l < DEPTH; ++l) {
        { MKCTX(); pg8::Gemm g{XN, WIN + (size_t)l * INW * D, M, INW, D, 0}; pg8::StaticOrder So; So.init(M, INW, G, (int)blockIdx.x);
          pg8::EpiRope E{PROJ, SSQA, ROPE};
          pg8::gemm_phase<pg8::EpiRope, pg8::StaticOrder, true, true>(C.lds + RING_OFF, g, So, E); }
        GRID_BAR();
        { MKCTX(); attn_naive(C, PROJ, OPART, LSE, sinks + l * 8); }
        GRID_BAR();
        { MKCTX(); combine_phase(C, OPART, LSE, mix_norm_a + l * 512, mix_norm_b + l * 512, MIX); }
        GRID_BAR();
        { MKCTX(); pg8::Gemm g{MIX, WOUT + (size_t)l * D * D, M, D, D, 0}; pg8::StaticOrder So; So.init(M, D, G, (int)blockIdx.x);
          pg8::EpiResid E{l == 0 ? x_in : xout, xout, XN, SSQF};
          pg8::gemm_phase<pg8::EpiResid, pg8::StaticOrder, true, true>(C.lds + RING_OFF, g, So, E); }
        GRID_BAR();
        if ((l & 1) == 0) {
            const int j = l >> 1;
            { MKCTX(); pg8::Gemm g{XN, WGU + (size_t)j * 2 * FF * D, M, 2 * FF, D, 0}; pg8::StaticOrder So; So.init(M, 2 * FF, G, (int)blockIdx.x);
              pg8::EpiSwiglu<true> E{HB, SSQF};
              pg8::gemm_phase<pg8::EpiSwiglu<true>, pg8::StaticOrder, true, true>(C.lds + RING_OFF, g, So, E); }
            GRID_BAR();
            { MKCTX(); pg8::Gemm g{HB, WDN + (size_t)j * D * FF, M, D, FF, 0}; pg8::StaticOrder So; So.init(M, D, G, (int)blockIdx.x);
              pg8::EpiResid E{xout, xout, XN, SSQA};
              pg8::gemm_phase<pg8::EpiResid, pg8::StaticOrder, true, true>(C.lds + RING_OFF, g, So, E); }
            GRID_BAR();
        } else {
            const int j = l >> 1;
            { MKCTX(); router_phase(C, xout, router + (size_t)j * D * NE, ffn_norm + l * D, RT, BLKCNT); }
            GRID_BAR();
            { MKCTX(); scatter_phase(C, xout, ffn_norm + l * D, RT, BLKCNT, AP, ROWGATE, SEGB); }
            GRID_BAR();
            const int nrows = SEGB[8];
            { MKCTX(); pg8::Gemm g{AP, MGU, nrows, 2 * FF, D, (size_t)2 * FF * D * 2}; pg8::GroupedOrder So; So.init(nrows, 2 * FF, G, (int)blockIdx.x); So.segb = (const LAS int*)(C.lds + MISC_OFF + 64);
              pg8::EpiSwiglu<false> E{HB, nullptr};
              pg8::gemm_phase<pg8::EpiSwiglu<false>, pg8::GroupedOrder, true, true>(C.lds + RING_OFF, g, So, E); }
            GRID_BAR();
            { MKCTX(); pg8::Gemm g{HB, MDN, nrows, D, FF, (size_t)D * FF * 2}; pg8::GroupedOrder So; So.init(nrows, D, G, (int)blockIdx.x); So.segb = (const LAS int*)(C.lds + MISC_OFF + 64);
              pg8::EpiY E{AP, ROWGATE};
              pg8::gemm_phase<pg8::EpiY, pg8::GroupedOrder, true, true>(C.lds + RING_OFF, g, So, E); }
            GRID_BAR();
            { MKCTX(); moe_combine(C, xout, RT, AP, XN, SSQA, l == DEPTH - 1 ? final_norm : nullptr);
            if (l == 1) convert_moe_layer(C, mwg + (size_t)NE * D * FF, mwu + (size_t)NE * D * FF, mwd + (size_t)NE * FF * D, MGU, MDN); }
            if (l != DEPTH - 1) GRID_BAR();
        }
    }
}

extern "C" void kernel_launch(void* const* d_in, const int* in_sizes, int n_in, void* d_out, int out_size, void* d_ws, size_t ws_size, hipStream_t stream) {
    static int grid = 0;
    if (grid == 0) {
        if (n_in != 17 || in_sizes[0] != M * D || out_size != M * D || ws_size < WS_END) {
            fprintf(stderr, "kernel_launch: unexpected shapes / workspace (n_in %d, in0 %d, out %d, ws %zu, need %zu); nothing launched\n", n_in, n_in > 0 ? in_sizes[0] : -1, out_size, ws_size, (size_t)WS_END); grid = -1; return; }
        int dev = 0, cus = 0, per_cu = 0;
        if (hipGetDevice(&dev) != hipSuccess || hipDeviceGetAttribute(&cus, hipDeviceAttributeMultiprocessorCount, dev) != hipSuccess) { grid = -1; return; }
        if (hipFuncSetAttribute((const void*)trunk_fwd, hipFuncAttributeMaxDynamicSharedMemorySize, LDS_BYTES) != hipSuccess) { fprintf(stderr, "kernel_launch: hipFuncSetAttribute failed\n"); grid = -1; return; }
        if (hipOccupancyMaxActiveBlocksPerMultiprocessor(&per_cu, (const void*)trunk_fwd, NWAVES * 64, LDS_BYTES) != hipSuccess || per_cu < 1) { fprintf(stderr, "kernel_launch: occupancy query reports %d blocks per CU\n", per_cu); }
        (void)hipGetLastError();
        grid = cus;
        if (grid != 256) { fprintf(stderr, "kernel_launch: built for 256 CUs, device has %d; nothing launched\n", cus); grid = -1; return; }
    }
    if (grid < 0) return;
    if (hipMemsetAsync((char*)d_ws + WS_CTL, 0, CTL_ZERO_BYTES, stream) != hipSuccess) return;
    Args a{};
    for (int i = 0; i < 17; ++i) a.in[i] = d_in[i];
    a.out = (float*)d_out; a.ws = (unsigned char*)d_ws;
    hipLaunchKernelGGL(trunk_fwd, dim3(grid), dim3(NWAVES * 64), LDS_BYTES, stream, a);
}
```

```cpp
#include <hip/hip_runtime.h>
#include <cstdio>
#include <cstdint>

#ifndef PROBE_T
#define PROBE_T 0
#endif
namespace cfg {
constexpr int D = 1024, NB = 4, S = 8192, M = NB * S, DEPTH = 4, HD = 64, INW = 2304, FF = 3584, NE = 8;
constexpr int QA_OFF = 0, KA_OFF = 512, VA_OFF = 1024, QB_OFF = 1536, KB_OFF = 2048, VB_OFF = 2176;
constexpr float EPS = 1e-5f;
constexpr float LOG2E = 1.4426950408889634f;
constexpr float C2 = 0.125f * LOG2E;
constexpr int MAXROWS = 2 * M + NE * 256;
constexpr int MAINROWS = 2 * M;
constexpr int TAILROWS = 7 * 256, KSPLIT = 7;
}

template <int K> __device__ __forceinline__ float swz_xor(float v) { return __builtin_bit_cast(float, __builtin_amdgcn_ds_swizzle(__builtin_bit_cast(int, v), (K << 10) | 0x1f)); }
__device__ __forceinline__ void pl32_swap(float& a, float& b) { asm volatile("s_nop 1\n\tv_permlane32_swap_b32 %0, %1" : "+v"(a), "+v"(b)); }
__device__ __forceinline__ float xor32_sum(float v) { float a = v, b = v; pl32_swap(a, b); return a + b; }
__device__ __forceinline__ float xor32_max(float v) { float a = v, b = v; pl32_swap(a, b); return fmaxf(a, b); }
__device__ __forceinline__ float fq_sum(float s) { s += swz_xor<16>(s); return xor32_sum(s); }
namespace pg8 {
#define PG8_LAS __attribute__((address_space(3)))
typedef unsigned short bf16_t;
typedef short bf16x8 __attribute__((ext_vector_type(8)));
typedef float f32x4 __attribute__((ext_vector_type(4)));
typedef unsigned u32x4 __attribute__((ext_vector_type(4)));
constexpr int BM = 256, BK = 64, HALF = 128, HTB = HALF * BK * 2  , STAGE_BYTES = 8 * HTB, NXCD = 8, WGM = 8;

__host__ __device__ __forceinline__ int lds_byte(int r, int c) { const int st = (r >> 4) * 2 + (c >> 5), rr = r & 15, cc = c & 31, ob = rr * 64 + cc * 2; return st * 1024 + (ob ^ (((ob >> 9) & 1) << 5)); }
__host__ __device__ __forceinline__ void stage_rc(int b, int& R, int& C) { const int st = b / 1024, sb = b % 1024, swz = sb ^ (((sb >> 9) & 1) << 5); R = (st >> 1) * 16 + swz / 64; C = (st & 1) * 32 + (swz % 64) / 2; }
__host__ __device__ __forceinline__ int perm32(int rho) { const int n = rho >> 4, i = rho & 15; return 8 * (i >> 2) + 4 * n + (i & 3); }

struct Unit { int pm, pn, eb, ko; };
struct Gemm { const bf16_t* A; const bf16_t* Bt; int M, N, K; size_t bstride; int ld; };

struct StaticOrder {
    int nM, nN, nwg, G, c;
    __host__ __device__ void init(int M, int N, int G_, int c_) { nM = M / BM; nN = N / BM; nwg = nM * nN; G = G_; c = c_; }
    __host__ __device__ bool next(int i, Unit& u) const {
        const long L = (long)i * G + c; if (L >= nwg) return false;
        int wgid = (int)L; { const int q = nwg / NXCD, r = nwg % NXCD, xcd = wgid % NXCD, off = wgid / NXCD; wgid = (xcd < r ? xcd * (q + 1) : r * (q + 1) + (xcd - r) * q) + off; }
        const int nig = WGM * nN, gid = wgid / nig, fm = gid * WGM, gsz = (nM - fm) < WGM ? (nM - fm) : WGM;
        u.pm = fm + ((wgid % nig) % gsz); u.pn = (wgid % nig) / gsz; u.eb = 0; u.ko = 0; return true;
    }
    __device__ __forceinline__ void a_ready(const Unit&) const {}
    __device__ __forceinline__ void done(const Unit&) const {}
};


__device__ __forceinline__ unsigned cvt_pk_bf16(float lo, float hi) { unsigned r; asm volatile("v_cvt_pk_bf16_f32 %0, %1, %2" : "=v"(r) : "v"(lo), "v"(hi)); return r; }
typedef unsigned u32x2 __attribute__((ext_vector_type(2)));
__device__ __forceinline__ void row_rs8(const float* ssq, int row0, int fq, float (&rs)[2][4]) {
#pragma unroll
    for (int ai = 0; ai < 2; ++ai)
#pragma unroll
        for (int m = 0; m < 4; ++m) { const f32x4 p = *(const f32x4*)(ssq + (size_t)(row0 + ai * HALF + m * 16) * 16 + 4 * fq);
            float s = (p[0] + p[1]) + (p[2] + p[3]); s = fq_sum(s);
            rs[ai][m] = __builtin_amdgcn_rsqf(s * (1.0f / cfg::D) + cfg::EPS); }
}
struct EpiRope {
    static constexpr bool PERM = true, AFTER_DRAIN = false;
    bf16_t* O; const float* ssq; const float* rope;
    __device__ __forceinline__ void operator()(const f32x4 (&acc)[2][2][4][2], const Unit& u, int wr, int wc, int fr, int fq) const {
        const int row0 = u.pm * BM + wr * 64 + fr;
        float rs[2][4]; row_rs8(ssq, row0, fq, rs);
        const int q8 = (wc & 1) * 4 + 2 * (fq & 1) + (fq >> 1);
        const int cst = (fq >> 1) * 32 + 8 * (2 * (wc & 1) + (fq & 1));
        const bool any_rope = (u.pn < 4) || (u.pn >= 6);
#pragma unroll
        for (int ai = 0; ai < 2; ++ai) {
            f32x4 c01[4], c23[4];
            if (any_rope) {
#pragma unroll
                for (int m = 0; m < 4; ++m) { const int r = row0 + ai * HALF + m * 16; const float* cs = rope + ((size_t)(r & (cfg::S - 1)) * 32 + 4 * q8) * 2;
                    c01[m] = *(const f32x4*)cs; c23[m] = *(const f32x4*)(cs + 4); }
            }
#pragma unroll
            for (int bj = 0; bj < 2; ++bj) {
                const int hb = u.pn * 4 + bj * 2 + (wc >> 1);
                const bool roped = (hb < 16) || (hb >= 24 && hb < 34);
                const bool isq = (hb < 8) || (hb >= 24 && hb < 32);
                const float sc = isq ? cfg::C2 : 1.0f;
#pragma unroll
                for (int m = 0; m < 4; ++m) {
                    const int r = row0 + ai * HALF + m * 16; const float f = rs[ai][m] * sc;
                    f32x4 v0 = acc[ai][bj][m][0] * f, v1 = acc[ai][bj][m][1] * f;
                    if (roped) {
                        const f32x4 co = {c01[m][0], c01[m][2], c23[m][0], c23[m][2]}, si = {c01[m][1], c01[m][3], c23[m][1], c23[m][3]};
                        const f32x4 o0 = v0 * co - v1 * si, o1 = v1 * co + v0 * si; v0 = o0; v1 = o1;
                    }
                    float a0 = __builtin_bit_cast(float, cvt_pk_bf16(v0[0], v0[1])), a1 = __builtin_bit_cast(float, cvt_pk_bf16(v0[2], v0[3]));
                    float b0 = __builtin_bit_cast(float, cvt_pk_bf16(v1[0], v1[1])), b1 = __builtin_bit_cast(float, cvt_pk_bf16(v1[2], v1[3]));
                    pl32_swap(a0, b0); pl32_swap(a1, b1);
                    u32x4 w; w.x = __builtin_bit_cast(unsigned, a0); w.y = __builtin_bit_cast(unsigned, a1); w.z = __builtin_bit_cast(unsigned, b0); w.w = __builtin_bit_cast(unsigned, b1);
                    *(u32x4*)(O + (size_t)r * cfg::INW + hb * 64 + cst) = w;
                }
            }
        }
    }
};
struct EpiResid {
    static constexpr bool PERM = true, AFTER_DRAIN = false;
    bf16_t* x; float* ssq;
    __device__ __forceinline__ void operator()(const f32x4 (&acc)[2][2][4][2], const Unit& u, int wr, int wc, int fr, int fq) const {
        const int row0 = u.pm * BM + wr * 64 + fr, col0 = u.pn * BM + wc * 32 + 8 * fq;
#pragma unroll
        for (int ai = 0; ai < 2; ++ai) {
            u32x4 b[4][2];
#pragma unroll
            for (int m = 0; m < 4; ++m) { const bf16_t* p = x + (size_t)(row0 + ai * HALF + m * 16) * cfg::D + col0; b[m][0] = *(const u32x4*)p; b[m][1] = *(const u32x4*)(p + HALF); }
#pragma unroll
            for (int m = 0; m < 4; ++m) { const int r = row0 + ai * HALF + m * 16; bf16_t* p = x + (size_t)r * cfg::D + col0; float s = 0.f;
#pragma unroll
                for (int bj = 0; bj < 2; ++bj) { const u32x4 bb = b[m][bj]; const f32x4 a0 = acc[ai][bj][m][0], a1 = acc[ai][bj][m][1];
                    const float o0 = __builtin_bit_cast(float, bb.x << 16) + a0[0], o1 = __builtin_bit_cast(float, bb.x & 0xffff0000u) + a0[1], o2 = __builtin_bit_cast(float, bb.y << 16) + a0[2], o3 = __builtin_bit_cast(float, bb.y & 0xffff0000u) + a0[3];
                    const float o4 = __builtin_bit_cast(float, bb.z << 16) + a1[0], o5 = __builtin_bit_cast(float, bb.z & 0xffff0000u) + a1[1], o6 = __builtin_bit_cast(float, bb.w << 16) + a1[2], o7 = __builtin_bit_cast(float, bb.w & 0xffff0000u) + a1[3];
                    s += ((o0 * o0 + o1 * o1) + (o2 * o2 + o3 * o3)) + ((o4 * o4 + o5 * o5) + (o6 * o6 + o7 * o7));
                    u32x4 w; w.x = cvt_pk_bf16(o0, o1); w.y = cvt_pk_bf16(o2, o3); w.z = cvt_pk_bf16(o4, o5); w.w = cvt_pk_bf16(o6, o7);
                    *(u32x4*)(p + bj * HALF) = w; }
                s = fq_sum(s);
                if (fq == 0) ssq[(size_t)r * 16 + u.pn * 4 + wc] = s; }
        }
    }
};
__device__ __forceinline__ float silu_mul(float g, float u) { return g * u * __builtin_amdgcn_rcpf(1.0f + __builtin_amdgcn_exp2f(-cfg::LOG2E * g)); }
template <bool RS> struct EpiSwiglu {
    static constexpr bool PERM = true, AFTER_DRAIN = false;
    bf16_t* H; const float* ssq;
    __device__ __forceinline__ void operator()(const f32x4 (&acc)[2][2][4][2], const Unit& u, int wr, int wc, int fr, int fq) const {
        const int row0 = u.pm * BM + wr * 64 + fr, col0 = u.pn * HALF + wc * 32 + 8 * fq;
        float rs[2][4];
        if (RS) row_rs8(ssq, row0, fq, rs);
#pragma unroll
        for (int ai = 0; ai < 2; ++ai)
#pragma unroll
            for (int m = 0; m < 4; ++m) { const int r = row0 + ai * HALF + m * 16; const float f = RS ? rs[ai][m] : 1.0f;
                const f32x4 g0 = acc[ai][0][m][0] * f, g1 = acc[ai][0][m][1] * f, u0 = acc[ai][1][m][0] * f, u1 = acc[ai][1][m][1] * f;
                u32x4 w; w.x = cvt_pk_bf16(silu_mul(g0[0], u0[0]), silu_mul(g0[1], u0[1])); w.y = cvt_pk_bf16(silu_mul(g0[2], u0[2]), silu_mul(g0[3], u0[3]));
                w.z = cvt_pk_bf16(silu_mul(g1[0], u1[0]), silu_mul(g1[1], u1[1])); w.w = cvt_pk_bf16(silu_mul(g1[2], u1[2]), silu_mul(g1[3], u1[3]));
                *(u32x4*)(H + (size_t)r * cfg::FF + col0) = w; }
    }
};
struct EpiY {
    static constexpr bool PERM = true, AFTER_DRAIN = false;
    bf16_t* Y; const float* gate;
    __device__ __forceinline__ void operator()(const f32x4 (&acc)[2][2][4][2], const Unit& u, int wr, int wc, int fr, int fq) const {
        const int row0 = u.pm * BM + wr * 64 + fr, col0 = u.pn * BM + wc * 32 + 8 * fq;
        float gt[2][4];
#pragma unroll
        for (int ai = 0; ai < 2; ++ai)
#pragma unroll
            for (int m = 0; m < 4; ++m) gt[ai][m] = gate[row0 + ai * HALF + m * 16];
#pragma unroll
        for (int ai = 0; ai < 2; ++ai)
#pragma unroll
            for (int m = 0; m < 4; ++m) { const int r = row0 + ai * HALF + m * 16; const float f = gt[ai][m];
#pragma unroll
                for (int bj = 0; bj < 2; ++bj) { const f32x4 v0 = acc[ai][bj][m][0] * f, v1 = acc[ai][bj][m][1] * f;
                    u32x4 w; w.x = cvt_pk_bf16(v0[0], v0[1]); w.y = cvt_pk_bf16(v0[2], v0[3]); w.z = cvt_pk_bf16(v1[0], v1[1]); w.w = cvt_pk_bf16(v1[2], v1[3]);
                    *(u32x4*)(Y + (size_t)r * cfg::D + col0 + bj * HALF) = w; } }
    }
};
struct EpiNull {
    static constexpr bool PERM = true, AFTER_DRAIN = false;
    __device__ __forceinline__ void operator()(const f32x4 (&acc)[2][2][4][2], const Unit& u, int wr, int wc, int fr, int fq) const {
#pragma unroll
        for (int ai = 0; ai < 2; ++ai)
#pragma unroll
            for (int bj = 0; bj < 2; ++bj)
#pragma unroll
                for (int m = 0; m < 4; ++m)
#pragma unroll
                    for (int n = 0; n < 2; ++n) asm volatile("" :: "v"(acc[ai][bj][m][n]));
    }
};
struct EpiRaw {
    static constexpr bool PERM = true, AFTER_DRAIN = false;
    bf16_t* H;
    __device__ __forceinline__ void operator()(const f32x4 (&acc)[2][2][4][2], const Unit& u, int wr, int wc, int fr, int fq) const {
        const int row0 = u.pm * BM + wr * 64 + fr, col0 = u.pn * HALF + wc * 32 + 8 * fq;
#pragma unroll
        for (int ai = 0; ai < 2; ++ai)
#pragma unroll
            for (int m = 0; m < 4; ++m) { const int r = row0 + ai * HALF + m * 16;
                const f32x4 g0 = acc[ai][0][m][0] + acc[ai][1][m][0], g1 = acc[ai][0][m][1] + acc[ai][1][m][1];
                u32x4 w; w.x = cvt_pk_bf16(g0[0], g0[1]); w.y = cvt_pk_bf16(g0[2], g0[3]); w.z = cvt_pk_bf16(g1[0], g1[1]); w.w = cvt_pk_bf16(g1[2], g1[3]);
                *(u32x4*)(H + (size_t)r * cfg::FF + col0) = w; }
    }
};
struct GroupedOrder : StaticOrder {
    const PG8_LAS int* segb;
    __device__ __forceinline__ bool next(int i, Unit& u) const {
        if (!StaticOrder::next(i, u)) return false;
        const int r = u.pm * BM; int e = 0;
#pragma unroll
        for (int k = 1; k < 8; ++k) e += (r >= segb[k]) ? 1 : 0;
        u.eb = e; return true;
    }
};

struct TailOrder {
    int npair, G, c; const PG8_LAS int* segb;
    __device__ __forceinline__ bool next(int i, Unit& u) const {
        const int L = i * G + c; if (L >= npair * cfg::KSPLIT) return false;
        const int q = L / cfg::KSPLIT, s = L % cfg::KSPLIT; u.pm = cfg::MAINROWS / BM + (q >> 2); u.pn = q & 3; u.ko = s * (cfg::FF / cfg::KSPLIT);
        const int r = u.pm * BM; int e = 0;
#pragma unroll
        for (int k = 1; k < 8; ++k) e += (r >= segb[k]) ? 1 : 0;
        u.eb = e; return true;
    }
    __device__ __forceinline__ void a_ready(const Unit&) const {}
    __device__ __forceinline__ void done(const Unit&) const {}
};
struct EpiPart {
    static constexpr bool PERM = true, AFTER_DRAIN = false;
    bf16_t* PT;
    __device__ __forceinline__ void operator()(const f32x4 (&acc)[2][2][4][2], const Unit& u, int wr, int wc, int fr, int fq) const {
        const int row0 = u.pm * BM - cfg::MAINROWS + wr * 64 + fr, col0 = u.pn * BM + wc * 32 + 8 * fq, s = u.ko / (cfg::FF / cfg::KSPLIT);
        bf16_t* base = PT + (size_t)s * cfg::TAILROWS * cfg::D;
#pragma unroll
        for (int ai = 0; ai < 2; ++ai)
#pragma unroll
            for (int m = 0; m < 4; ++m) { const int r = row0 + ai * HALF + m * 16;
#pragma unroll
                for (int bj = 0; bj < 2; ++bj) { const f32x4 v0 = acc[ai][bj][m][0], v1 = acc[ai][bj][m][1];
                    u32x4 w; w.x = cvt_pk_bf16(v0[0], v0[1]); w.y = cvt_pk_bf16(v0[2], v0[3]); w.z = cvt_pk_bf16(v1[0], v1[1]); w.w = cvt_pk_bf16(v1[2], v1[3]);
                    *(u32x4*)(base + (size_t)r * cfg::D + col0 + bj * HALF) = w; } }
    }
};

template <class Epi, class Sched, bool ALIGN_EPI = false, bool SP2 = false>
__device__ __forceinline__ void gemm_phase(PG8_LAS unsigned char* lds, const Gemm g, const Sched& S, const Epi& E, const int tid_in) {
    const int tid = tid_in, wid = __builtin_amdgcn_readfirstlane(tid >> 6), lane = tid & 63, wr = wid >> 2, wc = wid & 3, fr = lane & 15, fq = lane >> 4;
    const int K = g.K, nt = K / BK, LD = g.ld;
    unsigned voffA[2], voffB[2];
#pragma unroll
    for (int i = 0; i < 2; ++i) { int R, C; stage_rc(tid * 16 + i * 8192, R, C); const int Rb = Epi::PERM ? ((R & ~31) + perm32(R & 31)) : R;
        voffA[i] = (unsigned)(R * LD + C) * 2u; voffB[i] = (unsigned)(Rb * LD + C) * 2u; }
    const size_t kstep = (size_t)(BK * 2);
    const size_t hstep = (size_t)HALF * LD * 2;
    const size_t tstep = 2 * hstep;
    const unsigned ldsw = (unsigned)wid * 1024u;
    const int aoff = lds_byte(wr * 64 + fr, fq * 8), boff = lds_byte(wc * 32 + fr, fq * 8);
#define PG8_SA(b, h) (((b) * 2 + (h)) * HTB)
#define PG8_SB(b, h) ((4 + (b) * 2 + (h)) * HTB)
#define PG8_STAGE(bufoff, gbase, voff) do { _Pragma("unroll") for (int _i = 0; _i < 2; ++_i) \
        __builtin_amdgcn_global_load_lds((const unsigned*)((const char*)(gbase) + (voff)[_i]), (PG8_LAS unsigned*)(lds + (bufoff) + ldsw + _i * 8192), 16, 0, 0); } while (0)
#define PG8_LDA(dst, b, h) do { _Pragma("unroll") for (int m = 0; m < 4; ++m) _Pragma("unroll") for (int k = 0; k < 2; ++k) dst[m][k] = *(const PG8_LAS bf16x8*)(lds + PG8_SA(b, h) + aoff + m * 2048 + k * 1024); } while (0)
#define PG8_LDB(dst, b, h) do { _Pragma("unroll") for (int n = 0; n < 2; ++n) _Pragma("unroll") for (int k = 0; k < 2; ++k) dst[n][k] = *(const PG8_LAS bf16x8*)(lds + PG8_SB(b, h) + boff + n * 2048 + k * 1024); } while (0)
#define PG8_MMA(ai, bj, At, Bt) do { __builtin_amdgcn_s_setprio(1); _Pragma("unroll") for (int m = 0; m < 4; ++m) _Pragma("unroll") for (int n = 0; n < 2; ++n) _Pragma("unroll") for (int k = 0; k < 2; ++k) \
        acc[ai][bj][m][n] = __builtin_amdgcn_mfma_f32_16x16x32_bf16(Bt[n][k], At[m][k], acc[ai][bj][m][n], 0, 0, 0); __builtin_amdgcn_s_setprio(0); } while (0)
#define PG8_WAIT_V(n) asm volatile("s_waitcnt vmcnt(" #n ")" ::: "memory")
#define PG8_WAIT_L(n) asm volatile("s_waitcnt lgkmcnt(" #n ")" ::: "memory")
#define PG8_BAR __builtin_amdgcn_s_barrier()
#define PG8_SCHED __builtin_amdgcn_sched_barrier(0)
    Unit cur, nxt; int ui = 0;
    if (!S.next(0, cur)) return;
    f32x4 acc[2][2][4][2];
#pragma unroll
    for (int a = 0; a < 2; ++a)
#pragma unroll
        for (int b = 0; b < 2; ++b)
#pragma unroll
            for (int m = 0; m < 4; ++m)
#pragma unroll
                for (int n = 0; n < 2; ++n) acc[a][b][m][n] = (f32x4){0.f, 0.f, 0.f, 0.f};
    bf16x8 At[4][2], B0[2][2], B1[2][2];
    const char* cA = (const char*)g.A + (size_t)cur.pm * tstep + (size_t)cur.ko * 2; const char* cB = (const char*)g.Bt + (size_t)cur.eb * g.bstride + (size_t)cur.pn * tstep + (size_t)cur.ko * 2;
    S.a_ready(cur);
    if constexpr (SP2) {
        PG8_STAGE(PG8_SB(0, 0), cB, voffB); PG8_STAGE(PG8_SB(0, 1), cB + hstep, voffB); PG8_STAGE(PG8_SA(0, 0), cA, voffA); PG8_STAGE(PG8_SA(0, 1), cA + hstep, voffA);
        if (wr == 1) PG8_BAR;
        PG8_WAIT_V(2); PG8_BAR;
        PG8_STAGE(PG8_SB(1, 0), cB + kstep, voffB); PG8_STAGE(PG8_SA(1, 0), cA + kstep, voffA); PG8_STAGE(PG8_SB(1, 1), cB + hstep + kstep, voffB);
        PG8_WAIT_V(6); PG8_BAR;
    } else {
        PG8_STAGE(PG8_SB(0, 0), cB, voffB); PG8_STAGE(PG8_SA(0, 0), cA, voffA); PG8_STAGE(PG8_SB(0, 1), cB + hstep, voffB); PG8_STAGE(PG8_SA(0, 1), cA + hstep, voffA);
        if (wr == 1) PG8_BAR;
        PG8_WAIT_V(4); PG8_BAR;
        PG8_STAGE(PG8_SB(1, 0), cB + kstep, voffB); PG8_STAGE(PG8_SA(1, 0), cA + kstep, voffA); PG8_STAGE(PG8_SB(1, 1), cB + hstep + kstep, voffB);
        PG8_WAIT_V(6); PG8_BAR;
    }
    for (;;) {
        const bool has_next = S.next(ui + 1, nxt);
        const char* nA = has_next ? (const char*)g.A + (size_t)nxt.pm * tstep + (size_t)nxt.ko * 2 : cA; const char* nB = has_next ? (const char*)g.Bt + (size_t)nxt.eb * g.bstride + (size_t)nxt.pn * tstep + (size_t)nxt.ko * 2 : cB;
        for (int t = 0; t < nt; t += 2) {
            const bool last = (t == nt - 2);
            const char* a1 = cA + (size_t)(t + 1) * kstep;
            const char* a2 = last ? nA : cA + (size_t)(t + 2) * kstep; const char* b2 = last ? nB : cB + (size_t)(t + 2) * kstep;
            const char* a3 = a2 + kstep; const char* b3 = b2 + kstep;
            if (last && has_next) S.a_ready(nxt);
            if constexpr (SP2) {
            PG8_LDB(B0, 0, 0); PG8_LDB(B1, 0, 1); PG8_SCHED; PG8_LDA(At, 0, 0); PG8_STAGE(PG8_SA(1, 1), a1 + hstep, voffA);
            PG8_WAIT_V(8); PG8_WAIT_L(0); PG8_BAR; PG8_MMA(0, 0, At, B0); PG8_MMA(0, 1, At, B1); PG8_BAR; PG8_SCHED;
            PG8_LDA(At, 0, 1); PG8_STAGE(PG8_SB(0, 0), b2, voffB); PG8_STAGE(PG8_SB(0, 1), b2 + hstep, voffB); PG8_STAGE(PG8_SA(0, 0), a2, voffA);
            PG8_WAIT_V(8); PG8_WAIT_L(0); PG8_BAR; PG8_MMA(1, 0, At, B0); PG8_MMA(1, 1, At, B1); PG8_BAR; PG8_SCHED;
            PG8_LDB(B0, 1, 0); PG8_LDB(B1, 1, 1); PG8_SCHED; PG8_LDA(At, 1, 0); PG8_STAGE(PG8_SA(0, 1), a2 + hstep, voffA);
            PG8_WAIT_V(8); PG8_WAIT_L(0); PG8_BAR; PG8_MMA(0, 0, At, B0); PG8_MMA(0, 1, At, B1); PG8_BAR; PG8_SCHED;
            PG8_LDA(At, 1, 1); PG8_STAGE(PG8_SB(1, 0), b3, voffB); PG8_STAGE(PG8_SB(1, 1), b3 + hstep, voffB); PG8_STAGE(PG8_SA(1, 0), a3, voffA);
            PG8_WAIT_V(8); PG8_WAIT_L(0); PG8_BAR; PG8_MMA(1, 0, At, B0); PG8_MMA(1, 1, At, B1); PG8_BAR; PG8_SCHED;
            } else {
            PG8_LDB(B0, 0, 0); PG8_SCHED; PG8_LDA(At, 0, 0); PG8_STAGE(PG8_SA(1, 1), a1 + hstep, voffA);
            PG8_WAIT_L(8); PG8_BAR; PG8_WAIT_L(0); PG8_MMA(0, 0, At, B0); PG8_BAR; PG8_SCHED;
            PG8_LDB(B1, 0, 1); PG8_STAGE(PG8_SB(0, 0), b2, voffB);
            PG8_BAR; PG8_WAIT_L(0); PG8_MMA(0, 1, At, B1); PG8_BAR;
            PG8_LDA(At, 0, 1); PG8_STAGE(PG8_SA(0, 0), a2, voffA);
            PG8_BAR; PG8_WAIT_L(0); PG8_MMA(1, 0, At, B0); PG8_BAR; PG8_SCHED;
            PG8_STAGE(PG8_SB(0, 1), b2 + hstep, voffB);
            PG8_WAIT_V(6); PG8_BAR; PG8_MMA(1, 1, At, B1); PG8_BAR;
            PG8_LDB(B0, 1, 0); PG8_SCHED; PG8_LDA(At, 1, 0); PG8_STAGE(PG8_SA(0, 1), a2 + hstep, voffA);
            PG8_WAIT_L(8); PG8_BAR; PG8_WAIT_L(0); PG8_MMA(0, 0, At, B0); PG8_BAR; PG8_SCHED;
            PG8_LDB(B1, 1, 1); PG8_STAGE(PG8_SB(1, 0), b3, voffB);
            PG8_BAR; PG8_WAIT_L(0); PG8_MMA(0, 1, At, B1); PG8_BAR;
            PG8_LDA(At, 1, 1); PG8_STAGE(PG8_SA(1, 0), a3, voffA);
            PG8_BAR; PG8_WAIT_L(0); PG8_MMA(1, 0, At, B0); PG8_BAR; PG8_SCHED;
            PG8_STAGE(PG8_SB(1, 1), b3 + hstep, voffB);
            PG8_WAIT_V(6); PG8_BAR; PG8_MMA(1, 1, At, B1); PG8_BAR;
            }
        }
        if constexpr (ALIGN_EPI) { if (wr == 0) PG8_BAR; }
        if constexpr (!Epi::AFTER_DRAIN) { E(acc, cur, wr, wc, fr, fq); S.done(cur); }
        if (!has_next) break;
#pragma unroll
        for (int a = 0; a < 2; ++a)
#pragma unroll
            for (int b = 0; b < 2; ++b)
#pragma unroll
                for (int m = 0; m < 4; ++m)
#pragma unroll
                    for (int n = 0; n < 2; ++n) acc[a][b][m][n] = (f32x4){0.f, 0.f, 0.f, 0.f};
        cur = nxt; cA = nA; cB = nB; ++ui;
        if constexpr (ALIGN_EPI) { if (wr == 1) PG8_BAR; }
    }
    PG8_WAIT_V(0);
    if constexpr (!ALIGN_EPI) { if (wr == 0) PG8_BAR; }
    PG8_BAR;
    if constexpr (Epi::AFTER_DRAIN) { E.fused(acc, cur, wr, wc, fr, fq, lds, wid, lane); S.done(cur); }
#undef PG8_SA
#undef PG8_SB
#undef PG8_STAGE
#undef PG8_LDA
#undef PG8_LDB
#undef PG8_MMA
#undef PG8_WAIT_V
#undef PG8_WAIT_L
#undef PG8_BAR
#undef PG8_SCHED
}
}


using namespace cfg;
constexpr size_t MiB = 1u << 20;
constexpr size_t WS_CTL = 0, CTL_ZERO_BYTES = 1 * MiB;
constexpr size_t WS_ROPE = 1 * MiB;
constexpr size_t WS_SSQA = 3 * MiB;
constexpr size_t WS_SSQF = 5 * MiB;
constexpr size_t WS_ROUTE = 7 * MiB;
constexpr size_t WS_BLKCNT = 8 * MiB;
constexpr size_t WS_ROWGATE = 9 * MiB;
constexpr size_t WS_WIN = 16 * MiB;
constexpr size_t WS_WOUT = 34 * MiB;
constexpr size_t WS_WGU = 42 * MiB;
constexpr size_t WS_WDN = 70 * MiB;
constexpr size_t WS_MGU = 84 * MiB;
constexpr size_t WS_MDN = 196 * MiB;
constexpr size_t WS_XN = 252 * MiB;
constexpr size_t WS_PROJ = 316 * MiB;
constexpr size_t WS_OPART = 460 * MiB;
constexpr size_t WS_LSE = 588 * MiB;
constexpr size_t WS_MIX = 592 * MiB;
constexpr size_t WS_H = 316 * MiB;
constexpr size_t WS_AP = 778 * MiB;
constexpr size_t WS_PT = 910 * MiB;
constexpr size_t WS_END = WS_PT + (size_t)KSPLIT * TAILROWS * D * 2;
static_assert(WS_H + (size_t)MAXROWS * FF * 2 <= WS_AP && WS_AP + (size_t)MAXROWS * D * 2 <= WS_END && WS_MIX + (size_t)M * D * 2 <= WS_AP, "d_ws map");
static_assert(WS_ROWGATE + (size_t)MAXROWS * 4 <= WS_WIN && WS_LSE + (size_t)3 * M * 8 * 4 <= WS_MIX, "d_ws map 2");
constexpr int CW_BAR = 4096;
constexpr int LDS_BYTES = 147456;
constexpr int RING_OFF = 0, RING_BYTES = 131072;
constexpr int LDSCTL_OFF = LDS_BYTES - 1024, MISC_OFF = LDSCTL_OFF + 320;
constexpr int NWAVES = 8;

#define GAS __attribute__((address_space(1)))
#define LAS __attribute__((address_space(3)))
typedef unsigned short bf16;
typedef unsigned v4u __attribute__((ext_vector_type(4)));
typedef float f32x4 __attribute__((ext_vector_type(4)));
typedef short bf16x8 __attribute__((ext_vector_type(8)));
typedef GAS unsigned gu32;
typedef GAS unsigned long long gu64;
#define RLX_AGENT __ATOMIC_RELAXED, __HIP_MEMORY_SCOPE_AGENT
#define LDS_WAIT() asm volatile("s_waitcnt lgkmcnt(0)" ::: "memory")
#define VM_WAIT() asm volatile("s_waitcnt vmcnt(0)" ::: "memory")
__device__ __forceinline__ unsigned long long rt() { return __builtin_amdgcn_s_memrealtime(); }
__device__ __forceinline__ unsigned f2bf(float f) { unsigned u = __builtin_bit_cast(unsigned, f); return (u + 0x7fffu + ((u >> 16) & 1u)) >> 16; }
__device__ __forceinline__ unsigned pk2(float lo, float hi) { return f2bf(lo) | (f2bf(hi) << 16); }

#define XB_TMO      128
#define XB_XCNT(j)  (256  + 64 * (j))
#define XB_XSUB(j)  (1280 + 64 * (j))
#define XB_XGEN(j)  (2304 + 64 * (j))
#define XB_TOP      3328
#define XB_TOPGEN   3392
#define XCD_BAR_WORDS 3456
#define XB_SPIN_CAP (1u << 18)

__device__ __forceinline__ unsigned xb_ld(unsigned* p)              { return __hip_atomic_load(p, __ATOMIC_RELAXED, __HIP_MEMORY_SCOPE_AGENT); }
__device__ __forceinline__ unsigned xb_add(unsigned* p, unsigned v) { return __hip_atomic_fetch_add(p, v, __ATOMIC_RELAXED, __HIP_MEMORY_SCOPE_AGENT); }
__device__ __forceinline__ unsigned xb_xcc_id() { return (unsigned)__builtin_amdgcn_s_getreg((3 << 11) | 20) & 0xFu; }
#define XB_SPIN(cond, bar) do { unsigned _sp = 0; while (cond) { __builtin_amdgcn_s_sleep(1); \
    if ((++_sp & 255u) == 0u) { if (xb_ld(&(bar)[XB_TMO])) break; if (_sp > XB_SPIN_CAP) { atomicAdd(&(bar)[XB_TMO], 1u); break; } } } } while (0)

struct XcdBarrier {
    unsigned* bar; unsigned x;
    volatile LAS unsigned* st;
};

__device__ __forceinline__ XcdBarrier xcd_barrier_post(unsigned* bar, volatile LAS unsigned* st, const int tidx) {
    XcdBarrier b; b.bar = bar; b.x = xb_xcc_id(); b.st = st;
    if (tidx == 0) (void)xb_add(&bar[XB_XCNT(b.x)], 1u);
    return b;
}
__device__ __forceinline__ void xcd_barrier_complete(unsigned* bar, unsigned x, unsigned& nloc, unsigned& nx) {
    const unsigned G = gridDim.x * gridDim.y * gridDim.z;
    unsigned sum, cnt, mine, sp = 0u;
    for (;;) {
        sum = 0u; cnt = 0u; mine = 0u;
#pragma unroll
        for (unsigned j = 0; j < 16; ++j) { const unsigned c = xb_ld(&bar[XB_XCNT(j)]); sum += c; cnt += (c > 0u) ? 1u : 0u; mine = (j == x) ? c : mine; }
        if (sum == G) break;
        __builtin_amdgcn_s_sleep(1);
        if ((++sp & 255u) == 0u) { if (xb_ld(&bar[XB_TMO])) break; if (sp > XB_SPIN_CAP) { atomicAdd(&bar[XB_TMO], 1u); break; } }
    }
    nloc = mine > 0u ? mine : 1u; nx = cnt > 0u ? cnt : 1u;
}

__device__ __forceinline__ void xcd_barrier(const XcdBarrier& b, const int tidx) {
    asm volatile("s_waitcnt vmcnt(0)" ::: "memory");
    __syncthreads();
    if (tidx == 0) {
        unsigned* bar = b.bar;
        __builtin_amdgcn_s_waitcnt(0);
        unsigned nloc = b.st[0], nx = b.st[1];
        if (nloc == 0u) { xcd_barrier_complete(bar, b.x, nloc, nx); b.st[0] = nloc; b.st[1] = nx; }
        const unsigned old = xb_add(&bar[XB_XSUB(b.x)], 1u);
        const unsigned gen = old / nloc;
        if (old + 1u == (gen + 1u) * nloc) {
            __builtin_amdgcn_fence(__ATOMIC_RELEASE, "agent");
            asm volatile("s_waitcnt vmcnt(0)" ::: "memory");
            const unsigned og = xb_add(&bar[XB_TOP], 1u);
            const unsigned tg = og / nx;
            if (og + 1u == (tg + 1u) * nx) xb_add(&bar[XB_TOPGEN], 1u);
            else XB_SPIN(xb_ld(&bar[XB_TOPGEN]) == tg, bar);
            __builtin_amdgcn_fence(__ATOMIC_ACQUIRE, "agent");
            xb_add(&bar[XB_XGEN(b.x)], 1u);
            asm volatile("s_waitcnt vmcnt(0)" ::: "memory");
        } else {
            XB_SPIN(xb_ld(&bar[XB_XGEN(b.x)]) == gen, bar);
            __builtin_amdgcn_fence(__ATOMIC_ACQUIRE, "agent");
            asm volatile("s_waitcnt vmcnt(0)" ::: "memory");
        }
    }
    __syncthreads();
}


__device__ __forceinline__ float wave_sum(float v) {
    v += swz_xor<1>(v); v += swz_xor<2>(v); v += swz_xor<4>(v); v += swz_xor<8>(v); v += swz_xor<16>(v);
    return xor32_sum(v);
}
__device__ __forceinline__ int wave_sum_i(int v) {
    return (int)(wave_sum((float)v) + 0.5f);
}
__device__ __forceinline__ float bf2f(unsigned short b) { return __builtin_bit_cast(float, (unsigned)b << 16); }
__device__ __forceinline__ float bflo(unsigned w) { return __builtin_bit_cast(float, w << 16); }
__device__ __forceinline__ float bfhi(unsigned w) { return __builtin_bit_cast(float, w & 0xffff0000u); }
typedef unsigned u32x2v __attribute__((ext_vector_type(2)));

struct Ctx { LAS unsigned char* lds; int tid, lane, wave, gw, ngw; };

__device__ __forceinline__ int rowmap(int mode, int n) {
    if (mode == 1) { const int hb = n >> 6, w = n & 63, nn = w >> 5, i = w & 31, gi = i >> 2, fq = ((gi & 1) << 1) | ((gi >> 1) & 1);
        return (hb << 6) + 32 * (gi >> 2) + 8 * fq + 4 * nn + (i & 3); }
    if (mode == 2) return 256 * (n >> 7) + (n & 127);
    if (mode == 3) return 256 * (n >> 7) + 128 + (n & 127);
    return n;
}
struct ConvJob { const float* W; bf16* WT; const float* gain; int K, N, mode, item; };
__device__ __forceinline__ void tr_load(const ConvJob& J, int lane, f32x4 (&v)[8]) {
    const int nblk = J.N / 32, kb = J.item / nblk, nb = J.item % nblk, k0 = 64 * kb, n0 = 32 * nb, lr = lane >> 3, lc = lane & 7;
#pragma unroll
    for (int i = 0; i < 8; ++i) v[i] = *(const GAS f32x4*)(J.W + (size_t)(k0 + 8 * i + lr) * J.N + n0 + 4 * lc);
    if (J.gain) {
#pragma unroll
        for (int i = 0; i < 8; ++i) v[i] = v[i] * J.gain[k0 + 8 * i + lr];
    }
}
__device__ __forceinline__ void tr_store(const ConvJob& J, int lane, LAS float* scr, const f32x4 (&v)[8]) {
    const int nblk = J.N / 32, kb = J.item / nblk, nb = J.item % nblk, k0 = 64 * kb, n0 = 32 * nb, lr = lane >> 3, lc = lane & 7;
#pragma unroll
    for (int i = 0; i < 8; ++i) { LAS float* d = scr + (8 * i + lr) * 33 + 4 * lc; d[0] = v[i][0]; d[1] = v[i][1]; d[2] = v[i][2]; d[3] = v[i][3]; }
    LDS_WAIT(); asm volatile("" ::: "memory");
    const int c = lane & 7;
#pragma unroll
    for (int j = 0; j < 4; ++j) { const int n = (lane >> 3) + 8 * j; const LAS float* s = scr + (8 * c) * 33 + n;
        v4u o; o.x = pk2(s[0 * 33], s[1 * 33]); o.y = pk2(s[2 * 33], s[3 * 33]); o.z = pk2(s[4 * 33], s[5 * 33]); o.w = pk2(s[6 * 33], s[7 * 33]);
        *(GAS v4u*)(J.WT + (size_t)rowmap(J.mode, n0 + n) * J.K + k0 + 8 * c) = o; }
    LDS_WAIT(); asm volatile("" ::: "memory");
}
constexpr int IT_FF = (D / 64) * (FF / 32), IT_IN = (D / 64) * (INW / 32), IT_OUT = (D / 64) * (D / 32);
static_assert((FF / 64) * (D / 32) == IT_FF, "items");
constexpr int MOE_ITEMS = NE * 3 * IT_FF, PRO_ITEMS = DEPTH * (IT_IN + IT_OUT) + 6 * IT_FF;
struct ConvSrc { const float *w_in, *w_out, *attn_norm, *ffn_norm, *dwg, *dwu, *dwd; bf16 *WIN_, *WOUT_, *WGU_, *WDN_; };
__device__ __forceinline__ ConvJob conv_decode_moe(int f, const float* wg, const float* wu, const float* wd, bf16* MGU_, bf16* MDN_) {
    const int job = f / IT_FF, e = job / 3, which = job % 3; ConvJob J; J.item = f % IT_FF; J.gain = nullptr;
    if (which == 2) { J.W = wd + (size_t)e * FF * D; J.WT = MDN_ + (size_t)e * D * FF; J.K = FF; J.N = D; J.mode = 0; }
    else { J.W = (which ? wu : wg) + (size_t)e * D * FF; J.WT = MGU_ + (size_t)e * 2 * FF * D; J.K = D; J.N = FF; J.mode = 2 + which; }
    return J;
}
__device__ __forceinline__ ConvJob conv_decode_pro(int f, const ConvSrc& S) {
    ConvJob J;
    if (f < DEPTH * IT_IN) { const int l = f / IT_IN; J.item = f % IT_IN; J.W = S.w_in + (size_t)l * D * INW; J.WT = S.WIN_ + (size_t)l * INW * D; J.gain = S.attn_norm + l * D; J.K = D; J.N = INW; J.mode = 1; return J; }
    f -= DEPTH * IT_IN;
    if (f < DEPTH * IT_OUT) { const int l = f / IT_OUT; J.item = f % IT_OUT; J.W = S.w_out + (size_t)l * D * D; J.WT = S.WOUT_ + (size_t)l * D * D; J.gain = nullptr; J.K = D; J.N = D; J.mode = 0; return J; }
    f -= DEPTH * IT_OUT;
    const int job = f / IT_FF, j = job / 3, which = job % 3; J.item = f % IT_FF;
    if (which == 2) { J.W = S.dwd + (size_t)j * FF * D; J.WT = S.WDN_ + (size_t)j * D * FF; J.gain = nullptr; J.K = FF; J.N = D; J.mode = 0; }
    else { J.W = (which ? S.dwu : S.dwg) + (size_t)j * D * FF; J.WT = S.WGU_ + (size_t)j * 2 * FF * D; J.gain = S.ffn_norm + (2 * j) * D; J.K = D; J.N = FF; J.mode = 2 + which; }
    return J;
}
#define CONV_LOOP(total, DECODE) do { LAS float* scr_ = (LAS float*)(C.lds + RING_OFF + C.wave * 17408); \
    for (int f_ = C.gw; f_ < (total); f_ += 2 * C.ngw) { f32x4 va_[8], vb_[8]; const bool two_ = f_ + C.ngw < (total); \
        const ConvJob Ja_ = DECODE(f_); tr_load(Ja_, C.lane, va_); \
        ConvJob Jb_ = Ja_; if (two_) { Jb_ = DECODE(f_ + C.ngw); tr_load(Jb_, C.lane, vb_); } \
        tr_store(Ja_, C.lane, scr_, va_); if (two_) tr_store(Jb_, C.lane, scr_ + 2176, vb_); } } while (0)
__device__ __forceinline__ void convert_moe_layer(const Ctx& C, const float* wg, const float* wu, const float* wd, bf16* MGU_, bf16* MDN_) {
#define DEC_MOE(f) conv_decode_moe((f), wg, wu, wd, MGU_, MDN_)
    CONV_LOOP(MOE_ITEMS, DEC_MOE);
#undef DEC_MOE
}
__device__ __forceinline__ void convert_prologue(const Ctx& C, const ConvSrc& S) {
#define DEC_PRO(f) conv_decode_pro((f), S)
    CONV_LOOP(PRO_ITEMS, DEC_PRO);
#undef DEC_PRO
}

__device__ __forceinline__ void ld16bf(const bf16* p, float (&v)[16]) {
    const v4u a = *(const GAS v4u*)p, b = *(const GAS v4u*)(p + 8);
    v[0] = bflo(a.x); v[1] = bfhi(a.x); v[2] = bflo(a.y); v[3] = bfhi(a.y); v[4] = bflo(a.z); v[5] = bfhi(a.z); v[6] = bflo(a.w); v[7] = bfhi(a.w);
    v[8] = bflo(b.x); v[9] = bfhi(b.x); v[10] = bflo(b.y); v[11] = bfhi(b.y); v[12] = bflo(b.z); v[13] = bfhi(b.z); v[14] = bflo(b.w); v[15] = bfhi(b.w);
}
__device__ __forceinline__ void st16bf(bf16* p, const float (&v)[16], float f) {
    v4u a, b; a.x = pk2(v[0] * f, v[1] * f); a.y = pk2(v[2] * f, v[3] * f); a.z = pk2(v[4] * f, v[5] * f); a.w = pk2(v[6] * f, v[7] * f);
    b.x = pk2(v[8] * f, v[9] * f); b.y = pk2(v[10] * f, v[11] * f); b.z = pk2(v[12] * f, v[13] * f); b.w = pk2(v[14] * f, v[15] * f);
    *(GAS v4u*)p = a; *(GAS v4u*)(p + 8) = b;
}
__device__ __forceinline__ void attn_run(const bf16* PROJ, int rowb, int t, int d, int nk, int kcol, int vcol, const float (&q)[16], float (&o)[16], float& mx, float& l) {
    for (int k = 0; k < nk; ++k) {
        const int j = t - d * k; if (j < 0) break;
        const bf16* kr = PROJ + (size_t)(rowb + j) * INW;
        float kv[16]; ld16bf(kr + kcol, kv);
        float s = 0.f;
#pragma unroll
        for (int i = 0; i < 16; ++i) s += q[i] * kv[i];
        s += swz_xor<1>(s); s += swz_xor<2>(s);
        if (s > mx) { const float sc = __builtin_amdgcn_exp2f(mx - s); l *= sc;
#pragma unroll
            for (int i = 0; i < 16; ++i) o[i] *= sc;
            mx = s; }
        const float p = __builtin_amdgcn_exp2f(s - mx); l += p;
        float vv[16]; ld16bf(kr + vcol, vv);
#pragma unroll
        for (int i = 0; i < 16; ++i) o[i] += p * vv[i];
    }
}
__device__ __forceinline__ void attn_naive(const Ctx& C, const bf16* PROJ, bf16* OPART, float* LSE, const float* sinks) {
    const int grp = (blockIdx.x * 512 + C.tid) >> 2, sub = C.tid & 3, ngrp = gridDim.x * 128;
    for (int it = grp; it < M * 16; it += ngrp) {
        const int hh = it / M, row = it % M, t = row & (S - 1), rowb = row - t;
        if (hh < 8) {
            float q[16]; ld16bf(PROJ + (size_t)row * INW + QA_OFF + hh * 64 + sub * 16, q);
#pragma unroll 1
            for (int br = 0; br < 3; ++br) {
                const int d = (br == 0) ? 1 : (br == 1) ? 4 : 16;
                float o[16]; float mx = -INFINITY, l = 0.f;
#pragma unroll
                for (int i = 0; i < 16; ++i) o[i] = 0.f;
                attn_run(PROJ, rowb, t, d, 129, KA_OFF + hh * 64 + sub * 16, VA_OFF + hh * 64 + sub * 16, q, o, mx, l);
                st16bf(OPART + ((size_t)br * M + row) * 512 + hh * 64 + sub * 16, o, 1.0f / l);
                if (sub == 0) LSE[((size_t)br * M + row) * 8 + hh] = mx + __builtin_amdgcn_logf(l);
            }
        } else {
            const int hq = hh - 8, kvh = hq >> 2;
            float q[16]; ld16bf(PROJ + (size_t)row * INW + QB_OFF + hq * 64 + sub * 16, q);
            float o[16]; float mx = -INFINITY, l = 0.f;
#pragma unroll
            for (int i = 0; i < 16; ++i) o[i] = 0.f;
            attn_run(PROJ, rowb, t, 1, 128, KB_OFF + kvh * 64 + sub * 16, VB_OFF + kvh * 64 + sub * 16, q, o, mx, l);
            const float sk = sinks[hq] * LOG2E, m2 = fmaxf(mx, sk), sc = __builtin_amdgcn_exp2f(mx - m2);
            l = l * sc + __builtin_amdgcn_exp2f(sk - m2);
            st16bf(OPART + ((size_t)3 * M + row) * 512 + hq * 64 + sub * 16, o, sc / l);
        }
    }
}


namespace att {
typedef short bf16x8 __attribute__((ext_vector_type(8)));
typedef short s16x4 __attribute__((ext_vector_type(4)));
typedef float f32x16 __attribute__((ext_vector_type(16)));
typedef unsigned u32x4 __attribute__((ext_vector_type(4)));
constexpr int LK = 0, LV = 49152, LWS = 98304, LOST = 100352, LEND = 133120;
static_assert(LEND <= LDSCTL_OFF, "attention LDS");
__device__ __forceinline__ int crow(int r, int hi) { return (r & 3) + 8 * (r >> 2) + 4 * hi; }
__device__ __forceinline__ void glds16(const void* gsrc, unsigned lds_dst) { unsigned keep;
    asm volatile("s_mov_b32 %0, m0\n\ts_mov_b32 m0, %2\n\ts_nop 0\n\tglobal_load_lds_dwordx4 %1, off\n\ts_mov_b32 m0, %0" : "=&s"(keep) : "v"(gsrc), "s"(lds_dst) : "memory"); }
__device__ __forceinline__ unsigned cvtpk(float lo, float hi) { unsigned r; asm("v_cvt_pk_bf16_f32 %0, %1, %2" : "=v"(r) : "v"(lo), "v"(hi)); return r; }
__device__ __forceinline__ float xhalf_max(float m) { return xor32_max(m); }
__device__ __forceinline__ float xhalf_sum(float m) { return xor32_sum(m); }
__device__ __forceinline__ f32x16 qk32(const LAS unsigned char* ktile, int half, const bf16x8 (&qr)[4], int r32, int hi) {
    const LAS unsigned char* kb = ktile + hi * 1024 + r32 * 16 + half * 512;
    f32x16 p = {0.f, 0.f, 0.f, 0.f, 0.f, 0.f, 0.f, 0.f, 0.f, 0.f, 0.f, 0.f, 0.f, 0.f, 0.f, 0.f};
#pragma unroll
    for (int d0 = 0; d0 < 4; ++d0) { const bf16x8 kf = *(const LAS bf16x8*)(kb + d0 * 2048); p = __builtin_amdgcn_mfma_f32_32x32x16_bf16(kf, qr[d0], p, 0, 0, 0); }
    return p;
}
typedef short v4i16_t __attribute__((ext_vector_type(4)));
__device__ __forceinline__ s16x4 vtr(const LAS unsigned char* p) { return __builtin_bit_cast(s16x4, __builtin_amdgcn_ds_read_tr16_b64_v4i16((LAS v4i16_t*)p)); }
__device__ __forceinline__ void pv32(f32x16 (&o)[2], const LAS unsigned char* vb, int half, bf16x8 pa0, bf16x8 pa1) {
#pragma unroll
    for (int d0 = 0; d0 < 2; ++d0) {
        const LAS unsigned char* p = vb + d0 * 4096 + half * 2048;
        const s16x4 l0 = vtr(p), h0 = vtr(p + 512), l1 = vtr(p + 1024), h1 = vtr(p + 1536);
        const bf16x8 v0 = {l0[0], l0[1], l0[2], l0[3], h0[0], h0[1], h0[2], h0[3]}, v1 = {l1[0], l1[1], l1[2], l1[3], h1[0], h1[1], h1[2], h1[3]};
        o[d0] = __builtin_amdgcn_mfma_f32_32x32x16_bf16(pa0, v0, o[d0], 0, 0, 0);
        o[d0] = __builtin_amdgcn_mfma_f32_32x32x16_bf16(pa1, v1, o[d0], 0, 0, 0);
    }
}
}

struct AttUnit { int br, Pc, d, nq, kcol, vcol, qcol0, token0; };
__device__ __forceinline__ AttUnit att_decode(int ui) {
    AttUnit U;
    if (ui < 12) { const int a = blockIdx.x * 12 + ui, u = a & 31, h = (a >> 5) & 7, b = (a >> 8) & 3; U.br = a >> 10; U.d = (U.br == 0) ? 1 : (U.br == 1) ? 4 : 16;
        const int per = 32 / U.d, r = u / per; U.Pc = u % per; U.nq = 1; U.kcol = KA_OFF + 64 * h; U.vcol = VA_OFF + 64 * h; U.qcol0 = QA_OFF + 64 * h; U.token0 = b * S + r; }
    else { const int w = blockIdx.x, kvh = (w >> 5) & 1; U.Pc = w & 31; U.d = 1; U.br = 3; U.nq = 4; U.kcol = KB_OFF + 64 * kvh; U.vcol = VB_OFF + 64 * kvh; U.qcol0 = QB_OFF + 256 * kvh; U.token0 = (w >> 6) * S; }
    return U;
}
__device__ __forceinline__ void attn_mfma(const Ctx& C, const bf16* PROJ, bf16* OPART, float* LSE, const float* sinks) {
    using namespace att;
    const int lane = C.lane, r32 = lane & 31, hi = lane >> 5, wid = C.wave;
    LAS unsigned char* shm = C.lds;
    const unsigned lds0 = (unsigned)(uintptr_t)shm;
    LAS float* wsf = (LAS float*)(shm + LWS) + wid * 64;
    LAS bf16* stg = (LAS bf16*)(shm + LOST) + wid * 2048;
    const LAS unsigned char* vlane = shm + LV + ((lane >> 4) & 1) * 32 + (lane & 3) * 8 + (4 * hi + ((lane & 15) >> 2)) * 64;
#define ATT_ISSUE_K(U) do { const int m0k_ = 256 * (U).Pc - 128; _Pragma("unroll") for (int T = 0; T < 6; ++T) { int mk = m0k_ + 64 * T + lane; mk = mk < 0 ? 0 : mk; \
        glds16(PROJ + (size_t)((U).token0 + (U).d * mk) * INW + (U).kcol + wid * 8, (unsigned)__builtin_amdgcn_readfirstlane(lds0 + LK + T * 8192 + wid * 1024)); } } while (0)
#define ATT_ISSUE_V(U) do { const int m0k_ = 256 * (U).Pc - 128; _Pragma("unroll") for (int T = 0; T < 6; ++T) { int mv = m0k_ + 64 * T + 16 * (wid & 3) + (lane >> 2); mv = mv < 0 ? 0 : mv; \
        glds16(PROJ + (size_t)((U).token0 + (U).d * mv) * INW + (U).vcol + (wid >> 2) * 32 + (lane & 3) * 8, (unsigned)__builtin_amdgcn_readfirstlane(lds0 + LV + T * 8192 + wid * 1024)); } } while (0)
#define ATT_LOAD_Q(U, hq, dst) do { const bf16* Qrow_ = PROJ + (size_t)((U).token0 + (U).d * (256 * (U).Pc + 32 * wid + r32)) * INW + (U).qcol0 + 64 * (hq); \
        _Pragma("unroll") for (int d0 = 0; d0 < 4; ++d0) dst[d0] = *(const GAS bf16x8*)(Qrow_ + d0 * 16 + hi * 8); } while (0)
    bf16x8 qr[4];
    { const AttUnit U0 = att_decode(0); ATT_ISSUE_K(U0); ATT_LOAD_Q(U0, 0, qr);
      asm volatile("s_waitcnt vmcnt(0)" ::: "memory"); __builtin_amdgcn_s_barrier(); asm volatile("" ::: "memory");
      ATT_ISSUE_V(U0); }
#pragma unroll 1
    for (int ui = 0; ui < 13; ++ui) {
        const AttUnit U = att_decode(ui);
        const int Pc = U.Pc, br = U.br, d = U.d, token0 = U.token0, qcol0 = U.qcol0;
#pragma unroll 1
        for (int hq = 0; hq < U.nq; ++hq) {
            if (hq > 0) ATT_LOAD_Q(U, hq, qr);
            const int qm = 256 * Pc + 32 * wid + r32;
            f32x16 sc[5];
#pragma unroll
            for (int kb = 0; kb < 5; ++kb) {
                const int j0 = 32 * wid + 32 * kb;
                if (Pc == 0 && j0 < 128) { sc[kb] = (f32x16){-INFINITY, -INFINITY, -INFINITY, -INFINITY, -INFINITY, -INFINITY, -INFINITY, -INFINITY, -INFINITY, -INFINITY, -INFINITY, -INFINITY, -INFINITY, -INFINITY, -INFINITY, -INFINITY}; }
                else sc[kb] = qk32(shm + LK + (j0 >> 6) * 8192, (j0 >> 5) & 1, qr, r32, hi);
            }
            const int lowlim = r32 + (br == 3 ? 1 : 0);
#pragma unroll
            for (int rr = 0; rr < 16; ++rr) { const int c = crow(rr, hi); if (c < lowlim) sc[0][rr] = -INFINITY; if (c > r32) sc[4][rr] = -INFINITY; }
            float mx = -INFINITY;
#pragma unroll
            for (int kb = 0; kb < 5; ++kb)
#pragma unroll
                for (int rr = 0; rr < 16; ++rr) mx = fmaxf(mx, sc[kb][rr]);
            mx = xhalf_max(mx);
            float sk2 = 0.f;
            if (br == 3) { sk2 = sinks[(qcol0 - QB_OFF) / 64 + hq] * LOG2E; mx = fmaxf(mx, sk2); }
            float l = 0.f;
#pragma unroll
            for (int kb = 0; kb < 5; ++kb)
#pragma unroll
                for (int rr = 0; rr < 16; ++rr) { const float p = __builtin_amdgcn_exp2f(sc[kb][rr] - mx); sc[kb][rr] = p; l += p; }
            l = xhalf_sum(l);
            if (br == 3) l += __builtin_amdgcn_exp2f(sk2 - mx);
            if (hq == 0) {
                asm volatile("s_waitcnt vmcnt(0)" ::: "memory"); __builtin_amdgcn_s_barrier(); asm volatile("" ::: "memory");
                if (U.nq == 1 && ui + 1 < 13) { const AttUnit Un = att_decode(ui + 1); ATT_ISSUE_K(Un); ATT_LOAD_Q(Un, 0, qr); }
            }
            f32x16 o[2];
#pragma unroll
            for (int i = 0; i < 16; ++i) { o[0][i] = 0.f; o[1][i] = 0.f; }
#pragma unroll
            for (int kb = 0; kb < 5; ++kb) {
                const int j0 = 32 * wid + 32 * kb;
                if (!(Pc == 0 && j0 < 128)) {
                    u32x4 w0, w1;
                    w0.x = cvtpk(sc[kb][0], sc[kb][1]); w0.y = cvtpk(sc[kb][2], sc[kb][3]); w0.z = cvtpk(sc[kb][4], sc[kb][5]); w0.w = cvtpk(sc[kb][6], sc[kb][7]);
                    w1.x = cvtpk(sc[kb][8], sc[kb][9]); w1.y = cvtpk(sc[kb][10], sc[kb][11]); w1.z = cvtpk(sc[kb][12], sc[kb][13]); w1.w = cvtpk(sc[kb][14], sc[kb][15]);
                    pv32(o, vlane + (j0 >> 6) * 8192, (j0 >> 5) & 1, __builtin_bit_cast(bf16x8, w0), __builtin_bit_cast(bf16x8, w1));
                }
            }
            if (hi == 0) wsf[r32] = l;
            asm volatile("s_waitcnt lgkmcnt(0)" ::: "memory");
#pragma unroll
            for (int rr = 0; rr < 16; ++rr) { const int orow = crow(rr, hi); const float rl = __builtin_amdgcn_rcpf(wsf[orow]);
                stg[orow * 64 + r32] = (bf16)f2bf(o[0][rr] * rl); stg[orow * 64 + 32 + r32] = (bf16)f2bf(o[1][rr] * rl); }
            asm volatile("s_waitcnt lgkmcnt(0)" ::: "memory");
            const int hcol = (br == 3) ? (qcol0 - QB_OFF) + 64 * hq : (qcol0 - QA_OFF);
            bf16* Ob = OPART + ((size_t)br * M) * 512 + hcol;
            if (br < 3 && hi == 0) LSE[((size_t)br * M + (token0 + d * qm)) * 8 + (qcol0 - QA_OFF) / 64] = mx + __builtin_amdgcn_logf(l);
#pragma unroll
            for (int i = 0; i < 4; ++i) { const int row = i * 8 + (lane >> 3), ch = lane & 7; const v4u v = *(const LAS v4u*)(stg + row * 64 + ch * 8);
                const int tok = token0 + d * (256 * Pc + 32 * wid + row);
                *(GAS v4u*)(Ob + (size_t)tok * 512 + ch * 8) = v; }
            asm volatile("s_waitcnt lgkmcnt(0)" ::: "memory");
        }
        if (ui + 1 < 13) {
            asm volatile("s_waitcnt vmcnt(4)" : "+v"(qr[0]), "+v"(qr[1]), "+v"(qr[2]), "+v"(qr[3]) :: "memory"); __builtin_amdgcn_s_barrier(); asm volatile("" ::: "memory");
            const AttUnit Un = att_decode(ui + 1); ATT_ISSUE_V(Un);
        }
    }
    asm volatile("s_waitcnt vmcnt(0) lgkmcnt(0)" ::: "memory"); __builtin_amdgcn_s_barrier(); asm volatile("" ::: "memory");
#undef ATT_ISSUE_K
#undef ATT_ISSUE_V
#undef ATT_LOAD_Q
}

__device__ __forceinline__ void ld8bf(const bf16* p, float (&v)[8]) {
    const v4u a = *(const GAS v4u*)p;
    v[0] = bflo(a.x); v[1] = bfhi(a.x); v[2] = bflo(a.y); v[3] = bfhi(a.y); v[4] = bflo(a.z); v[5] = bfhi(a.z); v[6] = bflo(a.w); v[7] = bfhi(a.w);
}
__device__ __forceinline__ void unpack8(const v4u a, float (&v)[8]) {
    v[0] = bflo(a.x); v[1] = bfhi(a.x); v[2] = bflo(a.y); v[3] = bfhi(a.y); v[4] = bflo(a.z); v[5] = bfhi(a.z); v[6] = bflo(a.w); v[7] = bfhi(a.w);
}
constexpr int UNR = 4;
__device__ __forceinline__ void combine_phase(const Ctx& C, const bf16* OPART, const float* LSE, const float* gna, const float* gnb, bf16* MIX) {
    const int h = C.lane >> 3;
    float ga[8], gb[8];
#pragma unroll
    for (int i = 0; i < 8; ++i) { ga[i] = gna[8 * C.lane + i]; gb[i] = gnb[8 * C.lane + i]; }
    for (int row0 = C.gw; row0 < M; row0 += UNR * C.ngw) {
        v4u q0[UNR], q1[UNR], q2[UNR], q3[UNR]; float l0[UNR], l1[UNR], l2[UNR];
#pragma unroll
        for (int k = 0; k < UNR; ++k) { const int row = row0 + k * C.ngw;
            l0[k] = LSE[((size_t)0 * M + row) * 8 + h]; l1[k] = LSE[((size_t)1 * M + row) * 8 + h]; l2[k] = LSE[((size_t)2 * M + row) * 8 + h];
            q0[k] = *(const GAS v4u*)(OPART + ((size_t)0 * M + row) * 512 + 8 * C.lane); q1[k] = *(const GAS v4u*)(OPART + ((size_t)1 * M + row) * 512 + 8 * C.lane);
            q2[k] = *(const GAS v4u*)(OPART + ((size_t)2 * M + row) * 512 + 8 * C.lane); q3[k] = *(const GAS v4u*)(OPART + ((size_t)3 * M + row) * 512 + 8 * C.lane); }
#pragma unroll
        for (int k = 0; k < UNR; ++k) { const int row = row0 + k * C.ngw;
            const float mx = fmaxf(l0[k], fmaxf(l1[k], l2[k]));
            float w0 = __builtin_amdgcn_exp2f(l0[k] - mx), w1 = __builtin_amdgcn_exp2f(l1[k] - mx), w2 = __builtin_amdgcn_exp2f(l2[k] - mx);
            const float inv = 1.0f / (w0 + w1 + w2); w0 *= inv; w1 *= inv; w2 *= inv;
            float a0[8], a1[8], a2[8], b[8]; unpack8(q0[k], a0); unpack8(q1[k], a1); unpack8(q2[k], a2); unpack8(q3[k], b);
            float sa = 0.f, sb = 0.f;
#pragma unroll
            for (int i = 0; i < 8; ++i) { a0[i] = w0 * a0[i] + w1 * a1[i] + w2 * a2[i]; sa += a0[i] * a0[i]; sb += b[i] * b[i]; }
            sa = wave_sum(sa); sb = wave_sum(sb);
            const float ra = __builtin_amdgcn_rsqf(sa * (1.0f / 512.0f) + EPS), rb = __builtin_amdgcn_rsqf(sb * (1.0f / 512.0f) + EPS);
            v4u oa, ob;
            oa.x = pk2(a0[0] * ra * ga[0], a0[1] * ra * ga[1]); oa.y = pk2(a0[2] * ra * ga[2], a0[3] * ra * ga[3]); oa.z = pk2(a0[4] * ra * ga[4], a0[5] * ra * ga[5]); oa.w = pk2(a0[6] * ra * ga[6], a0[7] * ra * ga[7]);
            ob.x = pk2(b[0] * rb * gb[0], b[1] * rb * gb[1]); ob.y = pk2(b[2] * rb * gb[2], b[3] * rb * gb[3]); ob.z = pk2(b[4] * rb * gb[4], b[5] * rb * gb[5]); ob.w = pk2(b[6] * rb * gb[6], b[7] * rb * gb[7]);
            *(GAS v4u*)(MIX + (size_t)row * D + 8 * C.lane) = oa; *(GAS v4u*)(MIX + (size_t)row * D + 512 + 8 * C.lane) = ob; }
    }
}

__device__ __forceinline__ void row_load(const float* p, int lane, f32x4 (&v)[4]) {
#pragma unroll
    for (int j = 0; j < 4; ++j) v[j] = *(const GAS f32x4*)(p + 4 * lane + 256 * j);
}
__device__ __forceinline__ float row_ssq(const f32x4 (&v)[4]) {
    float s = 0.f;
#pragma unroll
    for (int j = 0; j < 4; ++j) s += (v[j][0] * v[j][0] + v[j][1] * v[j][1]) + (v[j][2] * v[j][2] + v[j][3] * v[j][3]);
    return wave_sum(s);
}
__device__ __forceinline__ void row_store_bf16(bf16* p, int lane, const f32x4 (&v)[4]) {
#pragma unroll
    for (int j = 0; j < 4; ++j) { u32x2v w; w.x = pk2(v[j][0], v[j][1]); w.y = pk2(v[j][2], v[j][3]); *(GAS u32x2v*)(p + 4 * lane + 256 * j) = w; }
}
__device__ __forceinline__ void row_load_bf16(const bf16* p, int lane, f32x4 (&v)[4]) {
#pragma unroll
    for (int j = 0; j < 4; ++j) { const u32x2v a = *(const GAS u32x2v*)(p + 4 * lane + 256 * j); v[j][0] = bflo(a.x); v[j][1] = bfhi(a.x); v[j][2] = bflo(a.y); v[j][3] = bfhi(a.y); }
}
__device__ __forceinline__ void xn_rows(const Ctx& C, const float* x, bf16* XN, float* ssq) {
    for (int row0 = C.gw; row0 < M; row0 += UNR * C.ngw) {
        f32x4 v[UNR][4];
#pragma unroll
        for (int k = 0; k < UNR; ++k) row_load(x + (size_t)(row0 + k * C.ngw) * D, C.lane, v[k]);
#pragma unroll
        for (int k = 0; k < UNR; ++k) { const int row = row0 + k * C.ngw;
            const float s = row_ssq(v[k]);
            row_store_bf16(XN + (size_t)row * D, C.lane, v[k]);
            if (C.lane < 16) ssq[(size_t)row * 16 + C.lane] = (C.lane == 0) ? s : 0.f; }
    }
}

struct Route { int e0, e1; float g0, g1, rs; int p0, p1, pad; };
__device__ __forceinline__ void router_phase(const Ctx& C, const bf16* x1, const float* router, const float* gain, Route* RT, int* blkcnt) {
    LAS float* GRt = (LAS float*)(C.lds + RING_OFF);
    LAS unsigned* tokE = (LAS unsigned*)(C.lds + RING_OFF + 32768);
    for (int i = C.tid; i < 1024 * 8; i += 512) { const int c = i >> 3, e = i & 7; GRt[e * 1024 + c] = router[i] * gain[c]; }
    __syncthreads();
    const int tok0 = blockIdx.x * 128 + C.wave * 16;
    for (int tt = 0; tt < 16; ++tt) {
        const int tok = tok0 + tt;
        f32x4 v[4]; row_load_bf16(x1 + (size_t)tok * D, C.lane, v);
        float ss = 0.f, lg[8];
#pragma unroll
        for (int e = 0; e < 8; ++e) lg[e] = 0.f;
#pragma unroll
        for (int j = 0; j < 4; ++j) { ss += (v[j][0] * v[j][0] + v[j][1] * v[j][1]) + (v[j][2] * v[j][2] + v[j][3] * v[j][3]);
#pragma unroll
            for (int e = 0; e < 8; ++e) { const f32x4 r = *(const LAS f32x4*)(GRt + e * 1024 + 4 * C.lane + 256 * j); lg[e] += (v[j][0] * r[0] + v[j][1] * r[1]) + (v[j][2] * r[2] + v[j][3] * r[3]); } }
        ss = wave_sum(ss);
        const float rs = __builtin_amdgcn_rsqf(ss * (1.0f / D) + EPS);
#pragma unroll
        for (int e = 0; e < 8; ++e) lg[e] = wave_sum(lg[e]) * rs;
        int e0 = 0; float v0 = lg[0];
#pragma unroll
        for (int e = 1; e < 8; ++e) if (lg[e] > v0) { v0 = lg[e]; e0 = e; }
        int e1 = -1; float v1 = -INFINITY;
#pragma unroll
        for (int e = 0; e < 8; ++e) if (e != e0 && lg[e] > v1) { v1 = lg[e]; e1 = e; }
        const float ex = __expf(v1 - v0), g0 = 1.0f / (1.0f + ex), g1 = ex * g0;
        if (C.lane == 0) { Route r; r.e0 = e0; r.e1 = e1; r.g0 = g0; r.g1 = g1; r.rs = rs; r.p0 = 0; r.p1 = 0; r.pad = 0; RT[tok] = r; tokE[C.wave * 16 + tt] = (unsigned)e0 | ((unsigned)e1 << 8); }
    }
    __syncthreads();
    if (C.tid < 8) { int cnt = 0; for (int t = 0; t < 128; ++t) { const unsigned w = tokE[t]; cnt += ((w & 255u) == (unsigned)C.tid) + ((w >> 8) == (unsigned)C.tid); } blkcnt[blockIdx.x * 8 + C.tid] = cnt; }
    __syncthreads();
}
__device__ __forceinline__ void scatter_phase(const Ctx& C, const bf16* x1, const float* gain, Route* RT, const int* blkcnt, bf16* AP, float* rowgate, volatile LAS int* SEGB) {
    LAS int* LTOT = (LAS int*)(C.lds + RING_OFF);
    LAS int* LPRE = LTOT + 8;
    LAS unsigned* tokE = (LAS unsigned*)(LTOT + 16);
    LAS int* POS = (LAS int*)(LTOT + 16 + 128);
    { const int e = C.wave; int st = 0, sp = 0;
#pragma unroll
      for (int j = 0; j < 4; ++j) { const int b = C.lane + 64 * j; const int c = blkcnt[b * 8 + e]; st += c; if (b < (int)blockIdx.x) sp += c; }
      st = wave_sum_i(st); sp = wave_sum_i(sp);
      if (C.lane == 0) { LTOT[e] = st; LPRE[e] = sp; } }
    if (C.tid < 128) { const Route r = RT[blockIdx.x * 128 + C.tid]; tokE[C.tid] = (unsigned)r.e0 | ((unsigned)r.e1 << 8); }
    __syncthreads();
    if (C.tid == 0) { int base = 0; for (int e = 0; e < 8; ++e) { SEGB[e] = base; base += (LTOT[e] + 255) & ~255; } SEGB[8] = base; }
    __syncthreads();
    if (C.tid < 8) { const int e = C.tid; int run = SEGB[e] + LPRE[e];
        for (int t = 0; t < 128; ++t) { const unsigned w = tokE[t]; if ((int)(w & 255u) == e) POS[2 * t] = run++; if ((int)(w >> 8) == e) POS[2 * t + 1] = run++; } }
    __syncthreads();
    float gn[4][4];
#pragma unroll
    for (int j = 0; j < 4; ++j) { const f32x4 g = *(const GAS f32x4*)(gain + 4 * C.lane + 256 * j); gn[j][0] = g[0]; gn[j][1] = g[1]; gn[j][2] = g[2]; gn[j][3] = g[3]; }
    for (int tt = 0; tt < 16; ++tt) {
        const int tl = C.wave * 16 + tt, tok = blockIdx.x * 128 + tl;
        const int p0 = POS[2 * tl], p1 = POS[2 * tl + 1];
        const Route r = RT[tok];
        if (C.lane == 0) { RT[tok].p0 = p0; RT[tok].p1 = p1; rowgate[p0] = r.g0; rowgate[p1] = r.g1; }
        f32x4 v[4]; row_load_bf16(x1 + (size_t)tok * D, C.lane, v);
#pragma unroll
        for (int j = 0; j < 4; ++j) { v[j][0] *= r.rs * gn[j][0]; v[j][1] *= r.rs * gn[j][1]; v[j][2] *= r.rs * gn[j][2]; v[j][3] *= r.rs * gn[j][3]; }
        row_store_bf16(AP + (size_t)p0 * D, C.lane, v); row_store_bf16(AP + (size_t)p1 * D, C.lane, v);
    }
    if (blockIdx.x < 8) { const int e = blockIdx.x; const int lo = SEGB[e] + LTOT[e], hi = SEGB[e + 1];
        for (int rr = lo + C.wave; rr < hi; rr += NWAVES) {
#pragma unroll
            for (int j = 0; j < 4; ++j) { u32x2v z; z.x = 0u; z.y = 0u; *(GAS u32x2v*)(AP + (size_t)rr * D + 4 * C.lane + 256 * j) = z; }
            if (C.lane == 0) rowgate[rr] = 0.f; } }
    __syncthreads();
}
__device__ __forceinline__ void moe_tail_row(const bf16* PTp, int p, float gate, int lane, u32x2v (&y)[4]) {
    f32x4 t[4];
#pragma unroll
    for (int j = 0; j < 4; ++j) t[j] = (f32x4){0.f, 0.f, 0.f, 0.f};
#pragma unroll 1
    for (int s = 0; s < KSPLIT; ++s) {
#pragma unroll
        for (int j = 0; j < 4; ++j) { const u32x2v a = *(const GAS u32x2v*)(PTp + ((size_t)s * TAILROWS + (p - MAINROWS)) * D + 4 * lane + 256 * j);
            t[j][0] += bflo(a.x); t[j][1] += bfhi(a.x); t[j][2] += bflo(a.y); t[j][3] += bfhi(a.y); } }
#pragma unroll
    for (int j = 0; j < 4; ++j) { y[j].x = pk2(t[j][0] * gate, t[j][1] * gate); y[j].y = pk2(t[j][2] * gate, t[j][3] * gate); }
}
__device__ __forceinline__ void moe_combine(const Ctx& C, float* xout, const Route* RT, const bf16* Y, const bf16* PTp, bf16* XN, float* ssq, const float* final_gain) {
    for (int row0 = C.gw; row0 < M; row0 += UNR * C.ngw) {
        int p0[UNR], p1[UNR]; float g0[UNR], g1[UNR];
#pragma unroll
        for (int k = 0; k < UNR; ++k) { const Route rt = RT[row0 + k * C.ngw]; p0[k] = rt.p0; p1[k] = rt.p1; g0[k] = rt.g0; g1[k] = rt.g1; }
        u32x2v xr[UNR][4], ya[UNR][4], yb[UNR][4];
#pragma unroll
        for (int k = 0; k < UNR; ++k)
#pragma unroll
            for (int j = 0; j < 4; ++j) { xr[k][j] = *(const GAS u32x2v*)(XN + (size_t)(row0 + k * C.ngw) * D + 4 * C.lane + 256 * j);
                ya[k][j] = *(const GAS u32x2v*)(Y + (size_t)p0[k] * D + 4 * C.lane + 256 * j); yb[k][j] = *(const GAS u32x2v*)(Y + (size_t)p1[k] * D + 4 * C.lane + 256 * j); }
#pragma unroll
        for (int k = 0; k < UNR; ++k) { const int row = row0 + k * C.ngw;
            if (p0[k] >= MAINROWS) moe_tail_row(PTp, p0[k], g0[k], C.lane, ya[k]);
            if (p1[k] >= MAINROWS) moe_tail_row(PTp, p1[k], g1[k], C.lane, yb[k]);
            f32x4 v[4];
#pragma unroll
            for (int j = 0; j < 4; ++j) { v[j][0] = bflo(xr[k][j].x) + bflo(ya[k][j].x) + bflo(yb[k][j].x); v[j][1] = bfhi(xr[k][j].x) + bfhi(ya[k][j].x) + bfhi(yb[k][j].x);
                v[j][2] = bflo(xr[k][j].y) + bflo(ya[k][j].y) + bflo(yb[k][j].y); v[j][3] = bfhi(xr[k][j].y) + bfhi(ya[k][j].y) + bfhi(yb[k][j].y); }
            const float s = row_ssq(v);
            if (final_gain) {
                const float rs = __builtin_amdgcn_rsqf(s * (1.0f / D) + EPS);
#pragma unroll
                for (int j = 0; j < 4; ++j) { const f32x4 g = *(const GAS f32x4*)(final_gain + 4 * C.lane + 256 * j); *(GAS f32x4*)(xout + (size_t)row * D + 4 * C.lane + 256 * j) = v[j] * rs * g; }
            } else {
                row_store_bf16(XN + (size_t)row * D, C.lane, v);
                if (C.lane < 16) ssq[(size_t)row * 16 + C.lane] = (C.lane == 0) ? s : 0.f;
            } }
    }
}

struct Args { const void* in[17]; float* out; unsigned char* ws; };
__global__ void __launch_bounds__(NWAVES * 64, 2) trunk_fwd(Args args) {
    extern __shared__ __attribute__((aligned(16))) unsigned char lds[];
    const int G = gridDim.x;
    const int wave_s = __builtin_amdgcn_readfirstlane(threadIdx.x >> 6);
#define TIDX() ({ unsigned z_ = 0u; asm volatile("" : "+v"(z_)); wave_s * 64 + (int)__builtin_amdgcn_mbcnt_hi(~0u, __builtin_amdgcn_mbcnt_lo(~0u, z_)); })
#define MKCTX() Ctx C; { int t_ = TIDX(); C.lds = (LAS unsigned char*)lds; C.tid = t_; C.lane = t_ & 63; C.wave = __builtin_amdgcn_readfirstlane(t_ >> 6); C.gw = blockIdx.x * NWAVES + C.wave; C.ngw = G * NWAVES; } \
    GAS unsigned char* wsl = (GAS unsigned char*)ws; int bid = blockIdx.x; asm volatile("" : "+s"(wsl), "+s"(bid));
    LAS unsigned char* const ldsb = (LAS unsigned char*)lds;
    volatile LAS unsigned* MISC = (volatile LAS unsigned*)(ldsb + MISC_OFF);
    volatile LAS int* SEGB = (volatile LAS int*)(ldsb + MISC_OFF + 64);
    unsigned char* ws = args.ws;
    gu32* ctl = (gu32*)(ws + WS_CTL);
    for (int u = threadIdx.x; u < (LDS_BYTES - LDSCTL_OFF) / 4; u += NWAVES * 64) ((LAS unsigned*)(ldsb + LDSCTL_OFF))[u] = 0u;
    __syncthreads();
    XcdBarrier bar = xcd_barrier_post((unsigned*)(ctl + CW_BAR), MISC + 8, (int)threadIdx.x);
#define GRID_BAR_RAW() do { XcdBarrier b_ = bar; GAS unsigned* p_ = (GAS unsigned*)bar.bar; asm volatile("" : "+s"(b_.x), "+s"(p_)); b_.bar = (unsigned*)p_; xcd_barrier(b_, TIDX()); } while (0)
#if PROBE_T
#define TBEG(id) do { if ((id) == PROBE_T && blockIdx.x == 0 && TIDX() == 0) MISC[33] = (unsigned)__builtin_amdgcn_s_memrealtime(); } while (0)
#define TEND(id) do { if ((id) == PROBE_T && blockIdx.x == 0 && TIDX() == 0) MISC[32] = MISC[32] + ((unsigned)__builtin_amdgcn_s_memrealtime() - MISC[33]); } while (0)
#else
#define TBEG(id) do {} while (0)
#define TEND(id) do {} while (0)
#endif
#define GRID_BAR() do { TBEG(1); GRID_BAR_RAW(); TEND(1); } while (0)

    const float* x_in = (const float*)args.in[0]; const int* positions = (const int*)args.in[1];
    const float* attn_norm = (const float*)args.in[2]; const float* w_in = (const float*)args.in[3];
    const float* mix_norm_a = (const float*)args.in[4]; const float* mix_norm_b = (const float*)args.in[5];
    const float* sinks = (const float*)args.in[6]; const float* w_out = (const float*)args.in[7];
    const float* ffn_norm = (const float*)args.in[8]; const float* dwg = (const float*)args.in[9];
    const float* dwu = (const float*)args.in[10]; const float* dwd = (const float*)args.in[11];
    const float* router = (const float*)args.in[12]; const float* mwg = (const float*)args.in[13];
    const float* mwu = (const float*)args.in[14]; const float* mwd = (const float*)args.in[15];
    const float* final_norm = (const float*)args.in[16];
    float* xout = args.out;
#define ROPE ((float*)(GAS float*)(wsl + WS_ROPE))
#define SSQA ((float*)(GAS float*)(wsl + WS_SSQA))
#define SSQF ((float*)(GAS float*)(wsl + WS_SSQF))
#define RT ((Route*)(GAS Route*)(wsl + WS_ROUTE))
#define BLKCNT ((int*)(GAS int*)(wsl + WS_BLKCNT))
#define ROWGATE ((float*)(GAS float*)(wsl + WS_ROWGATE))
#define WIN ((bf16*)(GAS bf16*)(wsl + WS_WIN))
#define WOUT ((bf16*)(GAS bf16*)(wsl + WS_WOUT))
#define WGU ((bf16*)(GAS bf16*)(wsl + WS_WGU))
#define WDN ((bf16*)(GAS bf16*)(wsl + WS_WDN))
#define MGU ((bf16*)(GAS bf16*)(wsl + WS_MGU))
#define MDN ((bf16*)(GAS bf16*)(wsl + WS_MDN))
#define XN ((bf16*)(GAS bf16*)(wsl + WS_XN))
#define PROJ ((bf16*)(GAS bf16*)(wsl + WS_PROJ))
#define OPART ((bf16*)(GAS bf16*)(wsl + WS_OPART))
#define LSE ((float*)(GAS float*)(wsl + WS_LSE))
#define MIX ((bf16*)(GAS bf16*)(wsl + WS_MIX))
#define HB ((bf16*)(GAS bf16*)(wsl + WS_H))
#define AP ((bf16*)(GAS bf16*)(wsl + WS_AP))
#define PT ((bf16*)(GAS bf16*)(wsl + WS_PT))

    TBEG(2);
    { MKCTX();
    { ConvSrc S{w_in, w_out, attn_norm, ffn_norm, dwg, dwu, dwd, WIN, WOUT, WGU, WDN}; convert_prologue(C, S); }
    convert_moe_layer(C, mwg, mwu, mwd, MGU, MDN);
    for (int i = blockIdx.x * 512 + C.tid; i < S * 32; i += G * 512) {
        const int s = i >> 5, f = i & 31;
        const float inv = __builtin_amdgcn_exp2f(-(float)f * (13.287712379549449f / 32.0f));
        const float ang = (float)positions[s] * inv;
        const double rev = (double)ang * 0.15915494309189535; const float fr = (float)(rev - __builtin_rint(rev));
        ROPE[2 * i] = __builtin_amdgcn_cosf(fr); ROPE[2 * i + 1] = __builtin_amdgcn_sinf(fr);
    }
    xn_rows(C, x_in, XN, SSQA); }
    TEND(2);
    GRID_BAR();

#pragma unroll 1
    for (int l = 0; l < DEPTH; ++l) {
        TBEG(3);
        { MKCTX(); pg8::Gemm g{XN, WIN + (size_t)l * INW * D, M, INW, D, 0, D}; pg8::StaticOrder So; So.init(M, INW, G, bid);
          pg8::EpiRope E{PROJ, SSQA, ROPE};
          pg8::gemm_phase<pg8::EpiRope, pg8::StaticOrder, true, true>(C.lds + RING_OFF, g, So, E, C.tid);
        }
        TEND(3);
        GRID_BAR();
        TBEG(4);
        { MKCTX(); attn_mfma(C, PROJ, OPART, LSE, sinks + l * 8); }
        TEND(4);
        GRID_BAR();
        TBEG(5);
        { MKCTX(); combine_phase(C, OPART, LSE, mix_norm_a + l * 512, mix_norm_b + l * 512, MIX); }
        TEND(5);
        GRID_BAR();
        TBEG(6);
        { MKCTX(); pg8::Gemm g{MIX, WOUT + (size_t)l * D * D, M, D, D, 0, D}; pg8::StaticOrder So; So.init(M, D, G, bid);
          pg8::EpiResid E{XN, SSQF};
          pg8::gemm_phase<pg8::EpiResid, pg8::StaticOrder, true, true>(C.lds + RING_OFF, g, So, E, C.tid); }
        TEND(6);
        GRID_BAR();
        if ((l & 1) == 0) {
            const int j = l >> 1;
            TBEG(7);
            { MKCTX(); pg8::Gemm g{XN, WGU + (size_t)j * 2 * FF * D, M, 2 * FF, D, 0, D}; pg8::StaticOrder So; So.init(M, 2 * FF, G, bid);
              pg8::EpiSwiglu<true> E{HB, SSQF};
              pg8::gemm_phase<pg8::EpiSwiglu<true>, pg8::StaticOrder, true, true>(C.lds + RING_OFF, g, So, E, C.tid);
            }
            TEND(7);
            GRID_BAR();
            TBEG(8);
            { MKCTX(); pg8::Gemm g{HB, WDN + (size_t)j * D * FF, M, D, FF, 0, FF}; pg8::StaticOrder So; So.init(M, D, G, bid);
              pg8::EpiResid E{XN, SSQA};
              pg8::gemm_phase<pg8::EpiResid, pg8::StaticOrder, true, true>(C.lds + RING_OFF, g, So, E, C.tid); }
            TEND(8);
            GRID_BAR();
        } else {
            const int j = l >> 1;
            TBEG(9);
            { MKCTX(); router_phase(C, XN, router + (size_t)j * D * NE, ffn_norm + l * D, RT, BLKCNT); }
            TEND(9);
            GRID_BAR();
            TBEG(10);
            { MKCTX(); scatter_phase(C, XN, ffn_norm + l * D, RT, BLKCNT, AP, ROWGATE, SEGB); }
            TEND(10);
            GRID_BAR();
            const int nrows = SEGB[8];
            TBEG(11);
            { MKCTX(); pg8::Gemm g{AP, MGU, nrows, 2 * FF, D, (size_t)2 * FF * D * 2, D}; pg8::GroupedOrder So; So.init(nrows, 2 * FF, G, bid); So.segb = (const LAS int*)(C.lds + MISC_OFF + 64);
              pg8::EpiSwiglu<false> E{HB, nullptr};
              pg8::gemm_phase<pg8::EpiSwiglu<false>, pg8::GroupedOrder, true, true>(C.lds + RING_OFF, g, So, E, C.tid);
            }
            TEND(11);
            GRID_BAR();
            TBEG(12);
            { MKCTX(); const int nmain = nrows < MAINROWS ? nrows : MAINROWS;
              pg8::Gemm g{HB, MDN, nmain, D, FF, (size_t)D * FF * 2, FF}; pg8::GroupedOrder So; So.init(nmain, D, G, bid); So.segb = (const LAS int*)(C.lds + MISC_OFF + 64);
              pg8::EpiY E{AP, ROWGATE};
              pg8::gemm_phase<pg8::EpiY, pg8::GroupedOrder, true, true>(C.lds + RING_OFF, g, So, E, C.tid);
              pg8::Gemm gt{HB, MDN, nrows, D, FF / KSPLIT, (size_t)D * FF * 2, FF}; pg8::TailOrder St; St.npair = (nrows - nmain) / 256 * 4; St.G = G; St.c = bid; St.segb = (const LAS int*)(C.lds + MISC_OFF + 64);
              pg8::EpiPart Ep{PT};
              pg8::gemm_phase<pg8::EpiPart, pg8::TailOrder, true, true>(C.lds + RING_OFF, gt, St, Ep, C.tid);
            }
            TEND(12);
            GRID_BAR();
            TBEG(13);
            { MKCTX(); moe_combine(C, xout, RT, AP, PT, XN, SSQA, l == DEPTH - 1 ? final_norm : nullptr);
            if (l == 1) convert_moe_layer(C, mwg + (size_t)NE * D * FF, mwu + (size_t)NE * D * FF, mwd + (size_t)NE * FF * D, MGU, MDN); }
            TEND(13);
            if (l != DEPTH - 1) GRID_BAR();
        }
    }
#if PROBE_T
    if (blockIdx.x == 0 && TIDX() == 0) { const unsigned long long t0 = __builtin_amdgcn_s_memrealtime(); const unsigned long long dt = MISC[32];
        while (__builtin_amdgcn_s_memrealtime() - t0 < dt) __builtin_amdgcn_s_sleep(8); }
#endif
}

extern "C" void kernel_launch(void* const* d_in, const int* in_sizes, int n_in, void* d_out, int out_size, void* d_ws, size_t ws_size, hipStream_t stream) {
    static int grid = 0;
    if (grid == 0) {
        if (n_in != 17 || in_sizes[0] != M * D || out_size != M * D || ws_size < WS_END) {
            fprintf(stderr, "kernel_launch: unexpected shapes / workspace (n_in %d, in0 %d, out %d, ws %zu, need %zu); nothing launched\n", n_in, n_in > 0 ? in_sizes[0] : -1, out_size, ws_size, (size_t)WS_END); grid = -1; return; }
        int dev = 0, cus = 0, per_cu = 0;
        if (hipGetDevice(&dev) != hipSuccess || hipDeviceGetAttribute(&cus, hipDeviceAttributeMultiprocessorCount, dev) != hipSuccess) { grid = -1; return; }
        if (hipFuncSetAttribute((const void*)trunk_fwd, hipFuncAttributeMaxDynamicSharedMemorySize, LDS_BYTES) != hipSuccess) { fprintf(stderr, "kernel_launch: hipFuncSetAttribute failed\n"); grid = -1; return; }
        if (hipOccupancyMaxActiveBlocksPerMultiprocessor(&per_cu, (const void*)trunk_fwd, NWAVES * 64, LDS_BYTES) != hipSuccess || per_cu < 1) { fprintf(stderr, "kernel_launch: occupancy query reports %d blocks per CU\n", per_cu); }
        (void)hipGetLastError();
        grid = cus;
        if (grid != 256) { fprintf(stderr, "kernel_launch: built for 256 CUs, device has %d; nothing launched\n", cus); grid = -1; return; }
    }
    if (grid < 0) return;
    if (hipMemsetAsync((char*)d_ws + WS_CTL, 0, CTL_ZERO_BYTES, stream) != hipSuccess) return;
    Args a{};
    for (int i = 0; i < 17; ++i) a.in[i] = d_in[i];
    a.out = (float*)d_out; a.ws = (unsigned char*)d_ws;
    hipLaunchKernelGGL(trunk_fwd, dim3(grid), dim3(NWAVES * 64), LDS_BYTES, stream, a);
}
```

```cpp
#include <hip/hip_runtime.h>
#include <cstdio>
#include <cstdint>

#ifndef PROBE_T
#define PROBE_T 0
#endif
namespace cfg {
constexpr int D = 1024, NB = 4, S = 8192, M = NB * S, DEPTH = 4, HD = 64, INW = 2304, FF = 3584, NE = 8;
constexpr int QA_OFF = 0, KA_OFF = 512, VA_OFF = 1024, QB_OFF = 1536, KB_OFF = 2048, VB_OFF = 2176;
constexpr float EPS = 1e-5f;
constexpr float LOG2E = 1.4426950408889634f;
constexpr float C2 = 0.125f * LOG2E;
constexpr int MAXROWS = 2 * M + NE * 256;
constexpr int MAINROWS = 2 * M;
constexpr int TAILROWS = 7 * 256, KSPLIT = 7;
}

template <int K> __device__ __forceinline__ float swz_xor(float v) { return __builtin_bit_cast(float, __builtin_amdgcn_ds_swizzle(__builtin_bit_cast(int, v), (K << 10) | 0x1f)); }
__device__ __forceinline__ void pl32_swap(float& a, float& b) { asm volatile("s_nop 1\n\tv_permlane32_swap_b32 %0, %1" : "+v"(a), "+v"(b)); }
__device__ __forceinline__ float xor32_sum(float v) { float a = v, b = v; pl32_swap(a, b); return a + b; }
__device__ __forceinline__ float xor32_max(float v) { float a = v, b = v; pl32_swap(a, b); return fmaxf(a, b); }
__device__ __forceinline__ float fq_sum(float s) { s += swz_xor<16>(s); return xor32_sum(s); }
namespace pg8 {
#define PG8_LAS __attribute__((address_space(3)))
typedef unsigned short bf16_t;
typedef short bf16x8 __attribute__((ext_vector_type(8)));
typedef float f32x4 __attribute__((ext_vector_type(4)));
typedef unsigned u32x4 __attribute__((ext_vector_type(4)));
constexpr int BM = 256, BK = 64, HALF = 128, HTB = HALF * BK * 2  , STAGE_BYTES = 8 * HTB, NXCD = 8, WGM = 8;

__host__ __device__ __forceinline__ int lds_byte(int r, int c) { const int st = (r >> 4) * 2 + (c >> 5), rr = r & 15, cc = c & 31, ob = rr * 64 + cc * 2; return st * 1024 + (ob ^ (((ob >> 9) & 1) << 5)); }
__host__ __device__ __forceinline__ void stage_rc(int b, int& R, int& C) { const int st = b / 1024, sb = b % 1024, swz = sb ^ (((sb >> 9) & 1) << 5); R = (st >> 1) * 16 + swz / 64; C = (st & 1) * 32 + (swz % 64) / 2; }
__host__ __device__ __forceinline__ int perm32(int rho) { const int n = rho >> 4, i = rho & 15; return 8 * (i >> 2) + 4 * n + (i & 3); }

struct Unit { int pm, pn, eb, ko; };
struct Gemm { const bf16_t* A; const bf16_t* Bt; int M, N, K; size_t bstride; int ld; };

struct StaticOrder {
    int nM, nN, nwg, G, c;
    __host__ __device__ void init(int M, int N, int G_, int c_) { nM = M / BM; nN = N / BM; nwg = nM * nN; G = G_; c = c_; }
    __host__ __device__ bool next(int i, Unit& u) const {
        const long L = (long)i * G + c; if (L >= nwg) return false;
        int wgid = (int)L; { const int q = nwg / NXCD, r = nwg % NXCD, xcd = wgid % NXCD, off = wgid / NXCD; wgid = (xcd < r ? xcd * (q + 1) : r * (q + 1) + (xcd - r) * q) + off; }
        const int nig = WGM * nN, gid = wgid / nig, fm = gid * WGM, gsz = (nM - fm) < WGM ? (nM - fm) : WGM;
        u.pm = fm + ((wgid % nig) % gsz); u.pn = (wgid % nig) / gsz; u.eb = 0; u.ko = 0; return true;
    }
    __device__ __forceinline__ void a_ready(const Unit&) const {}
    __device__ __forceinline__ void done(const Unit&) const {}
};


__device__ __forceinline__ unsigned cvt_pk_bf16(float lo, float hi) { unsigned r; asm volatile("v_cvt_pk_bf16_f32 %0, %1, %2" : "=v"(r) : "v"(lo), "v"(hi)); return r; }
typedef unsigned u32x2 __attribute__((ext_vector_type(2)));
__device__ __forceinline__ void row_rs8(const float* ssq, int row0, int fq, float (&rs)[2][4]) {
#pragma unroll
    for (int ai = 0; ai < 2; ++ai)
#pragma unroll
        for (int m = 0; m < 4; ++m) { const f32x4 p = *(const f32x4*)(ssq + (size_t)(row0 + ai * HALF + m * 16) * 16 + 4 * fq);
            float s = (p[0] + p[1]) + (p[2] + p[3]); s = fq_sum(s);
            rs[ai][m] = __builtin_amdgcn_rsqf(s * (1.0f / cfg::D) + cfg::EPS); }
}
template <bool DO_ROPE = true, bool DO_RS = true> struct EpiRopeT {
    static constexpr bool PERM = true, AFTER_DRAIN = false;
    bf16_t* O; const float* ssq; const float* rope;
    static __device__ __forceinline__ void store_pair(bf16_t* p, const f32x4 v0, const f32x4 v1) {
        float a0 = __builtin_bit_cast(float, cvt_pk_bf16(v0[0], v0[1])), a1 = __builtin_bit_cast(float, cvt_pk_bf16(v0[2], v0[3]));
        float b0 = __builtin_bit_cast(float, cvt_pk_bf16(v1[0], v1[1])), b1 = __builtin_bit_cast(float, cvt_pk_bf16(v1[2], v1[3]));
        pl32_swap(a0, b0); pl32_swap(a1, b1);
        u32x4 w; w.x = __builtin_bit_cast(unsigned, a0); w.y = __builtin_bit_cast(unsigned, a1); w.z = __builtin_bit_cast(unsigned, b0); w.w = __builtin_bit_cast(unsigned, b1);
        *(u32x4*)p = w;
    }
    __device__ __forceinline__ void operator()(const f32x4 (&acc)[2][2][4][2], const Unit& u, int wr, int wc, int fr, int fq) const {
        const int row0 = u.pm * BM + wr * 64 + fr;
        float rs[2][4];
        if (DO_RS) row_rs8(ssq, row0, fq, rs); else { _Pragma("unroll") for (int a_ = 0; a_ < 2; ++a_) _Pragma("unroll") for (int m_ = 0; m_ < 4; ++m_) rs[a_][m_] = 1.0f; }
        const int q8 = (wc & 1) * 4 + 2 * (fq & 1) + (fq >> 1);
        const int cst = (fq >> 1) * 32 + 8 * (2 * (wc & 1) + (fq & 1));
        const bool any_rope = DO_ROPE && ((u.pn < 4) || (u.pn >= 6));
#pragma unroll
        for (int ai = 0; ai < 2; ++ai) {
            f32x4 co[4], si[4];
            if (any_rope) {
#pragma unroll
                for (int m = 0; m < 4; ++m) { const int r = row0 + ai * HALF + m * 16; const float* cs = rope + (size_t)(r & (cfg::S - 1)) * 32 + 4 * q8;
                    co[m] = *(const f32x4*)cs; si[m] = *(const f32x4*)(cs + cfg::S * 32); }
            }
#pragma unroll
            for (int bj = 0; bj < 2; ++bj) {
                const int hb = u.pn * 4 + bj * 2 + (wc >> 1);
                const bool roped = DO_ROPE && ((hb < 16) || (hb >= 24 && hb < 34));
                const bool isq = (hb < 8) || (hb >= 24 && hb < 32);
                const float sc = isq ? cfg::C2 : 1.0f;
                bf16_t* pb = O + (size_t)(row0 + ai * HALF) * cfg::INW + hb * 64 + cst;
                if (roped) {
#pragma unroll
                    for (int m = 0; m < 4; ++m) { const float f = rs[ai][m] * sc; const f32x4 v0 = acc[ai][bj][m][0] * f, v1 = acc[ai][bj][m][1] * f;
                        store_pair(pb + (size_t)m * 16 * cfg::INW, v0 * co[m] - v1 * si[m], v1 * co[m] + v0 * si[m]); }
                } else {
#pragma unroll
                    for (int m = 0; m < 4; ++m) { const float f = rs[ai][m] * sc; store_pair(pb + (size_t)m * 16 * cfg::INW, acc[ai][bj][m][0] * f, acc[ai][bj][m][1] * f); }
                }
            }
        }
    }
};
typedef EpiRopeT<true, true> EpiRope;
struct EpiResid {
    static constexpr bool PERM = true, AFTER_DRAIN = false;
    bf16_t* x; float* ssq;
    __device__ __forceinline__ void operator()(const f32x4 (&acc)[2][2][4][2], const Unit& u, int wr, int wc, int fr, int fq) const {
        const int row0 = u.pm * BM + wr * 64 + fr, col0 = u.pn * BM + wc * 32 + 8 * fq;
#pragma unroll
        for (int ai = 0; ai < 2; ++ai) {
            u32x4 b[4][2];
#pragma unroll
            for (int m = 0; m < 4; ++m) { const bf16_t* p = x + (size_t)(row0 + ai * HALF + m * 16) * cfg::D + col0; b[m][0] = *(const u32x4*)p; b[m][1] = *(const u32x4*)(p + HALF); }
#pragma unroll
            for (int m = 0; m < 4; ++m) { const int r = row0 + ai * HALF + m * 16; bf16_t* p = x + (size_t)r * cfg::D + col0; float s = 0.f;
#pragma unroll
                for (int bj = 0; bj < 2; ++bj) { const u32x4 bb = b[m][bj]; const f32x4 a0 = acc[ai][bj][m][0], a1 = acc[ai][bj][m][1];
                    const float o0 = __builtin_bit_cast(float, bb.x << 16) + a0[0], o1 = __builtin_bit_cast(float, bb.x & 0xffff0000u) + a0[1], o2 = __builtin_bit_cast(float, bb.y << 16) + a0[2], o3 = __builtin_bit_cast(float, bb.y & 0xffff0000u) + a0[3];
                    const float o4 = __builtin_bit_cast(float, bb.z << 16) + a1[0], o5 = __builtin_bit_cast(float, bb.z & 0xffff0000u) + a1[1], o6 = __builtin_bit_cast(float, bb.w << 16) + a1[2], o7 = __builtin_bit_cast(float, bb.w & 0xffff0000u) + a1[3];
                    s += ((o0 * o0 + o1 * o1) + (o2 * o2 + o3 * o3)) + ((o4 * o4 + o5 * o5) + (o6 * o6 + o7 * o7));
                    u32x4 w; w.x = cvt_pk_bf16(o0, o1); w.y = cvt_pk_bf16(o2, o3); w.z = cvt_pk_bf16(o4, o5); w.w = cvt_pk_bf16(o6, o7);
                    *(u32x4*)(p + bj * HALF) = w; }
                s = fq_sum(s);
                if (fq == 0) ssq[(size_t)r * 16 + u.pn * 4 + wc] = s; }
        }
    }
};
typedef float f32x2 __attribute__((ext_vector_type(2)));
__device__ __forceinline__ f32x2 silu_mul2(f32x2 gs, f32x2 gu) {
    f32x2 e; e.x = __builtin_amdgcn_exp2f(gs.x); e.y = __builtin_amdgcn_exp2f(gs.y);
    const f32x2 d = e + 1.0f; f32x2 r; r.x = __builtin_amdgcn_rcpf(d.x); r.y = __builtin_amdgcn_rcpf(d.y);
    return gu * r;
}
template <bool RS> struct EpiSwiglu {
    static constexpr bool PERM = true, AFTER_DRAIN = false;
    bf16_t* H; const float* ssq;
    __device__ __forceinline__ void operator()(const f32x4 (&acc)[2][2][4][2], const Unit& u, int wr, int wc, int fr, int fq) const {
        const int row0 = u.pm * BM + wr * 64 + fr, col0 = u.pn * HALF + wc * 32 + 8 * fq;
        float rs[2][4];
        if (RS) row_rs8(ssq, row0, fq, rs);
#pragma unroll
        for (int ai = 0; ai < 2; ++ai)
#pragma unroll
            for (int m = 0; m < 4; ++m) { const int r = row0 + ai * HALF + m * 16; const float f = RS ? rs[ai][m] : 1.0f, fe = -cfg::LOG2E * f, ff = f * f;
                unsigned w[4];
#pragma unroll
                for (int n = 0; n < 2; ++n) { const f32x4 g = acc[ai][0][m][n], up = acc[ai][1][m][n];
                    const f32x2 ga = {g[0], g[1]}, gb = {g[2], g[3]}, ua = {up[0], up[1]}, ub = {up[2], up[3]};
                    const f32x2 ha = silu_mul2(ga * fe, RS ? (ga * ua) * ff : ga * ua), hb = silu_mul2(gb * fe, RS ? (gb * ub) * ff : gb * ub);
                    w[2 * n] = cvt_pk_bf16(ha.x, ha.y); w[2 * n + 1] = cvt_pk_bf16(hb.x, hb.y); }
                u32x4 wv; wv.x = w[0]; wv.y = w[1]; wv.z = w[2]; wv.w = w[3];
                *(u32x4*)(H + (size_t)r * cfg::FF + col0) = wv; }
    }
};
struct EpiY {
    static constexpr bool PERM = true, AFTER_DRAIN = false;
    bf16_t* Y; const float* gate;
    __device__ __forceinline__ void operator()(const f32x4 (&acc)[2][2][4][2], const Unit& u, int wr, int wc, int fr, int fq) const {
        const int row0 = u.pm * BM + wr * 64 + fr, col0 = u.pn * BM + wc * 32 + 8 * fq;
        float gt[2][4];
#pragma unroll
        for (int ai = 0; ai < 2; ++ai)
#pragma unroll
            for (int m = 0; m < 4; ++m) gt[ai][m] = gate[row0 + ai * HALF + m * 16];
#pragma unroll
        for (int ai = 0; ai < 2; ++ai)
#pragma unroll
            for (int m = 0; m < 4; ++m) { const int r = row0 + ai * HALF + m * 16; const float f = gt[ai][m];
#pragma unroll
                for (int bj = 0; bj < 2; ++bj) { const f32x4 v0 = acc[ai][bj][m][0] * f, v1 = acc[ai][bj][m][1] * f;
                    u32x4 w; w.x = cvt_pk_bf16(v0[0], v0[1]); w.y = cvt_pk_bf16(v0[2], v0[3]); w.z = cvt_pk_bf16(v1[0], v1[1]); w.w = cvt_pk_bf16(v1[2], v1[3]);
                    *(u32x4*)(Y + (size_t)r * cfg::D + col0 + bj * HALF) = w; } }
    }
};
struct EpiNull {
    static constexpr bool PERM = true, AFTER_DRAIN = false;
    __device__ __forceinline__ void operator()(const f32x4 (&acc)[2][2][4][2], const Unit& u, int wr, int wc, int fr, int fq) const {
#pragma unroll
        for (int ai = 0; ai < 2; ++ai)
#pragma unroll
            for (int bj = 0; bj < 2; ++bj)
#pragma unroll
                for (int m = 0; m < 4; ++m)
#pragma unroll
                    for (int n = 0; n < 2; ++n) asm volatile("" :: "v"(acc[ai][bj][m][n]));
    }
};
struct EpiRaw {
    static constexpr bool PERM = true, AFTER_DRAIN = false;
    bf16_t* H;
    __device__ __forceinline__ void operator()(const f32x4 (&acc)[2][2][4][2], const Unit& u, int wr, int wc, int fr, int fq) const {
        const int row0 = u.pm * BM + wr * 64 + fr, col0 = u.pn * HALF + wc * 32 + 8 * fq;
#pragma unroll
        for (int ai = 0; ai < 2; ++ai)
#pragma unroll
            for (int m = 0; m < 4; ++m) { const int r = row0 + ai * HALF + m * 16;
                const f32x4 g0 = acc[ai][0][m][0] + acc[ai][1][m][0], g1 = acc[ai][0][m][1] + acc[ai][1][m][1];
                u32x4 w; w.x = cvt_pk_bf16(g0[0], g0[1]); w.y = cvt_pk_bf16(g0[2], g0[3]); w.z = cvt_pk_bf16(g1[0], g1[1]); w.w = cvt_pk_bf16(g1[2], g1[3]);
                *(u32x4*)(H + (size_t)r * cfg::FF + col0) = w; }
    }
};
struct GroupedOrder : StaticOrder {
    const PG8_LAS int* segb;
    __device__ __forceinline__ bool next(int i, Unit& u) const {
        if (!StaticOrder::next(i, u)) return false;
        const int r = u.pm * BM; int e = 0;
#pragma unroll
        for (int k = 1; k < 8; ++k) e += (r >= segb[k]) ? 1 : 0;
        u.eb = e; return true;
    }
};

struct TailOrder {
    int npair, G, c; const PG8_LAS int* segb;
    __device__ __forceinline__ bool next(int i, Unit& u) const {
        const int L = i * G + c; if (L >= npair * cfg::KSPLIT) return false;
        const int q = L / cfg::KSPLIT, s = L % cfg::KSPLIT; u.pm = cfg::MAINROWS / BM + (q >> 2); u.pn = q & 3; u.ko = s * (cfg::FF / cfg::KSPLIT);
        const int r = u.pm * BM; int e = 0;
#pragma unroll
        for (int k = 1; k < 8; ++k) e += (r >= segb[k]) ? 1 : 0;
        u.eb = e; return true;
    }
    __device__ __forceinline__ void a_ready(const Unit&) const {}
    __device__ __forceinline__ void done(const Unit&) const {}
};
struct EpiPart {
    static constexpr bool PERM = true, AFTER_DRAIN = false;
    bf16_t* PT;
    __device__ __forceinline__ void operator()(const f32x4 (&acc)[2][2][4][2], const Unit& u, int wr, int wc, int fr, int fq) const {
        const int row0 = u.pm * BM - cfg::MAINROWS + wr * 64 + fr, col0 = u.pn * BM + wc * 32 + 8 * fq, s = u.ko / (cfg::FF / cfg::KSPLIT);
        bf16_t* base = PT + (size_t)s * cfg::TAILROWS * cfg::D;
#pragma unroll
        for (int ai = 0; ai < 2; ++ai)
#pragma unroll
            for (int m = 0; m < 4; ++m) { const int r = row0 + ai * HALF + m * 16;
#pragma unroll
                for (int bj = 0; bj < 2; ++bj) { const f32x4 v0 = acc[ai][bj][m][0], v1 = acc[ai][bj][m][1];
                    u32x4 w; w.x = cvt_pk_bf16(v0[0], v0[1]); w.y = cvt_pk_bf16(v0[2], v0[3]); w.z = cvt_pk_bf16(v1[0], v1[1]); w.w = cvt_pk_bf16(v1[2], v1[3]);
                    *(u32x4*)(base + (size_t)r * cfg::D + col0 + bj * HALF) = w; } }
    }
};

template <class Epi, class Sched, bool ALIGN_EPI = false, bool SP2 = false>
__device__ __forceinline__ void gemm_phase(PG8_LAS unsigned char* lds, const Gemm g, const Sched& S, const Epi& E, const int tid_in) {
    const int tid = tid_in, wid = __builtin_amdgcn_readfirstlane(tid >> 6), lane = tid & 63, wr = wid >> 2, wc = wid & 3, fr = lane & 15, fq = lane >> 4;
    const int K = g.K, nt = K / BK, LD = g.ld;
    unsigned voffA[2], voffB[2];
#pragma unroll
    for (int i = 0; i < 2; ++i) { int R, C; stage_rc(tid * 16 + i * 8192, R, C); const int Rb = Epi::PERM ? ((R & ~31) + perm32(R & 31)) : R;
        voffA[i] = (unsigned)(R * LD + C) * 2u; voffB[i] = (unsigned)(Rb * LD + C) * 2u; }
    const size_t kstep = (size_t)(BK * 2);
    const size_t hstep = (size_t)HALF * LD * 2;
    const size_t tstep = 2 * hstep;
    const unsigned ldsw = (unsigned)wid * 1024u;
    const int aoff = lds_byte(wr * 64 + fr, fq * 8), boff = lds_byte(wc * 32 + fr, fq * 8);
#define PG8_SA(b, h) (((b) * 2 + (h)) * HTB)
#define PG8_SB(b, h) ((4 + (b) * 2 + (h)) * HTB)
#define PG8_STAGE(bufoff, gbase, voff) do { _Pragma("unroll") for (int _i = 0; _i < 2; ++_i) \
        __builtin_amdgcn_global_load_lds((const unsigned*)((const char*)(gbase) + (voff)[_i]), (PG8_LAS unsigned*)(lds + (bufoff) + ldsw + _i * 8192), 16, 0, 0); } while (0)
#define PG8_LDA(dst, b, h) do { _Pragma("unroll") for (int m = 0; m < 4; ++m) _Pragma("unroll") for (int k = 0; k < 2; ++k) dst[m][k] = *(const PG8_LAS bf16x8*)(lds + PG8_SA(b, h) + aoff + m * 2048 + k * 1024); } while (0)
#define PG8_LDB(dst, b, h) do { _Pragma("unroll") for (int n = 0; n < 2; ++n) _Pragma("unroll") for (int k = 0; k < 2; ++k) dst[n][k] = *(const PG8_LAS bf16x8*)(lds + PG8_SB(b, h) + boff + n * 2048 + k * 1024); } while (0)
#define PG8_MMA(ai, bj, At, Bt) do { __builtin_amdgcn_s_setprio(1); _Pragma("unroll") for (int m = 0; m < 4; ++m) _Pragma("unroll") for (int n = 0; n < 2; ++n) _Pragma("unroll") for (int k = 0; k < 2; ++k) \
        acc[ai][bj][m][n] = __builtin_amdgcn_mfma_f32_16x16x32_bf16(Bt[n][k], At[m][k], acc[ai][bj][m][n], 0, 0, 0); __builtin_amdgcn_s_setprio(0); } while (0)
#define PG8_WAIT_V(n) asm volatile("s_waitcnt vmcnt(" #n ")" ::: "memory")
#define PG8_WAIT_L(n) asm volatile("s_waitcnt lgkmcnt(" #n ")" ::: "memory")
#define PG8_BAR __builtin_amdgcn_s_barrier()
#define PG8_SCHED __builtin_amdgcn_sched_barrier(0)
    Unit cur, nxt; int ui = 0;
    if (!S.next(0, cur)) return;
    f32x4 acc[2][2][4][2];
#pragma unroll
    for (int a = 0; a < 2; ++a)
#pragma unroll
        for (int b = 0; b < 2; ++b)
#pragma unroll
            for (int m = 0; m < 4; ++m)
#pragma unroll
                for (int n = 0; n < 2; ++n) acc[a][b][m][n] = (f32x4){0.f, 0.f, 0.f, 0.f};
    bf16x8 At[4][2], B0[2][2], B1[2][2];
    const char* cA = (const char*)g.A + (size_t)cur.pm * tstep + (size_t)cur.ko * 2; const char* cB = (const char*)g.Bt + (size_t)cur.eb * g.bstride + (size_t)cur.pn * tstep + (size_t)cur.ko * 2;
    S.a_ready(cur);
    if constexpr (SP2) {
        PG8_STAGE(PG8_SB(0, 0), cB, voffB); PG8_STAGE(PG8_SB(0, 1), cB + hstep, voffB); PG8_STAGE(PG8_SA(0, 0), cA, voffA); PG8_STAGE(PG8_SA(0, 1), cA + hstep, voffA);
        if (wr == 1) PG8_BAR;
        PG8_WAIT_V(2); PG8_BAR;
        PG8_STAGE(PG8_SB(1, 0), cB + kstep, voffB); PG8_STAGE(PG8_SA(1, 0), cA + kstep, voffA); PG8_STAGE(PG8_SB(1, 1), cB + hstep + kstep, voffB);
        PG8_WAIT_V(6); PG8_BAR;
    } else {
        PG8_STAGE(PG8_SB(0, 0), cB, voffB); PG8_STAGE(PG8_SA(0, 0), cA, voffA); PG8_STAGE(PG8_SB(0, 1), cB + hstep, voffB); PG8_STAGE(PG8_SA(0, 1), cA + hstep, voffA);
        if (wr == 1) PG8_BAR;
        PG8_WAIT_V(4); PG8_BAR;
        PG8_STAGE(PG8_SB(1, 0), cB + kstep, voffB); PG8_STAGE(PG8_SA(1, 0), cA + kstep, voffA); PG8_STAGE(PG8_SB(1, 1), cB + hstep + kstep, voffB);
        PG8_WAIT_V(6); PG8_BAR;
    }
    for (;;) {
        const bool has_next = S.next(ui + 1, nxt);
        const char* nA = has_next ? (const char*)g.A + (size_t)nxt.pm * tstep + (size_t)nxt.ko * 2 : cA; const char* nB = has_next ? (const char*)g.Bt + (size_t)nxt.eb * g.bstride + (size_t)nxt.pn * tstep + (size_t)nxt.ko * 2 : cB;
        for (int t = 0; t < nt; t += 2) {
            const bool last = (t == nt - 2);
            const char* a1 = cA + (size_t)(t + 1) * kstep;
            const char* a2 = last ? nA : cA + (size_t)(t + 2) * kstep; const char* b2 = last ? nB : cB + (size_t)(t + 2) * kstep;
            const char* a3 = a2 + kstep; const char* b3 = b2 + kstep;
            if (last && has_next) S.a_ready(nxt);
            if constexpr (SP2) {
            PG8_LDB(B0, 0, 0); PG8_LDB(B1, 0, 1); PG8_SCHED; PG8_LDA(At, 0, 0); PG8_STAGE(PG8_SA(1, 1), a1 + hstep, voffA);
            PG8_WAIT_V(8); PG8_WAIT_L(0); PG8_BAR; PG8_MMA(0, 0, At, B0); PG8_MMA(0, 1, At, B1); PG8_BAR; PG8_SCHED;
            PG8_LDA(At, 0, 1); PG8_STAGE(PG8_SB(0, 0), b2, voffB); PG8_STAGE(PG8_SB(0, 1), b2 + hstep, voffB); PG8_STAGE(PG8_SA(0, 0), a2, voffA);
            PG8_WAIT_V(8); PG8_WAIT_L(0); PG8_BAR; PG8_MMA(1, 0, At, B0); PG8_MMA(1, 1, At, B1); PG8_BAR; PG8_SCHED;
            PG8_LDB(B0, 1, 0); PG8_LDB(B1, 1, 1); PG8_SCHED; PG8_LDA(At, 1, 0); PG8_STAGE(PG8_SA(0, 1), a2 + hstep, voffA);
            PG8_WAIT_V(8); PG8_WAIT_L(0); PG8_BAR; PG8_MMA(0, 0, At, B0); PG8_MMA(0, 1, At, B1); PG8_BAR; PG8_SCHED;
            PG8_LDA(At, 1, 1); PG8_STAGE(PG8_SB(1, 0), b3, voffB); PG8_STAGE(PG8_SB(1, 1), b3 + hstep, voffB); PG8_STAGE(PG8_SA(1, 0), a3, voffA);
            PG8_WAIT_V(8); PG8_WAIT_L(0); PG8_BAR; PG8_MMA(1, 0, At, B0); PG8_MMA(1, 1, At, B1); PG8_BAR; PG8_SCHED;
            } else {
            PG8_LDB(B0, 0, 0); PG8_SCHED; PG8_LDA(At, 0, 0); PG8_STAGE(PG8_SA(1, 1), a1 + hstep, voffA);
            PG8_WAIT_L(8); PG8_BAR; PG8_WAIT_L(0); PG8_MMA(0, 0, At, B0); PG8_BAR; PG8_SCHED;
            PG8_LDB(B1, 0, 1); PG8_STAGE(PG8_SB(0, 0), b2, voffB);
            PG8_BAR; PG8_WAIT_L(0); PG8_MMA(0, 1, At, B1); PG8_BAR;
            PG8_LDA(At, 0, 1); PG8_STAGE(PG8_SA(0, 0), a2, voffA);
            PG8_BAR; PG8_WAIT_L(0); PG8_MMA(1, 0, At, B0); PG8_BAR; PG8_SCHED;
            PG8_STAGE(PG8_SB(0, 1), b2 + hstep, voffB);
            PG8_WAIT_V(6); PG8_BAR; PG8_MMA(1, 1, At, B1); PG8_BAR;
            PG8_LDB(B0, 1, 0); PG8_SCHED; PG8_LDA(At, 1, 0); PG8_STAGE(PG8_SA(0, 1), a2 + hstep, voffA);
            PG8_WAIT_L(8); PG8_BAR; PG8_WAIT_L(0); PG8_MMA(0, 0, At, B0); PG8_BAR; PG8_SCHED;
            PG8_LDB(B1, 1, 1); PG8_STAGE(PG8_SB(1, 0), b3, voffB);
            PG8_BAR; PG8_WAIT_L(0); PG8_MMA(0, 1, At, B1); PG8_BAR;
            PG8_LDA(At, 1, 1); PG8_STAGE(PG8_SA(1, 0), a3, voffA);
            PG8_BAR; PG8_WAIT_L(0); PG8_MMA(1, 0, At, B0); PG8_BAR; PG8_SCHED;
            PG8_STAGE(PG8_SB(1, 1), b3 + hstep, voffB);
            PG8_WAIT_V(6); PG8_BAR; PG8_MMA(1, 1, At, B1); PG8_BAR;
            }
        }
        if constexpr (ALIGN_EPI) { if (wr == 0) PG8_BAR; }
        if constexpr (!Epi::AFTER_DRAIN) { E(acc, cur, wr, wc, fr, fq); S.done(cur); }
        if (!has_next) break;
#pragma unroll
        for (int a = 0; a < 2; ++a)
#pragma unroll
            for (int b = 0; b < 2; ++b)
#pragma unroll
                for (int m = 0; m < 4; ++m)
#pragma unroll
                    for (int n = 0; n < 2; ++n) acc[a][b][m][n] = (f32x4){0.f, 0.f, 0.f, 0.f};
        cur = nxt; cA = nA; cB = nB; ++ui;
        if constexpr (ALIGN_EPI) { if (wr == 1) PG8_BAR; }
    }
    PG8_WAIT_V(0);
    if constexpr (!ALIGN_EPI) { if (wr == 0) PG8_BAR; }
    PG8_BAR;
    if constexpr (Epi::AFTER_DRAIN) { E.fused(acc, cur, wr, wc, fr, fq, lds, wid, lane); S.done(cur); }
#undef PG8_SA
#undef PG8_SB
#undef PG8_STAGE
#undef PG8_LDA
#undef PG8_LDB
#undef PG8_MMA
#undef PG8_WAIT_V
#undef PG8_WAIT_L
#undef PG8_BAR
#undef PG8_SCHED
}
}


using namespace cfg;
constexpr size_t MiB = 1u << 20;
constexpr size_t WS_CTL = 0, CTL_ZERO_BYTES = 1 * MiB;
constexpr size_t WS_ROPE = 1 * MiB;
constexpr size_t WS_SSQA = 3 * MiB;
constexpr size_t WS_SSQF = 5 * MiB;
constexpr size_t WS_ROUTE = 7 * MiB;
constexpr size_t WS_BLKCNT = 8 * MiB;
constexpr size_t WS_ROWGATE = 9 * MiB;
constexpr size_t WS_WIN = 16 * MiB;
constexpr size_t WS_WOUT = 34 * MiB;
constexpr size_t WS_WGU = 42 * MiB;
constexpr size_t WS_WDN = 70 * MiB;
constexpr size_t WS_MGU = 84 * MiB;
constexpr size_t WS_MDN = 196 * MiB;
constexpr size_t WS_XN = 252 * MiB;
constexpr size_t WS_PROJ = 316 * MiB;
constexpr size_t WS_OPART = 460 * MiB;
constexpr size_t WS_LSE = 588 * MiB;
constexpr size_t WS_MIX = 592 * MiB;
constexpr size_t WS_H = 316 * MiB;
constexpr size_t WS_AP = 778 * MiB;
constexpr size_t WS_PT = 910 * MiB;
constexpr size_t WS_END = WS_PT + (size_t)KSPLIT * TAILROWS * D * 2;
static_assert(WS_H + (size_t)MAXROWS * FF * 2 <= WS_AP && WS_AP + (size_t)MAXROWS * D * 2 <= WS_END && WS_MIX + (size_t)M * D * 2 <= WS_AP, "d_ws map");
static_assert(WS_ROWGATE + (size_t)MAXROWS * 4 <= WS_WIN && WS_LSE + (size_t)3 * M * 8 * 4 <= WS_MIX, "d_ws map 2");
constexpr int CW_BAR = 4096;
constexpr int LDS_BYTES = 147456;
constexpr int RING_OFF = 0, RING_BYTES = 131072;
constexpr int LDSCTL_OFF = LDS_BYTES - 1024, MISC_OFF = LDSCTL_OFF + 320;
constexpr int NWAVES = 8;

#define GAS __attribute__((address_space(1)))
#define LAS __attribute__((address_space(3)))
typedef unsigned short bf16;
typedef unsigned v4u __attribute__((ext_vector_type(4)));
typedef float f32x4 __attribute__((ext_vector_type(4)));
typedef short bf16x8 __attribute__((ext_vector_type(8)));
typedef GAS unsigned gu32;
typedef GAS unsigned long long gu64;
#define RLX_AGENT __ATOMIC_RELAXED, __HIP_MEMORY_SCOPE_AGENT
#define LDS_WAIT() asm volatile("s_waitcnt lgkmcnt(0)" ::: "memory")
#define VM_WAIT() asm volatile("s_waitcnt vmcnt(0)" ::: "memory")
__device__ __forceinline__ unsigned long long rt() { return __builtin_amdgcn_s_memrealtime(); }
__device__ __forceinline__ unsigned f2bf(float f) { unsigned u = __builtin_bit_cast(unsigned, f); return (u + 0x7fffu + ((u >> 16) & 1u)) >> 16; }
__device__ __forceinline__ unsigned pk2(float lo, float hi) { return f2bf(lo) | (f2bf(hi) << 16); }

#define XB_TMO      128
#define XB_XCNT(j)  (256  + 64 * (j))
#define XB_XSUB(j)  (1280 + 64 * (j))
#define XB_XGEN(j)  (2304 + 64 * (j))
#define XB_TOP      3328
#define XB_TOPGEN   3392
#define XCD_BAR_WORDS 3456
#define XB_SPIN_CAP (1u << 18)

__device__ __forceinline__ unsigned xb_ld(unsigned* p)              { return __hip_atomic_load(p, __ATOMIC_RELAXED, __HIP_MEMORY_SCOPE_AGENT); }
__device__ __forceinline__ unsigned xb_add(unsigned* p, unsigned v) { return __hip_atomic_fetch_add(p, v, __ATOMIC_RELAXED, __HIP_MEMORY_SCOPE_AGENT); }
__device__ __forceinline__ unsigned xb_xcc_id() { return (unsigned)__builtin_amdgcn_s_getreg((3 << 11) | 20) & 0xFu; }
#define XB_SPIN(cond, bar) do { unsigned _sp = 0; while (cond) { __builtin_amdgcn_s_sleep(1); \
    if ((++_sp & 255u) == 0u) { if (xb_ld(&(bar)[XB_TMO])) break; if (_sp > XB_SPIN_CAP) { atomicAdd(&(bar)[XB_TMO], 1u); break; } } } } while (0)

struct XcdBarrier {
    unsigned* bar; unsigned x;
    volatile LAS unsigned* st;
};

__device__ __forceinline__ XcdBarrier xcd_barrier_post(unsigned* bar, volatile LAS unsigned* st, const int tidx) {
    XcdBarrier b; b.bar = bar; b.x = xb_xcc_id(); b.st = st;
    if (tidx == 0) (void)xb_add(&bar[XB_XCNT(b.x)], 1u);
    return b;
}
__device__ __forceinline__ void xcd_barrier_complete(unsigned* bar, unsigned x, unsigned& nloc, unsigned& nx) {
    const unsigned G = gridDim.x * gridDim.y * gridDim.z;
    unsigned sum, cnt, mine, sp = 0u;
    for (;;) {
        sum = 0u; cnt = 0u; mine = 0u;
#pragma unroll
        for (unsigned j = 0; j < 16; ++j) { const unsigned c = xb_ld(&bar[XB_XCNT(j)]); sum += c; cnt += (c > 0u) ? 1u : 0u; mine = (j == x) ? c : mine; }
        if (sum == G) break;
        __builtin_amdgcn_s_sleep(1);
        if ((++sp & 255u) == 0u) { if (xb_ld(&bar[XB_TMO])) break; if (sp > XB_SPIN_CAP) { atomicAdd(&bar[XB_TMO], 1u); break; } }
    }
    nloc = mine > 0u ? mine : 1u; nx = cnt > 0u ? cnt : 1u;
}

__device__ __forceinline__ void xcd_barrier(const XcdBarrier& b, const int tidx) {
    asm volatile("s_waitcnt vmcnt(0)" ::: "memory");
    __syncthreads();
    if (tidx == 0) {
        unsigned* bar = b.bar;
        __builtin_amdgcn_s_waitcnt(0);
        unsigned nloc = b.st[0], nx = b.st[1];
        if (nloc == 0u) { xcd_barrier_complete(bar, b.x, nloc, nx); b.st[0] = nloc; b.st[1] = nx; }
        const unsigned old = xb_add(&bar[XB_XSUB(b.x)], 1u);
        const unsigned gen = old / nloc;
        if (old + 1u == (gen + 1u) * nloc) {
            __builtin_amdgcn_fence(__ATOMIC_RELEASE, "agent");
            asm volatile("s_waitcnt vmcnt(0)" ::: "memory");
            const unsigned og = xb_add(&bar[XB_TOP], 1u);
            const unsigned tg = og / nx;
            if (og + 1u == (tg + 1u) * nx) xb_add(&bar[XB_TOPGEN], 1u);
            else XB_SPIN(xb_ld(&bar[XB_TOPGEN]) == tg, bar);
            __builtin_amdgcn_fence(__ATOMIC_ACQUIRE, "agent");
            xb_add(&bar[XB_XGEN(b.x)], 1u);
            asm volatile("s_waitcnt vmcnt(0)" ::: "memory");
        } else {
            XB_SPIN(xb_ld(&bar[XB_XGEN(b.x)]) == gen, bar);
            __builtin_amdgcn_fence(__ATOMIC_ACQUIRE, "agent");
            asm volatile("s_waitcnt vmcnt(0)" ::: "memory");
        }
    }
    __syncthreads();
}


__device__ __forceinline__ float wave_sum(float v) {
    v += swz_xor<1>(v); v += swz_xor<2>(v); v += swz_xor<4>(v); v += swz_xor<8>(v); v += swz_xor<16>(v);
    return xor32_sum(v);
}
__device__ __forceinline__ int wave_sum_i(int v) {
    return (int)(wave_sum((float)v) + 0.5f);
}
__device__ __forceinline__ float bf2f(unsigned short b) { return __builtin_bit_cast(float, (unsigned)b << 16); }
__device__ __forceinline__ float bflo(unsigned w) { return __builtin_bit_cast(float, w << 16); }
__device__ __forceinline__ float bfhi(unsigned w) { return __builtin_bit_cast(float, w & 0xffff0000u); }
typedef unsigned u32x2v __attribute__((ext_vector_type(2)));

struct Ctx { LAS unsigned char* lds; int tid, lane, wave, gw, ngw; };

__device__ __forceinline__ int rowmap(int mode, int n) {
    if (mode == 1) { const int hb = n >> 6, w = n & 63, nn = w >> 5, i = w & 31, gi = i >> 2, fq = ((gi & 1) << 1) | ((gi >> 1) & 1);
        return (hb << 6) + 32 * (gi >> 2) + 8 * fq + 4 * nn + (i & 3); }
    if (mode == 2) return 256 * (n >> 7) + (n & 127);
    if (mode == 3) return 256 * (n >> 7) + 128 + (n & 127);
    return n;
}
struct ConvJob { const float* W; bf16* WT; const float* gain; int K, N, mode, item; };
__device__ __forceinline__ void tr_load(const ConvJob& J, int lane, f32x4 (&v)[8]) {
    const int nblk = J.N / 32, kb = J.item / nblk, nb = J.item % nblk, k0 = 64 * kb, n0 = 32 * nb, lr = lane >> 3, lc = lane & 7;
#pragma unroll
    for (int i = 0; i < 8; ++i) v[i] = *(const GAS f32x4*)(J.W + (size_t)(k0 + 8 * i + lr) * J.N + n0 + 4 * lc);
    if (J.gain) {
#pragma unroll
        for (int i = 0; i < 8; ++i) v[i] = v[i] * J.gain[k0 + 8 * i + lr];
    }
}
__device__ __forceinline__ void tr_store(const ConvJob& J, int lane, LAS float* scr, const f32x4 (&v)[8]) {
    const int nblk = J.N / 32, kb = J.item / nblk, nb = J.item % nblk, k0 = 64 * kb, n0 = 32 * nb, lr = lane >> 3, lc = lane & 7;
#pragma unroll
    for (int i = 0; i < 8; ++i) { LAS float* d = scr + (8 * i + lr) * 33 + 4 * lc; d[0] = v[i][0]; d[1] = v[i][1]; d[2] = v[i][2]; d[3] = v[i][3]; }
    LDS_WAIT(); asm volatile("" ::: "memory");
    const int c = lane & 7;
#pragma unroll
    for (int j = 0; j < 4; ++j) { const int n = (lane >> 3) + 8 * j; const LAS float* s = scr + (8 * c) * 33 + n;
        v4u o; o.x = pk2(s[0 * 33], s[1 * 33]); o.y = pk2(s[2 * 33], s[3 * 33]); o.z = pk2(s[4 * 33], s[5 * 33]); o.w = pk2(s[6 * 33], s[7 * 33]);
        *(GAS v4u*)(J.WT + (size_t)rowmap(J.mode, n0 + n) * J.K + k0 + 8 * c) = o; }
    LDS_WAIT(); asm volatile("" ::: "memory");
}
constexpr int IT_FF = (D / 64) * (FF / 32), IT_IN = (D / 64) * (INW / 32), IT_OUT = (D / 64) * (D / 32);
static_assert((FF / 64) * (D / 32) == IT_FF, "items");
constexpr int MOE_ITEMS = NE * 3 * IT_FF, PRO_ITEMS = DEPTH * (IT_IN + IT_OUT) + 6 * IT_FF;
struct ConvSrc { const float *w_in, *w_out, *attn_norm, *ffn_norm, *dwg, *dwu, *dwd; bf16 *WIN_, *WOUT_, *WGU_, *WDN_; };
__device__ __forceinline__ ConvJob conv_decode_moe(int f, const float* wg, const float* wu, const float* wd, bf16* MGU_, bf16* MDN_) {
    const int job = f / IT_FF, e = job / 3, which = job % 3; ConvJob J; J.item = f % IT_FF; J.gain = nullptr;
    if (which == 2) { J.W = wd + (size_t)e * FF * D; J.WT = MDN_ + (size_t)e * D * FF; J.K = FF; J.N = D; J.mode = 0; }
    else { J.W = (which ? wu : wg) + (size_t)e * D * FF; J.WT = MGU_ + (size_t)e * 2 * FF * D; J.K = D; J.N = FF; J.mode = 2 + which; }
    return J;
}
__device__ __forceinline__ ConvJob conv_decode_pro(int f, const ConvSrc& S) {
    ConvJob J;
    if (f < DEPTH * IT_IN) { const int l = f / IT_IN; J.item = f % IT_IN; J.W = S.w_in + (size_t)l * D * INW; J.WT = S.WIN_ + (size_t)l * INW * D; J.gain = S.attn_norm + l * D; J.K = D; J.N = INW; J.mode = 1; return J; }
    f -= DEPTH * IT_IN;
    if (f < DEPTH * IT_OUT) { const int l = f / IT_OUT; J.item = f % IT_OUT; J.W = S.w_out + (size_t)l * D * D; J.WT = S.WOUT_ + (size_t)l * D * D; J.gain = nullptr; J.K = D; J.N = D; J.mode = 0; return J; }
    f -= DEPTH * IT_OUT;
    const int job = f / IT_FF, j = job / 3, which = job % 3; J.item = f % IT_FF;
    if (which == 2) { J.W = S.dwd + (size_t)j * FF * D; J.WT = S.WDN_ + (size_t)j * D * FF; J.gain = nullptr; J.K = FF; J.N = D; J.mode = 0; }
    else { J.W = (which ? S.dwu : S.dwg) + (size_t)j * D * FF; J.WT = S.WGU_ + (size_t)j * 2 * FF * D; J.gain = S.ffn_norm + (2 * j) * D; J.K = D; J.N = FF; J.mode = 2 + which; }
    return J;
}
#define CONV_LOOP(total, DECODE) do { LAS float* scr_ = (LAS float*)(C.lds + RING_OFF + C.wave * 17408); \
    for (int f_ = C.gw; f_ < (total); f_ += 2 * C.ngw) { f32x4 va_[8], vb_[8]; const bool two_ = f_ + C.ngw < (total); \
        const ConvJob Ja_ = DECODE(f_); tr_load(Ja_, C.lane, va_); \
        ConvJob Jb_ = Ja_; if (two_) { Jb_ = DECODE(f_ + C.ngw); tr_load(Jb_, C.lane, vb_); } \
        tr_store(Ja_, C.lane, scr_, va_); if (two_) tr_store(Jb_, C.lane, scr_ + 2176, vb_); } } while (0)
__device__ __forceinline__ void convert_moe_layer(const Ctx& C, const float* wg, const float* wu, const float* wd, bf16* MGU_, bf16* MDN_) {
#define DEC_MOE(f) conv_decode_moe((f), wg, wu, wd, MGU_, MDN_)
    CONV_LOOP(MOE_ITEMS, DEC_MOE);
#undef DEC_MOE
}
__device__ __forceinline__ void convert_prologue(const Ctx& C, const ConvSrc& S) {
#define DEC_PRO(f) conv_decode_pro((f), S)
    CONV_LOOP(PRO_ITEMS, DEC_PRO);
#undef DEC_PRO
}

__device__ __forceinline__ void ld16bf(const bf16* p, float (&v)[16]) {
    const v4u a = *(const GAS v4u*)p, b = *(const GAS v4u*)(p + 8);
    v[0] = bflo(a.x); v[1] = bfhi(a.x); v[2] = bflo(a.y); v[3] = bfhi(a.y); v[4] = bflo(a.z); v[5] = bfhi(a.z); v[6] = bflo(a.w); v[7] = bfhi(a.w);
    v[8] = bflo(b.x); v[9] = bfhi(b.x); v[10] = bflo(b.y); v[11] = bfhi(b.y); v[12] = bflo(b.z); v[13] = bfhi(b.z); v[14] = bflo(b.w); v[15] = bfhi(b.w);
}
__device__ __forceinline__ void st16bf(bf16* p, const float (&v)[16], float f) {
    v4u a, b; a.x = pk2(v[0] * f, v[1] * f); a.y = pk2(v[2] * f, v[3] * f); a.z = pk2(v[4] * f, v[5] * f); a.w = pk2(v[6] * f, v[7] * f);
    b.x = pk2(v[8] * f, v[9] * f); b.y = pk2(v[10] * f, v[11] * f); b.z = pk2(v[12] * f, v[13] * f); b.w = pk2(v[14] * f, v[15] * f);
    *(GAS v4u*)p = a; *(GAS v4u*)(p + 8) = b;
}
__device__ __forceinline__ void attn_run(const bf16* PROJ, int rowb, int t, int d, int nk, int kcol, int vcol, const float (&q)[16], float (&o)[16], float& mx, float& l) {
    for (int k = 0; k < nk; ++k) {
        const int j = t - d * k; if (j < 0) break;
        const bf16* kr = PROJ + (size_t)(rowb + j) * INW;
        float kv[16]; ld16bf(kr + kcol, kv);
        float s = 0.f;
#pragma unroll
        for (int i = 0; i < 16; ++i) s += q[i] * kv[i];
        s += swz_xor<1>(s); s += swz_xor<2>(s);
        if (s > mx) { const float sc = __builtin_amdgcn_exp2f(mx - s); l *= sc;
#pragma unroll
            for (int i = 0; i < 16; ++i) o[i] *= sc;
            mx = s; }
        const float p = __builtin_amdgcn_exp2f(s - mx); l += p;
        float vv[16]; ld16bf(kr + vcol, vv);
#pragma unroll
        for (int i = 0; i < 16; ++i) o[i] += p * vv[i];
    }
}
__device__ __forceinline__ void attn_naive(const Ctx& C, const bf16* PROJ, bf16* OPART, float* LSE, const float* sinks) {
    const int grp = (blockIdx.x * 512 + C.tid) >> 2, sub = C.tid & 3, ngrp = gridDim.x * 128;
    for (int it = grp; it < M * 16; it += ngrp) {
        const int hh = it / M, row = it % M, t = row & (S - 1), rowb = row - t;
        if (hh < 8) {
            float q[16]; ld16bf(PROJ + (size_t)row * INW + QA_OFF + hh * 64 + sub * 16, q);
#pragma unroll 1
            for (int br = 0; br < 3; ++br) {
                const int d = (br == 0) ? 1 : (br == 1) ? 4 : 16;
                float o[16]; float mx = -INFINITY, l = 0.f;
#pragma unroll
                for (int i = 0; i < 16; ++i) o[i] = 0.f;
                attn_run(PROJ, rowb, t, d, 129, KA_OFF + hh * 64 + sub * 16, VA_OFF + hh * 64 + sub * 16, q, o, mx, l);
                st16bf(OPART + ((size_t)br * M + row) * 512 + hh * 64 + sub * 16, o, 1.0f / l);
                if (sub == 0) LSE[((size_t)br * M + row) * 8 + hh] = mx + __builtin_amdgcn_logf(l);
            }
        } else {
            const int hq = hh - 8, kvh = hq >> 2;
            float q[16]; ld16bf(PROJ + (size_t)row * INW + QB_OFF + hq * 64 + sub * 16, q);
            float o[16]; float mx = -INFINITY, l = 0.f;
#pragma unroll
            for (int i = 0; i < 16; ++i) o[i] = 0.f;
            attn_run(PROJ, rowb, t, 1, 128, KB_OFF + kvh * 64 + sub * 16, VB_OFF + kvh * 64 + sub * 16, q, o, mx, l);
            const float sk = sinks[hq] * LOG2E, m2 = fmaxf(mx, sk), sc = __builtin_amdgcn_exp2f(mx - m2);
            l = l * sc + __builtin_amdgcn_exp2f(sk - m2);
            st16bf(OPART + ((size_t)3 * M + row) * 512 + hq * 64 + sub * 16, o, sc / l);
        }
    }
}


namespace att {
typedef short bf16x8 __attribute__((ext_vector_type(8)));
typedef short s16x4 __attribute__((ext_vector_type(4)));
typedef float f32x16 __attribute__((ext_vector_type(16)));
typedef unsigned u32x4 __attribute__((ext_vector_type(4)));
constexpr int LK = 0, LV = 49152, LWS = 98304, LOST = 100352, LEND = 133120;
static_assert(LEND <= LDSCTL_OFF, "attention LDS");
__device__ __forceinline__ int crow(int r, int hi) { return (r & 3) + 8 * (r >> 2) + 4 * hi; }
__device__ __forceinline__ void glds16(const void* gsrc, unsigned lds_dst) { unsigned keep;
    asm volatile("s_mov_b32 %0, m0\n\ts_mov_b32 m0, %2\n\ts_nop 0\n\tglobal_load_lds_dwordx4 %1, off\n\ts_mov_b32 m0, %0" : "=&s"(keep) : "v"(gsrc), "s"(lds_dst) : "memory"); }
__device__ __forceinline__ unsigned cvtpk(float lo, float hi) { unsigned r; asm("v_cvt_pk_bf16_f32 %0, %1, %2" : "=v"(r) : "v"(lo), "v"(hi)); return r; }
__device__ __forceinline__ float xhalf_max(float m) { return xor32_max(m); }
__device__ __forceinline__ float xhalf_sum(float m) { return xor32_sum(m); }
__device__ __forceinline__ f32x16 qk32(const LAS unsigned char* ktile, int half, const bf16x8 (&qr)[4], int r32, int hi) {
    const LAS unsigned char* kb = ktile + (r32 + 32 * half) * 128; const int sw = (r32 >> 1) & 7;
    f32x16 p = {0.f, 0.f, 0.f, 0.f, 0.f, 0.f, 0.f, 0.f, 0.f, 0.f, 0.f, 0.f, 0.f, 0.f, 0.f, 0.f};
#pragma unroll
    for (int d0 = 0; d0 < 4; ++d0) { const bf16x8 kf = *(const LAS bf16x8*)(kb + (((2 * d0 + hi) ^ sw) << 4)); p = __builtin_amdgcn_mfma_f32_32x32x16_bf16(kf, qr[d0], p, 0, 0, 0); }
    return p;
}
typedef short v4i16_t __attribute__((ext_vector_type(4)));
__device__ __forceinline__ s16x4 vtr(const LAS unsigned char* p) { return __builtin_bit_cast(s16x4, __builtin_amdgcn_ds_read_tr16_b64_v4i16((LAS v4i16_t*)p)); }
__device__ __forceinline__ void pv32(f32x16 (&o)[2], const LAS unsigned char* vb, int half, bf16x8 pa0, bf16x8 pa1) {
#pragma unroll
    for (int d0 = 0; d0 < 2; ++d0) {
        const LAS unsigned char* p = vb + d0 * 512 + half * 4096;
        const s16x4 l0 = vtr(p), h0 = vtr(p + 1024), l1 = vtr(p + 2048), h1 = vtr(p + 3072);
        const bf16x8 v0 = {l0[0], l0[1], l0[2], l0[3], h0[0], h0[1], h0[2], h0[3]}, v1 = {l1[0], l1[1], l1[2], l1[3], h1[0], h1[1], h1[2], h1[3]};
        o[d0] = __builtin_amdgcn_mfma_f32_32x32x16_bf16(pa0, v0, o[d0], 0, 0, 0);
        o[d0] = __builtin_amdgcn_mfma_f32_32x32x16_bf16(pa1, v1, o[d0], 0, 0, 0);
    }
}
}

struct AttUnit { int br, Pc, d, nq, kcol, vcol, qcol0, token0; };
__device__ __forceinline__ AttUnit att_decode(int ui) {
    AttUnit U;
    if (ui < 12) { const int a = blockIdx.x * 12 + ui, u = a & 31, h = (a >> 5) & 7, b = (a >> 8) & 3; U.br = a >> 10; U.d = (U.br == 0) ? 1 : (U.br == 1) ? 4 : 16;
        const int per = 32 / U.d, r = u / per; U.Pc = u % per; U.nq = 1; U.kcol = KA_OFF + 64 * h; U.vcol = VA_OFF + 64 * h; U.qcol0 = QA_OFF + 64 * h; U.token0 = b * S + r; }
    else { const int w = blockIdx.x, kvh = (w >> 5) & 1; U.Pc = w & 31; U.d = 1; U.br = 3; U.nq = 4; U.kcol = KB_OFF + 64 * kvh; U.vcol = VB_OFF + 64 * kvh; U.qcol0 = QB_OFF + 256 * kvh; U.token0 = (w >> 6) * S; }
    return U;
}
__device__ __forceinline__ void attn_mfma(const Ctx& C, const bf16* PROJ, bf16* OPART, float* LSE, const float* sinks) {
    using namespace att;
    const int lane = C.lane, r32 = lane & 31, hi = lane >> 5, wid = C.wave;
    LAS unsigned char* shm = C.lds;
    const unsigned lds0 = (unsigned)(uintptr_t)shm;
    LAS float* wsf = (LAS float*)(shm + LWS) + wid * 64;
    LAS bf16* stg = (LAS bf16*)(shm + LOST) + wid * 2048;
    const LAS unsigned char* vlane = shm + LV + ((lane >> 4) & 1) * 32 + (lane & 3) * 8 + (4 * hi + ((lane & 15) >> 2)) * 64;
#define ATT_ISSUE_K(U) do { const int m0k_ = 256 * (U).Pc - 128, kr_ = 8 * wid + (lane >> 3), kc_ = (lane & 7) ^ ((kr_ >> 1) & 7); _Pragma("unroll") for (int T = 0; T < 6; ++T) { int mk = m0k_ + 64 * T + kr_; mk = mk < 0 ? 0 : mk; \
        glds16(PROJ + (size_t)((U).token0 + (U).d * mk) * INW + (U).kcol + kc_ * 8, (unsigned)__builtin_amdgcn_readfirstlane(lds0 + LK + T * 8192 + wid * 1024)); } } while (0)
#define ATT_ISSUE_V(U) do { const int m0k_ = 256 * (U).Pc - 128; _Pragma("unroll") for (int T = 0; T < 6; ++T) { int mv = m0k_ + 64 * T + 8 * wid + ((lane >> 2) & 7); mv = mv < 0 ? 0 : mv; \
        glds16(PROJ + (size_t)((U).token0 + (U).d * mv) * INW + (U).vcol + (lane >> 5) * 32 + (lane & 3) * 8, (unsigned)__builtin_amdgcn_readfirstlane(lds0 + LV + T * 8192 + wid * 1024)); } } while (0)
#define ATT_LOAD_Q(U, hq, dst) do { const bf16* Qrow_ = PROJ + (size_t)((U).token0 + (U).d * (256 * (U).Pc + 32 * wid + r32)) * INW + (U).qcol0 + 64 * (hq); \
        _Pragma("unroll") for (int d0 = 0; d0 < 4; ++d0) dst[d0] = *(const GAS bf16x8*)(Qrow_ + d0 * 16 + hi * 8); } while (0)
    bf16x8 qr[4];
    { const AttUnit U0 = att_decode(0); ATT_ISSUE_K(U0); ATT_LOAD_Q(U0, 0, qr);
      asm volatile("s_waitcnt vmcnt(0)" ::: "memory"); __builtin_amdgcn_s_barrier(); asm volatile("" ::: "memory");
      ATT_ISSUE_V(U0); }
#pragma unroll 1
    for (int ui = 0; ui < 13; ++ui) {
        const AttUnit U = att_decode(ui);
        const int Pc = U.Pc, br = U.br, d = U.d, token0 = U.token0, qcol0 = U.qcol0;
#pragma unroll 1
        for (int hq = 0; hq < U.nq; ++hq) {
            if (hq > 0) ATT_LOAD_Q(U, hq, qr);
            const int qm = 256 * Pc + 32 * wid + r32;
            f32x16 sc[5];
#pragma unroll
            for (int kb = 0; kb < 5; ++kb) {
                const int j0 = 32 * wid + 32 * kb;
                if (Pc == 0 && j0 < 128) { sc[kb] = (f32x16){-INFINITY, -INFINITY, -INFINITY, -INFINITY, -INFINITY, -INFINITY, -INFINITY, -INFINITY, -INFINITY, -INFINITY, -INFINITY, -INFINITY, -INFINITY, -INFINITY, -INFINITY, -INFINITY}; }
                else sc[kb] = qk32(shm + LK + (j0 >> 6) * 8192, (j0 >> 5) & 1, qr, r32, hi);
            }
            const int lowlim = r32 + (br == 3 ? 1 : 0);
#pragma unroll
            for (int rr = 0; rr < 16; ++rr) { const int c = crow(rr, hi); if (c < lowlim) sc[0][rr] = -INFINITY; if (c > r32) sc[4][rr] = -INFINITY; }
            float mx = -INFINITY;
#pragma unroll
            for (int kb = 0; kb < 5; ++kb)
#pragma unroll
                for (int rr = 0; rr < 16; ++rr) mx = fmaxf(mx, sc[kb][rr]);
            mx = xhalf_max(mx);
            float sk2 = 0.f;
            if (br == 3) { sk2 = sinks[(qcol0 - QB_OFF) / 64 + hq] * LOG2E; mx = fmaxf(mx, sk2); }
            float l = 0.f;
#pragma unroll
            for (int kb = 0; kb < 5; ++kb)
#pragma unroll
                for (int rr = 0; rr < 16; ++rr) { const float p = __builtin_amdgcn_exp2f(sc[kb][rr] - mx); sc[kb][rr] = p; l += p; }
            l = xhalf_sum(l);
            if (br == 3) l += __builtin_amdgcn_exp2f(sk2 - mx);
            if (hq == 0) {
                asm volatile("s_waitcnt vmcnt(0)" ::: "memory"); __builtin_amdgcn_s_barrier(); asm volatile("" ::: "memory");
                if (U.nq == 1 && ui + 1 < 13) { const AttUnit Un = att_decode(ui + 1); ATT_ISSUE_K(Un); ATT_LOAD_Q(Un, 0, qr); }
            }
            f32x16 o[2];
#pragma unroll
            for (int i = 0; i < 16; ++i) { o[0][i] = 0.f; o[1][i] = 0.f; }
#pragma unroll
            for (int kb = 0; kb < 5; ++kb) {
                const int j0 = 32 * wid + 32 * kb;
                if (!(Pc == 0 && j0 < 128)) {
                    u32x4 w0, w1;
                    w0.x = cvtpk(sc[kb][0], sc[kb][1]); w0.y = cvtpk(sc[kb][2], sc[kb][3]); w0.z = cvtpk(sc[kb][4], sc[kb][5]); w0.w = cvtpk(sc[kb][6], sc[kb][7]);
                    w1.x = cvtpk(sc[kb][8], sc[kb][9]); w1.y = cvtpk(sc[kb][10], sc[kb][11]); w1.z = cvtpk(sc[kb][12], sc[kb][13]); w1.w = cvtpk(sc[kb][14], sc[kb][15]);
                    pv32(o, vlane + (j0 >> 6) * 8192, (j0 >> 5) & 1, __builtin_bit_cast(bf16x8, w0), __builtin_bit_cast(bf16x8, w1));
                }
            }
            if (hi == 0) wsf[r32] = l;
            asm volatile("s_waitcnt lgkmcnt(0)" ::: "memory");
#pragma unroll
            for (int rr = 0; rr < 16; ++rr) { const int orow = crow(rr, hi); const float rl = __builtin_amdgcn_rcpf(wsf[orow]);
                stg[orow * 64 + r32] = (bf16)f2bf(o[0][rr] * rl); stg[orow * 64 + 32 + r32] = (bf16)f2bf(o[1][rr] * rl); }
            asm volatile("s_waitcnt lgkmcnt(0)" ::: "memory");
            const int hcol = (br == 3) ? (qcol0 - QB_OFF) + 64 * hq : (qcol0 - QA_OFF);
            bf16* Ob = OPART + ((size_t)br * M) * 512 + hcol;
            if (br < 3 && hi == 0) LSE[((size_t)br * M + (token0 + d * qm)) * 8 + (qcol0 - QA_OFF) / 64] = mx + __builtin_amdgcn_logf(l);
#pragma unroll
            for (int i = 0; i < 4; ++i) { const int row = i * 8 + (lane >> 3), ch = lane & 7; const v4u v = *(const LAS v4u*)(stg + row * 64 + ch * 8);
                const int tok = token0 + d * (256 * Pc + 32 * wid + row);
                *(GAS v4u*)(Ob + (size_t)tok * 512 + ch * 8) = v; }
            asm volatile("s_waitcnt lgkmcnt(0)" ::: "memory");
        }
        if (ui + 1 < 13) {
            asm volatile("s_waitcnt vmcnt(4)" : "+v"(qr[0]), "+v"(qr[1]), "+v"(qr[2]), "+v"(qr[3]) :: "memory"); __builtin_amdgcn_s_barrier(); asm volatile("" ::: "memory");
            const AttUnit Un = att_decode(ui + 1); ATT_ISSUE_V(Un);
        }
    }
    asm volatile("s_waitcnt vmcnt(0) lgkmcnt(0)" ::: "memory"); __builtin_amdgcn_s_barrier(); asm volatile("" ::: "memory");
#undef ATT_ISSUE_K
#undef ATT_ISSUE_V
#undef ATT_LOAD_Q
}

__device__ __forceinline__ void ld8bf(const bf16* p, float (&v)[8]) {
    const v4u a = *(const GAS v4u*)p;
    v[0] = bflo(a.x); v[1] = bfhi(a.x); v[2] = bflo(a.y); v[3] = bfhi(a.y); v[4] = bflo(a.z); v[5] = bfhi(a.z); v[6] = bflo(a.w); v[7] = bfhi(a.w);
}
__device__ __forceinline__ void unpack8(const v4u a, float (&v)[8]) {
    v[0] = bflo(a.x); v[1] = bfhi(a.x); v[2] = bflo(a.y); v[3] = bfhi(a.y); v[4] = bflo(a.z); v[5] = bfhi(a.z); v[6] = bflo(a.w); v[7] = bfhi(a.w);
}
constexpr int UNR = 4;
__device__ __forceinline__ void combine_phase(const Ctx& C, const bf16* OPART, const float* LSE, const float* gna, const float* gnb, bf16* MIX) {
    const int h = C.lane >> 3;
    float ga[8], gb[8];
#pragma unroll
    for (int i = 0; i < 8; ++i) { ga[i] = gna[8 * C.lane + i]; gb[i] = gnb[8 * C.lane + i]; }
    for (int row0 = C.gw; row0 < M; row0 += UNR * C.ngw) {
        v4u q0[UNR], q1[UNR], q2[UNR], q3[UNR]; float l0[UNR], l1[UNR], l2[UNR];
#pragma unroll
        for (int k = 0; k < UNR; ++k) { const int row = row0 + k * C.ngw;
            l0[k] = LSE[((size_t)0 * M + row) * 8 + h]; l1[k] = LSE[((size_t)1 * M + row) * 8 + h]; l2[k] = LSE[((size_t)2 * M + row) * 8 + h];
            q0[k] = *(const GAS v4u*)(OPART + ((size_t)0 * M + row) * 512 + 8 * C.lane); q1[k] = *(const GAS v4u*)(OPART + ((size_t)1 * M + row) * 512 + 8 * C.lane);
            q2[k] = *(const GAS v4u*)(OPART + ((size_t)2 * M + row) * 512 + 8 * C.lane); q3[k] = *(const GAS v4u*)(OPART + ((size_t)3 * M + row) * 512 + 8 * C.lane); }
#pragma unroll
        for (int k = 0; k < UNR; ++k) { const int row = row0 + k * C.ngw;
            const float mx = fmaxf(l0[k], fmaxf(l1[k], l2[k]));
            float w0 = __builtin_amdgcn_exp2f(l0[k] - mx), w1 = __builtin_amdgcn_exp2f(l1[k] - mx), w2 = __builtin_amdgcn_exp2f(l2[k] - mx);
            const float inv = 1.0f / (w0 + w1 + w2); w0 *= inv; w1 *= inv; w2 *= inv;
            float a0[8], a1[8], a2[8], b[8]; unpack8(q0[k], a0); unpack8(q1[k], a1); unpack8(q2[k], a2); unpack8(q3[k], b);
            float sa = 0.f, sb = 0.f;
#pragma unroll
            for (int i = 0; i < 8; ++i) { a0[i] = w0 * a0[i] + w1 * a1[i] + w2 * a2[i]; sa += a0[i] * a0[i]; sb += b[i] * b[i]; }
            sa = wave_sum(sa); sb = wave_sum(sb);
            const float ra = __builtin_amdgcn_rsqf(sa * (1.0f / 512.0f) + EPS), rb = __builtin_amdgcn_rsqf(sb * (1.0f / 512.0f) + EPS);
            v4u oa, ob;
            oa.x = pk2(a0[0] * ra * ga[0], a0[1] * ra * ga[1]); oa.y = pk2(a0[2] * ra * ga[2], a0[3] * ra * ga[3]); oa.z = pk2(a0[4] * ra * ga[4], a0[5] * ra * ga[5]); oa.w = pk2(a0[6] * ra * ga[6], a0[7] * ra * ga[7]);
            ob.x = pk2(b[0] * rb * gb[0], b[1] * rb * gb[1]); ob.y = pk2(b[2] * rb * gb[2], b[3] * rb * gb[3]); ob.z = pk2(b[4] * rb * gb[4], b[5] * rb * gb[5]); ob.w = pk2(b[6] * rb * gb[6], b[7] * rb * gb[7]);
            *(GAS v4u*)(MIX + (size_t)row * D + 8 * C.lane) = oa; *(GAS v4u*)(MIX + (size_t)row * D + 512 + 8 * C.lane) = ob; }
    }
}

__device__ __forceinline__ void row_load(const float* p, int lane, f32x4 (&v)[4]) {
#pragma unroll
    for (int j = 0; j < 4; ++j) v[j] = *(const GAS f32x4*)(p + 4 * lane + 256 * j);
}
__device__ __forceinline__ float row_ssq(const f32x4 (&v)[4]) {
    float s = 0.f;
#pragma unroll
    for (int j = 0; j < 4; ++j) s += (v[j][0] * v[j][0] + v[j][1] * v[j][1]) + (v[j][2] * v[j][2] + v[j][3] * v[j][3]);
    return wave_sum(s);
}
__device__ __forceinline__ void row_store_bf16(bf16* p, int lane, const f32x4 (&v)[4]) {
#pragma unroll
    for (int j = 0; j < 4; ++j) { u32x2v w; w.x = pk2(v[j][0], v[j][1]); w.y = pk2(v[j][2], v[j][3]); *(GAS u32x2v*)(p + 4 * lane + 256 * j) = w; }
}
__device__ __forceinline__ void row_load_bf16(const bf16* p, int lane, f32x4 (&v)[4]) {
#pragma unroll
    for (int j = 0; j < 4; ++j) { const u32x2v a = *(const GAS u32x2v*)(p + 4 * lane + 256 * j); v[j][0] = bflo(a.x); v[j][1] = bfhi(a.x); v[j][2] = bflo(a.y); v[j][3] = bfhi(a.y); }
}
__device__ __forceinline__ void xn_rows(const Ctx& C, const float* x, bf16* XN, float* ssq) {
    for (int row0 = C.gw; row0 < M; row0 += UNR * C.ngw) {
        f32x4 v[UNR][4];
#pragma unroll
        for (int k = 0; k < UNR; ++k) row_load(x + (size_t)(row0 + k * C.ngw) * D, C.lane, v[k]);
#pragma unroll
        for (int k = 0; k < UNR; ++k) { const int row = row0 + k * C.ngw;
            const float s = row_ssq(v[k]);
            row_store_bf16(XN + (size_t)row * D, C.lane, v[k]);
            if (C.lane < 16) ssq[(size_t)row * 16 + C.lane] = (C.lane == 0) ? s : 0.f; }
    }
}

struct Route { int e0, e1; float g0, g1, rs; int p0, p1, pad; };
__device__ __forceinline__ void router_phase(const Ctx& C, const bf16* x1, const float* router, const float* gain, Route* RT, int* blkcnt) {
    LAS float* GRt = (LAS float*)(C.lds + RING_OFF);
    LAS unsigned* tokE = (LAS unsigned*)(C.lds + RING_OFF + 32768);
    for (int i = C.tid; i < 1024 * 8; i += 512) { const int c = i >> 3, e = i & 7; GRt[e * 1024 + c] = router[i] * gain[c]; }
    __syncthreads();
    const int tok0 = blockIdx.x * 128 + C.wave * 16;
    for (int tt = 0; tt < 16; ++tt) {
        const int tok = tok0 + tt;
        f32x4 v[4]; row_load_bf16(x1 + (size_t)tok * D, C.lane, v);
        float ss = 0.f, lg[8];
#pragma unroll
        for (int e = 0; e < 8; ++e) lg[e] = 0.f;
#pragma unroll
        for (int j = 0; j < 4; ++j) { ss += (v[j][0] * v[j][0] + v[j][1] * v[j][1]) + (v[j][2] * v[j][2] + v[j][3] * v[j][3]);
#pragma unroll
            for (int e = 0; e < 8; ++e) { const f32x4 r = *(const LAS f32x4*)(GRt + e * 1024 + 4 * C.lane + 256 * j); lg[e] += (v[j][0] * r[0] + v[j][1] * r[1]) + (v[j][2] * r[2] + v[j][3] * r[3]); } }
        ss = wave_sum(ss);
        const float rs = __builtin_amdgcn_rsqf(ss * (1.0f / D) + EPS);
#pragma unroll
        for (int e = 0; e < 8; ++e) lg[e] = wave_sum(lg[e]) * rs;
        int e0 = 0; float v0 = lg[0];
#pragma unroll
        for (int e = 1; e < 8; ++e) if (lg[e] > v0) { v0 = lg[e]; e0 = e; }
        int e1 = -1; float v1 = -INFINITY;
#pragma unroll
        for (int e = 0; e < 8; ++e) if (e != e0 && lg[e] > v1) { v1 = lg[e]; e1 = e; }
        const float ex = __expf(v1 - v0), g0 = 1.0f / (1.0f + ex), g1 = ex * g0;
        if (C.lane == 0) { Route r; r.e0 = e0; r.e1 = e1; r.g0 = g0; r.g1 = g1; r.rs = rs; r.p0 = 0; r.p1 = 0; r.pad = 0; RT[tok] = r; tokE[C.wave * 16 + tt] = (unsigned)e0 | ((unsigned)e1 << 8); }
    }
    __syncthreads();
    if (C.tid < 8) { int cnt = 0; for (int t = 0; t < 128; ++t) { const unsigned w = tokE[t]; cnt += ((w & 255u) == (unsigned)C.tid) + ((w >> 8) == (unsigned)C.tid); } blkcnt[blockIdx.x * 8 + C.tid] = cnt; }
    __syncthreads();
}
__device__ __forceinline__ void scatter_phase(const Ctx& C, const bf16* x1, const float* gain, Route* RT, const int* blkcnt, bf16* AP, float* rowgate, volatile LAS int* SEGB) {
    LAS int* LTOT = (LAS int*)(C.lds + RING_OFF);
    LAS int* LPRE = LTOT + 8;
    LAS unsigned* tokE = (LAS unsigned*)(LTOT + 16);
    LAS int* POS = (LAS int*)(LTOT + 16 + 128);
    { const int e = C.wave; int st = 0, sp = 0;
#pragma unroll
      for (int j = 0; j < 4; ++j) { const int b = C.lane + 64 * j; const int c = blkcnt[b * 8 + e]; st += c; if (b < (int)blockIdx.x) sp += c; }
      st = wave_sum_i(st); sp = wave_sum_i(sp);
      if (C.lane == 0) { LTOT[e] = st; LPRE[e] = sp; } }
    if (C.tid < 128) { const Route r = RT[blockIdx.x * 128 + C.tid]; tokE[C.tid] = (unsigned)r.e0 | ((unsigned)r.e1 << 8); }
    __syncthreads();
    if (C.tid == 0) { int base = 0; for (int e = 0; e < 8; ++e) { SEGB[e] = base; base += (LTOT[e] + 255) & ~255; } SEGB[8] = base; }
    __syncthreads();
    if (C.tid < 8) { const int e = C.tid; int run = SEGB[e] + LPRE[e];
        for (int t = 0; t < 128; ++t) { const unsigned w = tokE[t]; if ((int)(w & 255u) == e) POS[2 * t] = run++; if ((int)(w >> 8) == e) POS[2 * t + 1] = run++; } }
    __syncthreads();
    float gn[4][4];
#pragma unroll
    for (int j = 0; j < 4; ++j) { const f32x4 g = *(const GAS f32x4*)(gain + 4 * C.lane + 256 * j); gn[j][0] = g[0]; gn[j][1] = g[1]; gn[j][2] = g[2]; gn[j][3] = g[3]; }
    for (int tt = 0; tt < 16; ++tt) {
        const int tl = C.wave * 16 + tt, tok = blockIdx.x * 128 + tl;
        const int p0 = POS[2 * tl], p1 = POS[2 * tl + 1];
        const Route r = RT[tok];
        if (C.lane == 0) { RT[tok].p0 = p0; RT[tok].p1 = p1; rowgate[p0] = r.g0; rowgate[p1] = r.g1; }
        f32x4 v[4]; row_load_bf16(x1 + (size_t)tok * D, C.lane, v);
#pragma unroll
        for (int j = 0; j < 4; ++j) { v[j][0] *= r.rs * gn[j][0]; v[j][1] *= r.rs * gn[j][1]; v[j][2] *= r.rs * gn[j][2]; v[j][3] *= r.rs * gn[j][3]; }
        row_store_bf16(AP + (size_t)p0 * D, C.lane, v); row_store_bf16(AP + (size_t)p1 * D, C.lane, v);
    }
    if (blockIdx.x < 8) { const int e = blockIdx.x; const int lo = SEGB[e] + LTOT[e], hi = SEGB[e + 1];
        for (int rr = lo + C.wave; rr < hi; rr += NWAVES) {
#pragma unroll
            for (int j = 0; j < 4; ++j) { u32x2v z; z.x = 0u; z.y = 0u; *(GAS u32x2v*)(AP + (size_t)rr * D + 4 * C.lane + 256 * j) = z; }
            if (C.lane == 0) rowgate[rr] = 0.f; } }
    __syncthreads();
}
__device__ __forceinline__ void moe_tail_row(const bf16* PTp, int p, float gate, int lane, u32x2v (&y)[4]) {
    f32x4 t[4];
#pragma unroll
    for (int j = 0; j < 4; ++j) t[j] = (f32x4){0.f, 0.f, 0.f, 0.f};
#pragma unroll 1
    for (int s = 0; s < KSPLIT; ++s) {
#pragma unroll
        for (int j = 0; j < 4; ++j) { const u32x2v a = *(const GAS u32x2v*)(PTp + ((size_t)s * TAILROWS + (p - MAINROWS)) * D + 4 * lane + 256 * j);
            t[j][0] += bflo(a.x); t[j][1] += bfhi(a.x); t[j][2] += bflo(a.y); t[j][3] += bfhi(a.y); } }
#pragma unroll
    for (int j = 0; j < 4; ++j) { y[j].x = pk2(t[j][0] * gate, t[j][1] * gate); y[j].y = pk2(t[j][2] * gate, t[j][3] * gate); }
}
__device__ __forceinline__ void moe_combine(const Ctx& C, float* xout, const Route* RT, const bf16* Y, const bf16* PTp, bf16* XN, float* ssq, const float* final_gain) {
    for (int row0 = C.gw; row0 < M; row0 += UNR * C.ngw) {
        int p0[UNR], p1[UNR]; float g0[UNR], g1[UNR];
#pragma unroll
        for (int k = 0; k < UNR; ++k) { const Route rt = RT[row0 + k * C.ngw]; p0[k] = rt.p0; p1[k] = rt.p1; g0[k] = rt.g0; g1[k] = rt.g1; }
        u32x2v xr[UNR][4], ya[UNR][4], yb[UNR][4];
#pragma unroll
        for (int k = 0; k < UNR; ++k)
#pragma unroll
            for (int j = 0; j < 4; ++j) { xr[k][j] = *(const GAS u32x2v*)(XN + (size_t)(row0 + k * C.ngw) * D + 4 * C.lane + 256 * j);
                ya[k][j] = *(const GAS u32x2v*)(Y + (size_t)p0[k] * D + 4 * C.lane + 256 * j); yb[k][j] = *(const GAS u32x2v*)(Y + (size_t)p1[k] * D + 4 * C.lane + 256 * j); }
#pragma unroll
        for (int k = 0; k < UNR; ++k) { const int row = row0 + k * C.ngw;
            if (p0[k] >= MAINROWS) moe_tail_row(PTp, p0[k], g0[k], C.lane, ya[k]);
            if (p1[k] >= MAINROWS) moe_tail_row(PTp, p1[k], g1[k], C.lane, yb[k]);
            f32x4 v[4];
#pragma unroll
            for (int j = 0; j < 4; ++j) { v[j][0] = bflo(xr[k][j].x) + bflo(ya[k][j].x) + bflo(yb[k][j].x); v[j][1] = bfhi(xr[k][j].x) + bfhi(ya[k][j].x) + bfhi(yb[k][j].x);
                v[j][2] = bflo(xr[k][j].y) + bflo(ya[k][j].y) + bflo(yb[k][j].y); v[j][3] = bfhi(xr[k][j].y) + bfhi(ya[k][j].y) + bfhi(yb[k][j].y); }
            const float s = row_ssq(v);
            if (final_gain) {
                const float rs = __builtin_amdgcn_rsqf(s * (1.0f / D) + EPS);
#pragma unroll
                for (int j = 0; j < 4; ++j) { const f32x4 g = *(const GAS f32x4*)(final_gain + 4 * C.lane + 256 * j); *(GAS f32x4*)(xout + (size_t)row * D + 4 * C.lane + 256 * j) = v[j] * rs * g; }
            } else {
                row_store_bf16(XN + (size_t)row * D, C.lane, v);
                if (C.lane < 16) ssq[(size_t)row * 16 + C.lane] = (C.lane == 0) ? s : 0.f;
            } }
    }
}

struct Args { const void* in[17]; float* out; unsigned char* ws; };
__global__ void __launch_bounds__(NWAVES * 64, 2) trunk_fwd(Args args) {
    extern __shared__ __attribute__((aligned(16))) unsigned char lds[];
    const int G = gridDim.x;
    const int wave_s = __builtin_amdgcn_readfirstlane(threadIdx.x >> 6);
#define TIDX() ({ unsigned z_ = 0u; asm volatile("" : "+v"(z_)); wave_s * 64 + (int)__builtin_amdgcn_mbcnt_hi(~0u, __builtin_amdgcn_mbcnt_lo(~0u, z_)); })
#define MKCTX() Ctx C; { int t_ = TIDX(); C.lds = (LAS unsigned char*)lds; C.tid = t_; C.lane = t_ & 63; C.wave = __builtin_amdgcn_readfirstlane(t_ >> 6); C.gw = blockIdx.x * NWAVES + C.wave; C.ngw = G * NWAVES; } \
    GAS unsigned char* wsl = (GAS unsigned char*)ws; int bid = blockIdx.x; asm volatile("" : "+s"(wsl), "+s"(bid));
    LAS unsigned char* const ldsb = (LAS unsigned char*)lds;
    volatile LAS unsigned* MISC = (volatile LAS unsigned*)(ldsb + MISC_OFF);
    volatile LAS int* SEGB = (volatile LAS int*)(ldsb + MISC_OFF + 64);
    unsigned char* ws = args.ws;
    gu32* ctl = (gu32*)(ws + WS_CTL);
    for (int u = threadIdx.x; u < (LDS_BYTES - LDSCTL_OFF) / 4; u += NWAVES * 64) ((LAS unsigned*)(ldsb + LDSCTL_OFF))[u] = 0u;
    __syncthreads();
    XcdBarrier bar = xcd_barrier_post((unsigned*)(ctl + CW_BAR), MISC + 8, (int)threadIdx.x);
#define GRID_BAR_RAW() do { XcdBarrier b_ = bar; GAS unsigned* p_ = (GAS unsigned*)bar.bar; asm volatile("" : "+s"(b_.x), "+s"(p_)); b_.bar = (unsigned*)p_; xcd_barrier(b_, TIDX()); } while (0)
#if PROBE_T
#define TBEG(id) do { if ((id) == PROBE_T && blockIdx.x == 0 && TIDX() == 0) MISC[33] = (unsigned)__builtin_amdgcn_s_memrealtime(); } while (0)
#define TEND(id) do { if ((id) == PROBE_T && blockIdx.x == 0 && TIDX() == 0) MISC[32] = MISC[32] + ((unsigned)__builtin_amdgcn_s_memrealtime() - MISC[33]); } while (0)
#else
#define TBEG(id) do {} while (0)
#define TEND(id) do {} while (0)
#endif
#define GRID_BAR() do { TBEG(1); GRID_BAR_RAW(); TEND(1); } while (0)

    const float* x_in = (const float*)args.in[0]; const int* positions = (const int*)args.in[1];
    const float* attn_norm = (const float*)args.in[2]; const float* w_in = (const float*)args.in[3];
    const float* mix_norm_a = (const float*)args.in[4]; const float* mix_norm_b = (const float*)args.in[5];
    const float* sinks = (const float*)args.in[6]; const float* w_out = (const float*)args.in[7];
    const float* ffn_norm = (const float*)args.in[8]; const float* dwg = (const float*)args.in[9];
    const float* dwu = (const float*)args.in[10]; const float* dwd = (const float*)args.in[11];
    const float* router = (const float*)args.in[12]; const float* mwg = (const float*)args.in[13];
    const float* mwu = (const float*)args.in[14]; const float* mwd = (const float*)args.in[15];
    const float* final_norm = (const float*)args.in[16];
    float* xout = args.out;
#define ROPE ((float*)(GAS float*)(wsl + WS_ROPE))
#define SSQA ((float*)(GAS float*)(wsl + WS_SSQA))
#define SSQF ((float*)(GAS float*)(wsl + WS_SSQF))
#define RT ((Route*)(GAS Route*)(wsl + WS_ROUTE))
#define BLKCNT ((int*)(GAS int*)(wsl + WS_BLKCNT))
#define ROWGATE ((float*)(GAS float*)(wsl + WS_ROWGATE))
#define WIN ((bf16*)(GAS bf16*)(wsl + WS_WIN))
#define WOUT ((bf16*)(GAS bf16*)(wsl + WS_WOUT))
#define WGU ((bf16*)(GAS bf16*)(wsl + WS_WGU))
#define WDN ((bf16*)(GAS bf16*)(wsl + WS_WDN))
#define MGU ((bf16*)(GAS bf16*)(wsl + WS_MGU))
#define MDN ((bf16*)(GAS bf16*)(wsl + WS_MDN))
#define XN ((bf16*)(GAS bf16*)(wsl + WS_XN))
#define PROJ ((bf16*)(GAS bf16*)(wsl + WS_PROJ))
#define OPART ((bf16*)(GAS bf16*)(wsl + WS_OPART))
#define LSE ((float*)(GAS float*)(wsl + WS_LSE))
#define MIX ((bf16*)(GAS bf16*)(wsl + WS_MIX))
#define HB ((bf16*)(GAS bf16*)(wsl + WS_H))
#define AP ((bf16*)(GAS bf16*)(wsl + WS_AP))
#define PT ((bf16*)(GAS bf16*)(wsl + WS_PT))

    TBEG(2);
    { MKCTX();
    { ConvSrc S{w_in, w_out, attn_norm, ffn_norm, dwg, dwu, dwd, WIN, WOUT, WGU, WDN}; convert_prologue(C, S); }
    convert_moe_layer(C, mwg, mwu, mwd, MGU, MDN);
    for (int i = blockIdx.x * 512 + C.tid; i < S * 32; i += G * 512) {
        const int s = i >> 5, f = i & 31;
        const float inv = __builtin_amdgcn_exp2f(-(float)f * (13.287712379549449f / 32.0f));
        const float ang = (float)positions[s] * inv;
        const double rev = (double)ang * 0.15915494309189535; const float fr = (float)(rev - __builtin_rint(rev));
        ROPE[i] = __builtin_amdgcn_cosf(fr); ROPE[S * 32 + i] = __builtin_amdgcn_sinf(fr);
    }
    xn_rows(C, x_in, XN, SSQA); }
    TEND(2);
    GRID_BAR();

#pragma unroll 1
    for (int l = 0; l < DEPTH; ++l) {
        TBEG(3);
        { MKCTX(); pg8::Gemm g{XN, WIN + (size_t)l * INW * D, M, INW, D, 0, D}; pg8::StaticOrder So; So.init(M, INW, G, bid);
          pg8::EpiRope E{PROJ, SSQA, ROPE};
          pg8::gemm_phase<pg8::EpiRope, pg8::StaticOrder, true, true>(C.lds + RING_OFF, g, So, E, C.tid);
#if PROBE_T == 101
          GRID_BAR_RAW(); pg8::gemm_phase<pg8::EpiRope, pg8::StaticOrder, true, true>(C.lds + RING_OFF, g, So, E, C.tid);
#endif
#if PROBE_T == 102
          GRID_BAR_RAW(); { pg8::EpiNull E0; pg8::gemm_phase<pg8::EpiNull, pg8::StaticOrder, true, true>(C.lds + RING_OFF, g, So, E0, C.tid); }
#endif
#if PROBE_T == 103
          GRID_BAR_RAW(); { pg8::EpiRopeT<false, true> E0{AP, SSQA, ROPE}; pg8::gemm_phase<pg8::EpiRopeT<false, true>, pg8::StaticOrder, true, true>(C.lds + RING_OFF, g, So, E0, C.tid); }
#endif
#if PROBE_T == 104
          GRID_BAR_RAW(); { pg8::EpiRopeT<false, false> E0{AP, SSQA, ROPE}; pg8::gemm_phase<pg8::EpiRopeT<false, false>, pg8::StaticOrder, true, true>(C.lds + RING_OFF, g, So, E0, C.tid); }
#endif
        }
        TEND(3);
        GRID_BAR();
        TBEG(4);
        { MKCTX(); attn_mfma(C, PROJ, OPART, LSE, sinks + l * 8); }
        TEND(4);
        GRID_BAR();
        TBEG(5);
        { MKCTX(); combine_phase(C, OPART, LSE, mix_norm_a + l * 512, mix_norm_b + l * 512, MIX); }
        TEND(5);
        GRID_BAR();
        TBEG(6);
        { MKCTX(); pg8::Gemm g{MIX, WOUT + (size_t)l * D * D, M, D, D, 0, D}; pg8::StaticOrder So; So.init(M, D, G, bid);
          pg8::EpiResid E{XN, SSQF};
          pg8::gemm_phase<pg8::EpiResid, pg8::StaticOrder, true, true>(C.lds + RING_OFF, g, So, E, C.tid); }
        TEND(6);
        GRID_BAR();
        if ((l & 1) == 0) {
            const int j = l >> 1;
            TBEG(7);
            { MKCTX(); pg8::Gemm g{XN, WGU + (size_t)j * 2 * FF * D, M, 2 * FF, D, 0, D}; pg8::StaticOrder So; So.init(M, 2 * FF, G, bid);
              pg8::EpiSwiglu<true> E{HB, SSQF};
              pg8::gemm_phase<pg8::EpiSwiglu<true>, pg8::StaticOrder, true, true>(C.lds + RING_OFF, g, So, E, C.tid);
            }
            TEND(7);
            GRID_BAR();
            TBEG(8);
            { MKCTX(); pg8::Gemm g{HB, WDN + (size_t)j * D * FF, M, D, FF, 0, FF}; pg8::StaticOrder So; So.init(M, D, G, bid);
              pg8::EpiResid E{XN, SSQA};
              pg8::gemm_phase<pg8::EpiResid, pg8::StaticOrder, true, true>(C.lds + RING_OFF, g, So, E, C.tid); }
            TEND(8);
            GRID_BAR();
        } else {
            const int j = l >> 1;
            TBEG(9);
            { MKCTX(); router_phase(C, XN, router + (size_t)j * D * NE, ffn_norm + l * D, RT, BLKCNT); }
            TEND(9);
            GRID_BAR();
            TBEG(10);
            { MKCTX(); scatter_phase(C, XN, ffn_norm + l * D, RT, BLKCNT, AP, ROWGATE, SEGB); }
            TEND(10);
            GRID_BAR();
            const int nrows = SEGB[8];
            TBEG(11);
            { MKCTX(); pg8::Gemm g{AP, MGU, nrows, 2 * FF, D, (size_t)2 * FF * D * 2, D}; pg8::GroupedOrder So; So.init(nrows, 2 * FF, G, bid); So.segb = (const LAS int*)(C.lds + MISC_OFF + 64);
              pg8::EpiSwiglu<false> E{HB, nullptr};
              pg8::gemm_phase<pg8::EpiSwiglu<false>, pg8::GroupedOrder, true, true>(C.lds + RING_OFF, g, So, E, C.tid);
            }
            TEND(11);
            GRID_BAR();
            TBEG(12);
            { MKCTX(); const int nmain = nrows < MAINROWS ? nrows : MAINROWS;
              pg8::Gemm g{HB, MDN, nmain, D, FF, (size_t)D * FF * 2, FF}; pg8::GroupedOrder So; So.init(nmain, D, G, bid); So.segb = (const LAS int*)(C.lds + MISC_OFF + 64);
              pg8::EpiY E{AP, ROWGATE};
              pg8::gemm_phase<pg8::EpiY, pg8::GroupedOrder, true, true>(C.lds + RING_OFF, g, So, E, C.tid);
              pg8::Gemm gt{HB, MDN, nrows, D, FF / KSPLIT, (size_t)D * FF * 2, FF}; pg8::TailOrder St; St.npair = (nrows - nmain) / 256 * 4; St.G = G; St.c = bid; St.segb = (const LAS int*)(C.lds + MISC_OFF + 64);
              pg8::EpiPart Ep{PT};
              pg8::gemm_phase<pg8::EpiPart, pg8::TailOrder, true, true>(C.lds + RING_OFF, gt, St, Ep, C.tid);
            }
            TEND(12);
            GRID_BAR();
            TBEG(13);
            { MKCTX(); moe_combine(C, xout, RT, AP, PT, XN, SSQA, l == DEPTH - 1 ? final_norm : nullptr);
            if (l == 1) convert_moe_layer(C, mwg + (size_t)NE * D * FF, mwu + (size_t)NE * D * FF, mwd + (size_t)NE * FF * D, MGU, MDN); }
            TEND(13);
            if (l != DEPTH - 1) GRID_BAR();
        }
    }
#if PROBE_T == 200
    for (int i_ = 0; i_ < 20; ++i_) GRID_BAR_RAW();
#endif
#if PROBE_T
    if (blockIdx.x == 0 && TIDX() == 0) { const unsigned long long t0 = __builtin_amdgcn_s_memrealtime(); const unsigned long long dt = MISC[32];
        while (__builtin_amdgcn_s_memrealtime() - t0 < dt) __builtin_amdgcn_s_sleep(8); }
#endif
}

extern "C" void kernel_launch(void* const* d_in, const int* in_sizes, int n_in, void* d_out, int out_size, void* d_ws, size_t ws_size, hipStream_t stream) {
    static int grid = 0;
    if (grid == 0) {
        if (n_in != 17 || in_sizes[0] != M * D || out_size != M * D || ws_size < WS_END) {
            fprintf(stderr, "kernel_launch: unexpected shapes / workspace (n_in %d, in0 %d, out %d, ws %zu, need %zu); nothing launched\n", n_in, n_in > 0 ? in_sizes[0] : -1, out_size, ws_size, (size_t)WS_END); grid = -1; return; }
        int dev = 0, cus = 0, per_cu = 0;
        if (hipGetDevice(&dev) != hipSuccess || hipDeviceGetAttribute(&cus, hipDeviceAttributeMultiprocessorCount, dev) != hipSuccess) { grid = -1; return; }
        if (hipFuncSetAttribute((const void*)trunk_fwd, hipFuncAttributeMaxDynamicSharedMemorySize, LDS_BYTES) != hipSuccess) { fprintf(stderr, "kernel_launch: hipFuncSetAttribute failed\n"); grid = -1; return; }
        if (hipOccupancyMaxActiveBlocksPerMultiprocessor(&per_cu, (const void*)trunk_fwd, NWAVES * 64, LDS_BYTES) != hipSuccess || per_cu < 1) { fprintf(stderr, "kernel_launch: occupancy query reports %d blocks per CU\n", per_cu); }
        (void)hipGetLastError();
        grid = cus;
        if (grid != 256) { fprintf(stderr, "kernel_launch: built for 256 CUs, device has %d; nothing launched\n", cus); grid = -1; return; }
    }
    if (grid < 0) return;
    if (hipMemsetAsync((char*)d_ws + WS_CTL, 0, CTL_ZERO_BYTES, stream) != hipSuccess) return;
    Args a{};
    for (int i = 0; i < 17; ++i) a.in[i] = d_in[i];
    a.out = (float*)d_out; a.ws = (unsigned char*)d_ws;
    hipLaunchKernelGGL(trunk_fwd, dim3(grid), dim3(NWAVES * 64), LDS_BYTES, stream, a);
}
```

```cpp
#include <hip/hip_runtime.h>
#include <cstdio>
#include <cstdint>

#ifndef PROBE_T
#define PROBE_T 0
#endif
namespace cfg {
constexpr int D = 1024, NB = 4, S = 8192, M = NB * S, DEPTH = 4, HD = 64, INW = 2304, FF = 3584, NE = 8;
constexpr int QA_OFF = 0, KA_OFF = 512, VA_OFF = 1024, QB_OFF = 1536, KB_OFF = 2048, VB_OFF = 2176;
constexpr float EPS = 1e-5f;
constexpr float LOG2E = 1.4426950408889634f;
constexpr float C2 = 0.125f * LOG2E;
constexpr int MAXROWS = 2 * M + NE * 256;
constexpr int MAINROWS = 2 * M;
constexpr int TAILROWS = 7 * 256, KSPLIT = 7;
}

template <int K> __device__ __forceinline__ float swz_xor(float v) { return __builtin_bit_cast(float, __builtin_amdgcn_ds_swizzle(__builtin_bit_cast(int, v), (K << 10) | 0x1f)); }
__device__ __forceinline__ void pl32_swap(float& a, float& b) { asm volatile("s_nop 1\n\tv_permlane32_swap_b32 %0, %1" : "+v"(a), "+v"(b)); }
__device__ __forceinline__ float xor32_sum(float v) { float a = v, b = v; pl32_swap(a, b); return a + b; }
__device__ __forceinline__ float xor32_max(float v) { float a = v, b = v; pl32_swap(a, b); return fmaxf(a, b); }
__device__ __forceinline__ float fq_sum(float s) { s += swz_xor<16>(s); return xor32_sum(s); }
namespace pg8 {
#define PG8_LAS __attribute__((address_space(3)))
typedef unsigned short bf16_t;
typedef short bf16x8 __attribute__((ext_vector_type(8)));
typedef float f32x4 __attribute__((ext_vector_type(4)));
typedef unsigned u32x4 __attribute__((ext_vector_type(4)));
constexpr int BM = 256, BK = 64, HALF = 128, HTB = HALF * BK * 2  , STAGE_BYTES = 8 * HTB, NXCD = 8, WGM = 8;

__host__ __device__ __forceinline__ int lds_byte(int r, int c) { const int st = (r >> 4) * 2 + (c >> 5), rr = r & 15, cc = c & 31, ob = rr * 64 + cc * 2; return st * 1024 + (ob ^ (((ob >> 9) & 1) << 5)); }
__host__ __device__ __forceinline__ void stage_rc(int b, int& R, int& C) { const int st = b / 1024, sb = b % 1024, swz = sb ^ (((sb >> 9) & 1) << 5); R = (st >> 1) * 16 + swz / 64; C = (st & 1) * 32 + (swz % 64) / 2; }
__host__ __device__ __forceinline__ int perm32(int rho) { const int n = rho >> 4, i = rho & 15; return 8 * (i >> 2) + 4 * n + (i & 3); }

struct Unit { int pm, pn, eb, ko; };
struct Gemm { const bf16_t* A; const bf16_t* Bt; int M, N, K; size_t bstride; int ld; };

struct StaticOrder {
    int nM, nN, nwg, G, c;
    __host__ __device__ void init(int M, int N, int G_, int c_) { nM = M / BM; nN = N / BM; nwg = nM * nN; G = G_; c = c_; }
    __host__ __device__ bool next(int i, Unit& u) const {
        const long L = (long)i * G + c; if (L >= nwg) return false;
        int wgid = (int)L; { const int q = nwg / NXCD, r = nwg % NXCD, xcd = wgid % NXCD, off = wgid / NXCD; wgid = (xcd < r ? xcd * (q + 1) : r * (q + 1) + (xcd - r) * q) + off; }
        const int nig = WGM * nN, gid = wgid / nig, fm = gid * WGM, gsz = (nM - fm) < WGM ? (nM - fm) : WGM;
        u.pm = fm + ((wgid % nig) % gsz); u.pn = (wgid % nig) / gsz; u.eb = 0; u.ko = 0; return true;
    }
    __device__ __forceinline__ void a_ready(const Unit&) const {}
    __device__ __forceinline__ void done(const Unit&) const {}
    __device__ __forceinline__ void pre(int) const {}
    __device__ __forceinline__ void post(int) const {}
};


__device__ __forceinline__ unsigned cvt_pk_bf16(float lo, float hi) { unsigned r; asm volatile("v_cvt_pk_bf16_f32 %0, %1, %2" : "=v"(r) : "v"(lo), "v"(hi)); return r; }
typedef unsigned u32x2 __attribute__((ext_vector_type(2)));
__device__ __forceinline__ void row_rs8_load(const float* ssq, int row0, int fq, f32x4 (&p)[2][4]) {
#pragma unroll
    for (int ai = 0; ai < 2; ++ai)
#pragma unroll
        for (int m = 0; m < 4; ++m) p[ai][m] = *(const f32x4*)(ssq + (size_t)(row0 + ai * HALF + m * 16) * 16 + 4 * fq);
}
__device__ __forceinline__ void row_rs8_reduce(const f32x4 (&p)[2][4], float (&rs)[2][4]) {
#pragma unroll
    for (int ai = 0; ai < 2; ++ai)
#pragma unroll
        for (int m = 0; m < 4; ++m) { float s = (p[ai][m][0] + p[ai][m][1]) + (p[ai][m][2] + p[ai][m][3]); s = fq_sum(s); rs[ai][m] = __builtin_amdgcn_rsqf(s * (1.0f / cfg::D) + cfg::EPS); }
}
__device__ __forceinline__ void row_rs8(const float* ssq, int row0, int fq, float (&rs)[2][4]) {
#pragma unroll
    for (int ai = 0; ai < 2; ++ai)
#pragma unroll
        for (int m = 0; m < 4; ++m) { const f32x4 p = *(const f32x4*)(ssq + (size_t)(row0 + ai * HALF + m * 16) * 16 + 4 * fq);
            float s = (p[0] + p[1]) + (p[2] + p[3]); s = fq_sum(s);
            rs[ai][m] = __builtin_amdgcn_rsqf(s * (1.0f / cfg::D) + cfg::EPS); }
}
template <bool DO_ROPE = true, bool DO_RS = true> struct EpiRopeT {
    static constexpr bool PERM = true, AFTER_DRAIN = false;
    bf16_t* O; const float* ssq; const float* rope;
    static __device__ __forceinline__ void store_pair(bf16_t* p, const f32x4 v0, const f32x4 v1) {
        float a0 = __builtin_bit_cast(float, cvt_pk_bf16(v0[0], v0[1])), a1 = __builtin_bit_cast(float, cvt_pk_bf16(v0[2], v0[3]));
        float b0 = __builtin_bit_cast(float, cvt_pk_bf16(v1[0], v1[1])), b1 = __builtin_bit_cast(float, cvt_pk_bf16(v1[2], v1[3]));
        pl32_swap(a0, b0); pl32_swap(a1, b1);
        u32x4 w; w.x = __builtin_bit_cast(unsigned, a0); w.y = __builtin_bit_cast(unsigned, a1); w.z = __builtin_bit_cast(unsigned, b0); w.w = __builtin_bit_cast(unsigned, b1);
        *(u32x4*)p = w;
    }
    __device__ __forceinline__ void operator()(const f32x4 (&acc)[2][2][4][2], const Unit& u, int wr, int wc, int fr, int fq) const {
        const int row0 = u.pm * BM + wr * 64 + fr;
        const int q8 = (wc & 1) * 4 + 2 * (fq & 1) + (fq >> 1);
        const int cst = (fq >> 1) * 32 + 8 * (2 * (wc & 1) + (fq & 1));
        const bool any_rope = DO_ROPE && ((u.pn < 4) || (u.pn >= 6));
        f32x4 praw[2][4]; if (DO_RS) row_rs8_load(ssq, row0, fq, praw);
        f32x4 coa[2][4], sia[2][4];
#define ROPE_LOAD(ai_) do { if (any_rope) { _Pragma("unroll") for (int m = 0; m < 4; ++m) { const int r = row0 + (ai_) * HALF + m * 16; const float* cs = rope + (size_t)(r & (cfg::S - 1)) * 32 + 4 * q8; \
            coa[ai_][m] = *(const f32x4*)cs; sia[ai_][m] = *(const f32x4*)(cs + cfg::S * 32); } } } while (0)
        ROPE_LOAD(0);
        float rs[2][4];
        if (DO_RS) row_rs8_reduce(praw, rs); else { _Pragma("unroll") for (int a_ = 0; a_ < 2; ++a_) _Pragma("unroll") for (int m_ = 0; m_ < 4; ++m_) rs[a_][m_] = 1.0f; }
        ROPE_LOAD(1);
#undef ROPE_LOAD
#pragma unroll
        for (int ai = 0; ai < 2; ++ai) {
            const f32x4 (&co)[4] = coa[ai]; const f32x4 (&si)[4] = sia[ai];
#pragma unroll
            for (int bj = 0; bj < 2; ++bj) {
                const int hb = u.pn * 4 + bj * 2 + (wc >> 1);
                const bool roped = DO_ROPE && ((hb < 16) || (hb >= 24 && hb < 34));
                const bool isq = (hb < 8) || (hb >= 24 && hb < 32);
                const float sc = isq ? cfg::C2 : 1.0f;
                bf16_t* pb = O + (size_t)(row0 + ai * HALF) * cfg::INW + hb * 64 + cst;
                if (roped) {
#pragma unroll
                    for (int m = 0; m < 4; ++m) { const float f = rs[ai][m] * sc; const f32x4 v0 = acc[ai][bj][m][0] * f, v1 = acc[ai][bj][m][1] * f;
                        store_pair(pb + (size_t)m * 16 * cfg::INW, v0 * co[m] - v1 * si[m], v1 * co[m] + v0 * si[m]); }
                } else {
#pragma unroll
                    for (int m = 0; m < 4; ++m) { const float f = rs[ai][m] * sc; store_pair(pb + (size_t)m * 16 * cfg::INW, acc[ai][bj][m][0] * f, acc[ai][bj][m][1] * f); }
                }
            }
        }
    }
};
typedef EpiRopeT<true, true> EpiRope;
struct EpiResid {
    static constexpr bool PERM = true, AFTER_DRAIN = false;
    bf16_t* x; float* ssq;
    __device__ __forceinline__ void operator()(const f32x4 (&acc)[2][2][4][2], const Unit& u, int wr, int wc, int fr, int fq) const {
        const int row0 = u.pm * BM + wr * 64 + fr, col0 = u.pn * BM + wc * 32 + 8 * fq;
#pragma unroll
        for (int ai = 0; ai < 2; ++ai) {
            u32x4 b[4][2];
#pragma unroll
            for (int m = 0; m < 4; ++m) { const bf16_t* p = x + (size_t)(row0 + ai * HALF + m * 16) * cfg::D + col0; b[m][0] = *(const u32x4*)p; b[m][1] = *(const u32x4*)(p + HALF); }
#pragma unroll
            for (int m = 0; m < 4; ++m) { const int r = row0 + ai * HALF + m * 16; bf16_t* p = x + (size_t)r * cfg::D + col0; float s = 0.f;
#pragma unroll
                for (int bj = 0; bj < 2; ++bj) { const u32x4 bb = b[m][bj]; const f32x4 a0 = acc[ai][bj][m][0], a1 = acc[ai][bj][m][1];
                    const float o0 = __builtin_bit_cast(float, bb.x << 16) + a0[0], o1 = __builtin_bit_cast(float, bb.x & 0xffff0000u) + a0[1], o2 = __builtin_bit_cast(float, bb.y << 16) + a0[2], o3 = __builtin_bit_cast(float, bb.y & 0xffff0000u) + a0[3];
                    const float o4 = __builtin_bit_cast(float, bb.z << 16) + a1[0], o5 = __builtin_bit_cast(float, bb.z & 0xffff0000u) + a1[1], o6 = __builtin_bit_cast(float, bb.w << 16) + a1[2], o7 = __builtin_bit_cast(float, bb.w & 0xffff0000u) + a1[3];
                    s += ((o0 * o0 + o1 * o1) + (o2 * o2 + o3 * o3)) + ((o4 * o4 + o5 * o5) + (o6 * o6 + o7 * o7));
                    u32x4 w; w.x = cvt_pk_bf16(o0, o1); w.y = cvt_pk_bf16(o2, o3); w.z = cvt_pk_bf16(o4, o5); w.w = cvt_pk_bf16(o6, o7);
                    *(u32x4*)(p + bj * HALF) = w; }
                s = fq_sum(s);
                if (fq == 0) ssq[(size_t)r * 16 + u.pn * 4 + wc] = s; }
        }
    }
};
typedef float f32x2 __attribute__((ext_vector_type(2)));
__device__ __forceinline__ f32x2 silu_mul2(f32x2 gs, f32x2 gu) {
    f32x2 e; e.x = __builtin_amdgcn_exp2f(gs.x); e.y = __builtin_amdgcn_exp2f(gs.y);
    const f32x2 d = e + 1.0f; f32x2 r; r.x = __builtin_amdgcn_rcpf(d.x); r.y = __builtin_amdgcn_rcpf(d.y);
    return gu * r;
}
template <bool RS> struct EpiSwiglu {
    static constexpr bool PERM = true, AFTER_DRAIN = false;
    bf16_t* H; const float* ssq;
    __device__ __forceinline__ void operator()(const f32x4 (&acc)[2][2][4][2], const Unit& u, int wr, int wc, int fr, int fq) const {
        const int row0 = u.pm * BM + wr * 64 + fr, col0 = u.pn * HALF + wc * 32 + 8 * fq;
        float rs[2][4];
        if (RS) row_rs8(ssq, row0, fq, rs);
#pragma unroll
        for (int ai = 0; ai < 2; ++ai)
#pragma unroll
            for (int m = 0; m < 4; ++m) { const int r = row0 + ai * HALF + m * 16; const float f = RS ? rs[ai][m] : 1.0f, fe = -cfg::LOG2E * f, ff = f * f;
                unsigned w[4];
#pragma unroll
                for (int n = 0; n < 2; ++n) { const f32x4 g = acc[ai][0][m][n], up = acc[ai][1][m][n];
                    const f32x2 ga = {g[0], g[1]}, gb = {g[2], g[3]}, ua = {up[0], up[1]}, ub = {up[2], up[3]};
                    const f32x2 ha = silu_mul2(ga * fe, RS ? (ga * ua) * ff : ga * ua), hb = silu_mul2(gb * fe, RS ? (gb * ub) * ff : gb * ub);
                    w[2 * n] = cvt_pk_bf16(ha.x, ha.y); w[2 * n + 1] = cvt_pk_bf16(hb.x, hb.y); }
                u32x4 wv; wv.x = w[0]; wv.y = w[1]; wv.z = w[2]; wv.w = w[3];
                *(u32x4*)(H + (size_t)r * cfg::FF + col0) = wv; }
    }
};
struct EpiY {
    static constexpr bool PERM = true, AFTER_DRAIN = false;
    bf16_t* Y; const float* gate;
    __device__ __forceinline__ void operator()(const f32x4 (&acc)[2][2][4][2], const Unit& u, int wr, int wc, int fr, int fq) const {
        const int row0 = u.pm * BM + wr * 64 + fr, col0 = u.pn * BM + wc * 32 + 8 * fq;
        float gt[2][4];
#pragma unroll
        for (int ai = 0; ai < 2; ++ai)
#pragma unroll
            for (int m = 0; m < 4; ++m) gt[ai][m] = gate[row0 + ai * HALF + m * 16];
#pragma unroll
        for (int ai = 0; ai < 2; ++ai)
#pragma unroll
            for (int m = 0; m < 4; ++m) { const int r = row0 + ai * HALF + m * 16; const float f = gt[ai][m];
#pragma unroll
                for (int bj = 0; bj < 2; ++bj) { const f32x4 v0 = acc[ai][bj][m][0] * f, v1 = acc[ai][bj][m][1] * f;
                    u32x4 w; w.x = cvt_pk_bf16(v0[0], v0[1]); w.y = cvt_pk_bf16(v0[2], v0[3]); w.z = cvt_pk_bf16(v1[0], v1[1]); w.w = cvt_pk_bf16(v1[2], v1[3]);
                    *(u32x4*)(Y + (size_t)r * cfg::D + col0 + bj * HALF) = w; } }
    }
};
struct EpiNull {
    static constexpr bool PERM = true, AFTER_DRAIN = false;
    __device__ __forceinline__ void operator()(const f32x4 (&acc)[2][2][4][2], const Unit& u, int wr, int wc, int fr, int fq) const {
#pragma unroll
        for (int ai = 0; ai < 2; ++ai)
#pragma unroll
            for (int bj = 0; bj < 2; ++bj)
#pragma unroll
                for (int m = 0; m < 4; ++m)
#pragma unroll
                    for (int n = 0; n < 2; ++n) asm volatile("" :: "v"(acc[ai][bj][m][n]));
    }
};
struct EpiRaw {
    static constexpr bool PERM = true, AFTER_DRAIN = false;
    bf16_t* H;
    __device__ __forceinline__ void operator()(const f32x4 (&acc)[2][2][4][2], const Unit& u, int wr, int wc, int fr, int fq) const {
        const int row0 = u.pm * BM + wr * 64 + fr, col0 = u.pn * HALF + wc * 32 + 8 * fq;
#pragma unroll
        for (int ai = 0; ai < 2; ++ai)
#pragma unroll
            for (int m = 0; m < 4; ++m) { const int r = row0 + ai * HALF + m * 16;
                const f32x4 g0 = acc[ai][0][m][0] + acc[ai][1][m][0], g1 = acc[ai][0][m][1] + acc[ai][1][m][1];
                u32x4 w; w.x = cvt_pk_bf16(g0[0], g0[1]); w.y = cvt_pk_bf16(g0[2], g0[3]); w.z = cvt_pk_bf16(g1[0], g1[1]); w.w = cvt_pk_bf16(g1[2], g1[3]);
                *(u32x4*)(H + (size_t)r * cfg::FF + col0) = w; }
    }
};
struct GroupedOrder : StaticOrder {
    const PG8_LAS int* segb;
    __device__ __forceinline__ bool next(int i, Unit& u) const {
        if (!StaticOrder::next(i, u)) return false;
        const int r = u.pm * BM; int e = 0;
#pragma unroll
        for (int k = 1; k < 8; ++k) e += (r >= segb[k]) ? 1 : 0;
        u.eb = e; return true;
    }
};

struct TailOrder {
    int npair, G, c; const PG8_LAS int* segb;
    __device__ __forceinline__ bool next(int i, Unit& u) const {
        const int L = i * G + c; if (L >= npair * cfg::KSPLIT) return false;
        const int q = L / cfg::KSPLIT, s = L % cfg::KSPLIT; u.pm = cfg::MAINROWS / BM + (q >> 2); u.pn = q & 3; u.ko = s * (cfg::FF / cfg::KSPLIT);
        const int r = u.pm * BM; int e = 0;
#pragma unroll
        for (int k = 1; k < 8; ++k) e += (r >= segb[k]) ? 1 : 0;
        u.eb = e; return true;
    }
    __device__ __forceinline__ void a_ready(const Unit&) const {}
    __device__ __forceinline__ void done(const Unit&) const {}
    __device__ __forceinline__ void pre(int) const {}
    __device__ __forceinline__ void post(int) const {}
};
struct EpiPart {
    static constexpr bool PERM = true, AFTER_DRAIN = false;
    bf16_t* PT;
    __device__ __forceinline__ void operator()(const f32x4 (&acc)[2][2][4][2], const Unit& u, int wr, int wc, int fr, int fq) const {
        const int row0 = u.pm * BM - cfg::MAINROWS + wr * 64 + fr, col0 = u.pn * BM + wc * 32 + 8 * fq, s = u.ko / (cfg::FF / cfg::KSPLIT);
        bf16_t* base = PT + (size_t)s * cfg::TAILROWS * cfg::D;
#pragma unroll
        for (int ai = 0; ai < 2; ++ai)
#pragma unroll
            for (int m = 0; m < 4; ++m) { const int r = row0 + ai * HALF + m * 16;
#pragma unroll
                for (int bj = 0; bj < 2; ++bj) { const f32x4 v0 = acc[ai][bj][m][0], v1 = acc[ai][bj][m][1];
                    u32x4 w; w.x = cvt_pk_bf16(v0[0], v0[1]); w.y = cvt_pk_bf16(v0[2], v0[3]); w.z = cvt_pk_bf16(v1[0], v1[1]); w.w = cvt_pk_bf16(v1[2], v1[3]);
                    *(u32x4*)(base + (size_t)r * cfg::D + col0 + bj * HALF) = w; } }
    }
};

template <class Epi, class Sched, bool ALIGN_EPI = false, bool SP2 = false>
__device__ __forceinline__ void gemm_phase(PG8_LAS unsigned char* lds, const Gemm g, const Sched& S, const Epi& E, const int tid_in) {
    const int tid = tid_in, wid = __builtin_amdgcn_readfirstlane(tid >> 6), lane = tid & 63, wr = wid >> 2, wc = wid & 3, fr = lane & 15, fq = lane >> 4;
    const int K = g.K, nt = K / BK, LD = g.ld;
    unsigned voffA[2], voffB[2];
#pragma unroll
    for (int i = 0; i < 2; ++i) { int R, C; stage_rc(tid * 16 + i * 8192, R, C); const int Rb = Epi::PERM ? ((R & ~31) + perm32(R & 31)) : R;
        voffA[i] = (unsigned)(R * LD + C) * 2u; voffB[i] = (unsigned)(Rb * LD + C) * 2u; }
    const size_t kstep = (size_t)(BK * 2);
    const size_t hstep = (size_t)HALF * LD * 2;
    const size_t tstep = 2 * hstep;
    const unsigned ldsw = (unsigned)wid * 1024u;
    const int aoff = lds_byte(wr * 64 + fr, fq * 8), boff = lds_byte(wc * 32 + fr, fq * 8);
#define PG8_SA(b, h) (((b) * 2 + (h)) * HTB)
#define PG8_SB(b, h) ((4 + (b) * 2 + (h)) * HTB)
#define PG8_STAGE(bufoff, gbase, voff) do { _Pragma("unroll") for (int _i = 0; _i < 2; ++_i) \
        __builtin_amdgcn_global_load_lds((const unsigned*)((const char*)(gbase) + (voff)[_i]), (PG8_LAS unsigned*)(lds + (bufoff) + ldsw + _i * 8192), 16, 0, 0); } while (0)
#define PG8_LDA(dst, b, h) do { _Pragma("unroll") for (int m = 0; m < 4; ++m) _Pragma("unroll") for (int k = 0; k < 2; ++k) dst[m][k] = *(const PG8_LAS bf16x8*)(lds + PG8_SA(b, h) + aoff + m * 2048 + k * 1024); } while (0)
#define PG8_LDB(dst, b, h) do { _Pragma("unroll") for (int n = 0; n < 2; ++n) _Pragma("unroll") for (int k = 0; k < 2; ++k) dst[n][k] = *(const PG8_LAS bf16x8*)(lds + PG8_SB(b, h) + boff + n * 2048 + k * 1024); } while (0)
#define PG8_MMA(ai, bj, At, Bt) do { __builtin_amdgcn_s_setprio(1); _Pragma("unroll") for (int m = 0; m < 4; ++m) _Pragma("unroll") for (int n = 0; n < 2; ++n) _Pragma("unroll") for (int k = 0; k < 2; ++k) \
        acc[ai][bj][m][n] = __builtin_amdgcn_mfma_f32_16x16x32_bf16(Bt[n][k], At[m][k], acc[ai][bj][m][n], 0, 0, 0); __builtin_amdgcn_s_setprio(0); } while (0)
#define PG8_WAIT_V(n) asm volatile("s_waitcnt vmcnt(" #n ")" ::: "memory")
#define PG8_WAIT_L(n) asm volatile("s_waitcnt lgkmcnt(" #n ")" ::: "memory")
#define PG8_BAR __builtin_amdgcn_s_barrier()
#define PG8_SCHED __builtin_amdgcn_sched_barrier(0)
    Unit cur, nxt; int ui = 0;
    if (!S.next(0, cur)) return;
    f32x4 acc[2][2][4][2];
#pragma unroll
    for (int a = 0; a < 2; ++a)
#pragma unroll
        for (int b = 0; b < 2; ++b)
#pragma unroll
            for (int m = 0; m < 4; ++m)
#pragma unroll
                for (int n = 0; n < 2; ++n) acc[a][b][m][n] = (f32x4){0.f, 0.f, 0.f, 0.f};
    bf16x8 At[4][2], B0[2][2], B1[2][2];
    const char* cA = (const char*)g.A + (size_t)cur.pm * tstep + (size_t)cur.ko * 2; const char* cB = (const char*)g.Bt + (size_t)cur.eb * g.bstride + (size_t)cur.pn * tstep + (size_t)cur.ko * 2;
    S.a_ready(cur);
    if constexpr (SP2) {
        PG8_STAGE(PG8_SB(0, 0), cB, voffB); PG8_STAGE(PG8_SB(0, 1), cB + hstep, voffB); PG8_STAGE(PG8_SA(0, 0), cA, voffA); PG8_STAGE(PG8_SA(0, 1), cA + hstep, voffA);
        if (wr == 1) PG8_BAR;
        PG8_WAIT_V(2); PG8_BAR;
        PG8_STAGE(PG8_SB(1, 0), cB + kstep, voffB); PG8_STAGE(PG8_SA(1, 0), cA + kstep, voffA); PG8_STAGE(PG8_SB(1, 1), cB + hstep + kstep, voffB);
        PG8_WAIT_V(6); PG8_BAR;
    } else {
        PG8_STAGE(PG8_SB(0, 0), cB, voffB); PG8_STAGE(PG8_SA(0, 0), cA, voffA); PG8_STAGE(PG8_SB(0, 1), cB + hstep, voffB); PG8_STAGE(PG8_SA(0, 1), cA + hstep, voffA);
        if (wr == 1) PG8_BAR;
        PG8_WAIT_V(4); PG8_BAR;
        PG8_STAGE(PG8_SB(1, 0), cB + kstep, voffB); PG8_STAGE(PG8_SA(1, 0), cA + kstep, voffA); PG8_STAGE(PG8_SB(1, 1), cB + hstep + kstep, voffB);
        PG8_WAIT_V(6); PG8_BAR;
    }
    for (;;) {
        const bool has_next = S.next(ui + 1, nxt);
        const char* nA = has_next ? (const char*)g.A + (size_t)nxt.pm * tstep + (size_t)nxt.ko * 2 : cA; const char* nB = has_next ? (const char*)g.Bt + (size_t)nxt.eb * g.bstride + (size_t)nxt.pn * tstep + (size_t)nxt.ko * 2 : cB;
        for (int t = 0; t < nt; t += 2) {
            const bool last = (t == nt - 2);
            const char* a1 = cA + (size_t)(t + 1) * kstep;
            const char* a2 = last ? nA : cA + (size_t)(t + 2) * kstep; const char* b2 = last ? nB : cB + (size_t)(t + 2) * kstep;
            const char* a3 = a2 + kstep; const char* b3 = b2 + kstep;
            if (last && has_next) S.a_ready(nxt);
            if constexpr (SP2) {
            PG8_LDB(B0, 0, 0); PG8_LDB(B1, 0, 1); PG8_SCHED; PG8_LDA(At, 0, 0); PG8_STAGE(PG8_SA(1, 1), a1 + hstep, voffA);
            PG8_WAIT_V(8); PG8_WAIT_L(0); PG8_BAR; PG8_MMA(0, 0, At, B0); PG8_MMA(0, 1, At, B1); PG8_BAR; PG8_SCHED;
            PG8_LDA(At, 0, 1); PG8_STAGE(PG8_SB(0, 0), b2, voffB); PG8_STAGE(PG8_SB(0, 1), b2 + hstep, voffB); PG8_STAGE(PG8_SA(0, 0), a2, voffA);
            PG8_WAIT_V(8); PG8_WAIT_L(0); PG8_BAR; PG8_MMA(1, 0, At, B0); PG8_MMA(1, 1, At, B1); PG8_BAR; PG8_SCHED;
            PG8_LDB(B0, 1, 0); PG8_LDB(B1, 1, 1); PG8_SCHED; PG8_LDA(At, 1, 0); PG8_STAGE(PG8_SA(0, 1), a2 + hstep, voffA);
            PG8_WAIT_V(8); PG8_WAIT_L(0); PG8_BAR; PG8_MMA(0, 0, At, B0); PG8_MMA(0, 1, At, B1); PG8_BAR; PG8_SCHED;
            PG8_LDA(At, 1, 1); PG8_STAGE(PG8_SB(1, 0), b3, voffB); PG8_STAGE(PG8_SB(1, 1), b3 + hstep, voffB); PG8_STAGE(PG8_SA(1, 0), a3, voffA);
            PG8_WAIT_V(8); PG8_WAIT_L(0); PG8_BAR; PG8_MMA(1, 0, At, B0); PG8_MMA(1, 1, At, B1); PG8_BAR; PG8_SCHED;
            } else {
            PG8_LDB(B0, 0, 0); PG8_SCHED; PG8_LDA(At, 0, 0); PG8_STAGE(PG8_SA(1, 1), a1 + hstep, voffA);
            PG8_WAIT_L(8); PG8_BAR; PG8_WAIT_L(0); PG8_MMA(0, 0, At, B0); PG8_BAR; PG8_SCHED;
            PG8_LDB(B1, 0, 1); PG8_STAGE(PG8_SB(0, 0), b2, voffB);
            PG8_BAR; PG8_WAIT_L(0); PG8_MMA(0, 1, At, B1); PG8_BAR;
            PG8_LDA(At, 0, 1); PG8_STAGE(PG8_SA(0, 0), a2, voffA);
            PG8_BAR; PG8_WAIT_L(0); PG8_MMA(1, 0, At, B0); PG8_BAR; PG8_SCHED;
            PG8_STAGE(PG8_SB(0, 1), b2 + hstep, voffB);
            PG8_WAIT_V(6); PG8_BAR; PG8_MMA(1, 1, At, B1); PG8_BAR;
            PG8_LDB(B0, 1, 0); PG8_SCHED; PG8_LDA(At, 1, 0); PG8_STAGE(PG8_SA(0, 1), a2 + hstep, voffA);
            PG8_WAIT_L(8); PG8_BAR; PG8_WAIT_L(0); PG8_MMA(0, 0, At, B0); PG8_BAR; PG8_SCHED;
            PG8_LDB(B1, 1, 1); PG8_STAGE(PG8_SB(1, 0), b3, voffB);
            PG8_BAR; PG8_WAIT_L(0); PG8_MMA(0, 1, At, B1); PG8_BAR;
            PG8_LDA(At, 1, 1); PG8_STAGE(PG8_SA(1, 0), a3, voffA);
            PG8_BAR; PG8_WAIT_L(0); PG8_MMA(1, 0, At, B0); PG8_BAR; PG8_SCHED;
            PG8_STAGE(PG8_SB(1, 1), b3 + hstep, voffB);
            PG8_WAIT_V(6); PG8_BAR; PG8_MMA(1, 1, At, B1); PG8_BAR;
            }
        }
        if constexpr (ALIGN_EPI) { if (wr == 0) PG8_BAR; }
        if constexpr (!Epi::AFTER_DRAIN) { S.pre(ui); E(acc, cur, wr, wc, fr, fq); S.post(ui); S.done(cur); }
        if (!has_next) break;
#pragma unroll
        for (int a = 0; a < 2; ++a)
#pragma unroll
            for (int b = 0; b < 2; ++b)
#pragma unroll
                for (int m = 0; m < 4; ++m)
#pragma unroll
                    for (int n = 0; n < 2; ++n) acc[a][b][m][n] = (f32x4){0.f, 0.f, 0.f, 0.f};
        cur = nxt; cA = nA; cB = nB; ++ui;
        if constexpr (ALIGN_EPI) { if (wr == 1) PG8_BAR; }
    }
    PG8_WAIT_V(0);
    if constexpr (!ALIGN_EPI) { if (wr == 0) PG8_BAR; }
    PG8_BAR;
    if constexpr (Epi::AFTER_DRAIN) { E.fused(acc, cur, wr, wc, fr, fq, lds, wid, lane); S.done(cur); }
#undef PG8_SA
#undef PG8_SB
#undef PG8_STAGE
#undef PG8_LDA
#undef PG8_LDB
#undef PG8_MMA
#undef PG8_WAIT_V
#undef PG8_WAIT_L
#undef PG8_BAR
#undef PG8_SCHED
}
}


using namespace cfg;
constexpr size_t MiB = 1u << 20;
constexpr size_t WS_CTL = 0, CTL_ZERO_BYTES = 1 * MiB;
constexpr size_t WS_ROPE = 1 * MiB;
constexpr size_t WS_SSQA = 3 * MiB;
constexpr size_t WS_SSQF = 5 * MiB;
constexpr size_t WS_ROUTE = 7 * MiB;
constexpr size_t WS_BLKCNT = 8 * MiB;
constexpr size_t WS_ROWGATE = 9 * MiB;
constexpr size_t WS_WIN = 16 * MiB;
constexpr size_t WS_WOUT = 34 * MiB;
constexpr size_t WS_WGU = 42 * MiB;
constexpr size_t WS_WDN = 70 * MiB;
constexpr size_t WS_MGU = 84 * MiB;
constexpr size_t WS_MDN = 196 * MiB;
constexpr size_t WS_XN = 252 * MiB;
constexpr size_t WS_PROJ = 316 * MiB;
constexpr size_t WS_OPART = 460 * MiB;
constexpr size_t WS_LSE = 588 * MiB;
constexpr size_t WS_MIX = 592 * MiB;
constexpr size_t WS_H = 316 * MiB;
constexpr size_t WS_AP = 778 * MiB;
constexpr size_t WS_PT = 910 * MiB;
constexpr size_t WS_END = WS_PT + (size_t)KSPLIT * TAILROWS * D * 2;
static_assert(WS_H + (size_t)MAXROWS * FF * 2 <= WS_AP && WS_AP + (size_t)MAXROWS * D * 2 <= WS_END && WS_MIX + (size_t)M * D * 2 <= WS_AP, "d_ws map");
static_assert(WS_ROWGATE + (size_t)MAXROWS * 4 <= WS_WIN && WS_LSE + (size_t)3 * M * 8 * 4 <= WS_MIX, "d_ws map 2");
constexpr int CW_BAR = 4096;
constexpr int LDS_BYTES = 147456;
constexpr int RING_OFF = 0, RING_BYTES = 131072;
constexpr int LDSCTL_OFF = LDS_BYTES - 1024, MISC_OFF = LDSCTL_OFF + 320;
constexpr int NWAVES = 8;

#define GAS __attribute__((address_space(1)))
#define LAS __attribute__((address_space(3)))
typedef unsigned short bf16;
typedef unsigned v4u __attribute__((ext_vector_type(4)));
typedef float f32x4 __attribute__((ext_vector_type(4)));
typedef short bf16x8 __attribute__((ext_vector_type(8)));
typedef GAS unsigned gu32;
typedef GAS unsigned long long gu64;
#define RLX_AGENT __ATOMIC_RELAXED, __HIP_MEMORY_SCOPE_AGENT
#define LDS_WAIT() asm volatile("s_waitcnt lgkmcnt(0)" ::: "memory")
#define VM_WAIT() asm volatile("s_waitcnt vmcnt(0)" ::: "memory")
__device__ __forceinline__ unsigned long long rt() { return __builtin_amdgcn_s_memrealtime(); }
__device__ __forceinline__ unsigned f2bf(float f) { unsigned u = __builtin_bit_cast(unsigned, f); return (u + 0x7fffu + ((u >> 16) & 1u)) >> 16; }
__device__ __forceinline__ unsigned pk2(float lo, float hi) { return f2bf(lo) | (f2bf(hi) << 16); }

#define XB_TMO      128
#define XB_XCNT(j)  (256  + 64 * (j))
#define XB_XSUB(j)  (1280 + 64 * (j))
#define XB_XGEN(j)  (2304 + 64 * (j))
#define XB_TOP      3328
#define XB_TOPGEN   3392
#define XCD_BAR_WORDS 3456
#define XB_SPIN_CAP (1u << 18)

__device__ __forceinline__ unsigned xb_ld(unsigned* p)              { return __hip_atomic_load(p, __ATOMIC_RELAXED, __HIP_MEMORY_SCOPE_AGENT); }
__device__ __forceinline__ unsigned xb_add(unsigned* p, unsigned v) { return __hip_atomic_fetch_add(p, v, __ATOMIC_RELAXED, __HIP_MEMORY_SCOPE_AGENT); }
__device__ __forceinline__ unsigned xb_xcc_id() { return (unsigned)__builtin_amdgcn_s_getreg((3 << 11) | 20) & 0xFu; }
#define XB_SPIN(cond, bar) do { unsigned _sp = 0; while (cond) { __builtin_amdgcn_s_sleep(1); \
    if ((++_sp & 255u) == 0u) { if (xb_ld(&(bar)[XB_TMO])) break; if (_sp > XB_SPIN_CAP) { atomicAdd(&(bar)[XB_TMO], 1u); break; } } } } while (0)

struct XcdBarrier {
    unsigned* bar; unsigned x;
    volatile LAS unsigned* st;
};

__device__ __forceinline__ XcdBarrier xcd_barrier_post(unsigned* bar, volatile LAS unsigned* st, const int tidx) {
    XcdBarrier b; b.bar = bar; b.x = xb_xcc_id(); b.st = st;
    if (tidx == 0) (void)xb_add(&bar[XB_XCNT(b.x)], 1u);
    return b;
}
__device__ __forceinline__ void xcd_barrier_complete(unsigned* bar, unsigned x, unsigned& nloc, unsigned& nx) {
    const unsigned G = gridDim.x * gridDim.y * gridDim.z;
    unsigned sum, cnt, mine, sp = 0u;
    for (;;) {
        sum = 0u; cnt = 0u; mine = 0u;
#pragma unroll
        for (unsigned j = 0; j < 16; ++j) { const unsigned c = xb_ld(&bar[XB_XCNT(j)]); sum += c; cnt += (c > 0u) ? 1u : 0u; mine = (j == x) ? c : mine; }
        if (sum == G) break;
        __builtin_amdgcn_s_sleep(1);
        if ((++sp & 255u) == 0u) { if (xb_ld(&bar[XB_TMO])) break; if (sp > XB_SPIN_CAP) { atomicAdd(&bar[XB_TMO], 1u); break; } }
    }
    nloc = mine > 0u ? mine : 1u; nx = cnt > 0u ? cnt : 1u;
}

__device__ __forceinline__ void xcd_barrier(const XcdBarrier& b, const int tidx) {
    asm volatile("s_waitcnt vmcnt(0)" ::: "memory");
    __syncthreads();
    if (tidx == 0) {
        unsigned* bar = b.bar;
        __builtin_amdgcn_s_waitcnt(0);
        unsigned nloc = b.st[0], nx = b.st[1];
        if (nloc == 0u) { xcd_barrier_complete(bar, b.x, nloc, nx); b.st[0] = nloc; b.st[1] = nx; }
        const unsigned old = xb_add(&bar[XB_XSUB(b.x)], 1u);
        const unsigned gen = old / nloc;
        if (old + 1u == (gen + 1u) * nloc) {
            __builtin_amdgcn_fence(__ATOMIC_RELEASE, "agent");
            asm volatile("s_waitcnt vmcnt(0)" ::: "memory");
            const unsigned og = xb_add(&bar[XB_TOP], 1u);
            const unsigned tg = og / nx;
            if (og + 1u == (tg + 1u) * nx) xb_add(&bar[XB_TOPGEN], 1u);
            else XB_SPIN(xb_ld(&bar[XB_TOPGEN]) == tg, bar);
            __builtin_amdgcn_fence(__ATOMIC_ACQUIRE, "agent");
            xb_add(&bar[XB_XGEN(b.x)], 1u);
            asm volatile("s_waitcnt vmcnt(0)" ::: "memory");
        } else {
            XB_SPIN(xb_ld(&bar[XB_XGEN(b.x)]) == gen, bar);
            __builtin_amdgcn_fence(__ATOMIC_ACQUIRE, "agent");
            asm volatile("s_waitcnt vmcnt(0)" ::: "memory");
        }
    }
    __syncthreads();
}


__device__ __forceinline__ float wave_sum(float v) {
    v += swz_xor<1>(v); v += swz_xor<2>(v); v += swz_xor<4>(v); v += swz_xor<8>(v); v += swz_xor<16>(v);
    return xor32_sum(v);
}
__device__ __forceinline__ int wave_sum_i(int v) {
    return (int)(wave_sum((float)v) + 0.5f);
}
__device__ __forceinline__ float bf2f(unsigned short b) { return __builtin_bit_cast(float, (unsigned)b << 16); }
__device__ __forceinline__ float bflo(unsigned w) { return __builtin_bit_cast(float, w << 16); }
__device__ __forceinline__ float bfhi(unsigned w) { return __builtin_bit_cast(float, w & 0xffff0000u); }
typedef unsigned u32x2v __attribute__((ext_vector_type(2)));

struct Ctx { LAS unsigned char* lds; int tid, lane, wave, gw, ngw; };

__device__ __forceinline__ int rowmap(int mode, int n) {
    if (mode == 1) { const int hb = n >> 6, w = n & 63, nn = w >> 5, i = w & 31, gi = i >> 2, fq = ((gi & 1) << 1) | ((gi >> 1) & 1);
        return (hb << 6) + 32 * (gi >> 2) + 8 * fq + 4 * nn + (i & 3); }
    if (mode == 2) return 256 * (n >> 7) + (n & 127);
    if (mode == 3) return 256 * (n >> 7) + 128 + (n & 127);
    return n;
}
struct ConvJob { const float* W; bf16* WT; const float* gain; int K, N, mode, item; };
__device__ __forceinline__ void tr_load(const ConvJob& J, int lane, f32x4 (&v)[8]) {
    const int nblk = J.N / 32, kb = J.item / nblk, nb = J.item % nblk, k0 = 64 * kb, n0 = 32 * nb, lr = lane >> 3, lc = lane & 7;
#pragma unroll
    for (int i = 0; i < 8; ++i) v[i] = *(const GAS f32x4*)(J.W + (size_t)(k0 + 8 * i + lr) * J.N + n0 + 4 * lc);
    if (J.gain) {
#pragma unroll
        for (int i = 0; i < 8; ++i) v[i] = v[i] * J.gain[k0 + 8 * i + lr];
    }
}
__device__ __forceinline__ void tr_store(const ConvJob& J, int lane, LAS float* scr, const f32x4 (&v)[8]) {
    const int nblk = J.N / 32, kb = J.item / nblk, nb = J.item % nblk, k0 = 64 * kb, n0 = 32 * nb, lr = lane >> 3, lc = lane & 7;
#pragma unroll
    for (int i = 0; i < 8; ++i) { LAS float* d = scr + (8 * i + lr) * 33 + 4 * lc; d[0] = v[i][0]; d[1] = v[i][1]; d[2] = v[i][2]; d[3] = v[i][3]; }
    LDS_WAIT(); asm volatile("" ::: "memory");
    const int c = lane & 7;
#pragma unroll
    for (int j = 0; j < 4; ++j) { const int n = (lane >> 3) + 8 * j; const LAS float* s = scr + (8 * c) * 33 + n;
        v4u o; o.x = pk2(s[0 * 33], s[1 * 33]); o.y = pk2(s[2 * 33], s[3 * 33]); o.z = pk2(s[4 * 33], s[5 * 33]); o.w = pk2(s[6 * 33], s[7 * 33]);
        *(GAS v4u*)(J.WT + (size_t)rowmap(J.mode, n0 + n) * J.K + k0 + 8 * c) = o; }
    LDS_WAIT(); asm volatile("" ::: "memory");
}
constexpr int IT_FF = (D / 64) * (FF / 32), IT_IN = (D / 64) * (INW / 32), IT_OUT = (D / 64) * (D / 32);
static_assert((FF / 64) * (D / 32) == IT_FF, "items");
constexpr int MOE_ITEMS = NE * 3 * IT_FF, PRO_ITEMS = DEPTH * (IT_IN + IT_OUT) + 6 * IT_FF;
struct ConvSrc { const float *w_in, *w_out, *attn_norm, *ffn_norm, *dwg, *dwu, *dwd; bf16 *WIN_, *WOUT_, *WGU_, *WDN_; };
__device__ __forceinline__ ConvJob conv_decode_moe(int f, const float* wg, const float* wu, const float* wd, bf16* MGU_, bf16* MDN_) {
    const int job = f / IT_FF, e = job / 3, which = job % 3; ConvJob J; J.item = f % IT_FF; J.gain = nullptr;
    if (which == 2) { J.W = wd + (size_t)e * FF * D; J.WT = MDN_ + (size_t)e * D * FF; J.K = FF; J.N = D; J.mode = 0; }
    else { J.W = (which ? wu : wg) + (size_t)e * D * FF; J.WT = MGU_ + (size_t)e * 2 * FF * D; J.K = D; J.N = FF; J.mode = 2 + which; }
    return J;
}
__device__ __forceinline__ ConvJob conv_decode_pro(int f, const ConvSrc& S) {
    ConvJob J;
    if (f < DEPTH * IT_IN) { const int l = f / IT_IN; J.item = f % IT_IN; J.W = S.w_in + (size_t)l * D * INW; J.WT = S.WIN_ + (size_t)l * INW * D; J.gain = S.attn_norm + l * D; J.K = D; J.N = INW; J.mode = 1; return J; }
    f -= DEPTH * IT_IN;
    if (f < DEPTH * IT_OUT) { const int l = f / IT_OUT; J.item = f % IT_OUT; J.W = S.w_out + (size_t)l * D * D; J.WT = S.WOUT_ + (size_t)l * D * D; J.gain = nullptr; J.K = D; J.N = D; J.mode = 0; return J; }
    f -= DEPTH * IT_OUT;
    const int job = f / IT_FF, j = job / 3, which = job % 3; J.item = f % IT_FF;
    if (which == 2) { J.W = S.dwd + (size_t)j * FF * D; J.WT = S.WDN_ + (size_t)j * D * FF; J.gain = nullptr; J.K = FF; J.N = D; J.mode = 0; }
    else { J.W = (which ? S.dwu : S.dwg) + (size_t)j * D * FF; J.WT = S.WGU_ + (size_t)j * 2 * FF * D; J.gain = S.ffn_norm + (2 * j) * D; J.K = D; J.N = FF; J.mode = 2 + which; }
    return J;
}
#define CONV_LOOP(total, DECODE) do { LAS float* scr_ = (LAS float*)(C.lds + RING_OFF + C.wave * 17408); \
    for (int f_ = C.gw; f_ < (total); f_ += 2 * C.ngw) { f32x4 va_[8], vb_[8]; const bool two_ = f_ + C.ngw < (total); \
        const ConvJob Ja_ = DECODE(f_); tr_load(Ja_, C.lane, va_); \
        ConvJob Jb_ = Ja_; if (two_) { Jb_ = DECODE(f_ + C.ngw); tr_load(Jb_, C.lane, vb_); } \
        tr_store(Ja_, C.lane, scr_, va_); if (two_) tr_store(Jb_, C.lane, scr_ + 2176, vb_); } } while (0)
__device__ __forceinline__ void convert_moe_layer(const Ctx& C, const float* wg, const float* wu, const float* wd, bf16* MGU_, bf16* MDN_) {
#define DEC_MOE(f) conv_decode_moe((f), wg, wu, wd, MGU_, MDN_)
    CONV_LOOP(MOE_ITEMS, DEC_MOE);
#undef DEC_MOE
}
__device__ __forceinline__ void convert_prologue(const Ctx& C, const ConvSrc& S) {
#define DEC_PRO(f) conv_decode_pro((f), S)
    CONV_LOOP(PRO_ITEMS, DEC_PRO);
#undef DEC_PRO
}

__device__ __forceinline__ void ld16bf(const bf16* p, float (&v)[16]) {
    const v4u a = *(const GAS v4u*)p, b = *(const GAS v4u*)(p + 8);
    v[0] = bflo(a.x); v[1] = bfhi(a.x); v[2] = bflo(a.y); v[3] = bfhi(a.y); v[4] = bflo(a.z); v[5] = bfhi(a.z); v[6] = bflo(a.w); v[7] = bfhi(a.w);
    v[8] = bflo(b.x); v[9] = bfhi(b.x); v[10] = bflo(b.y); v[11] = bfhi(b.y); v[12] = bflo(b.z); v[13] = bfhi(b.z); v[14] = bflo(b.w); v[15] = bfhi(b.w);
}
__device__ __forceinline__ void st16bf(bf16* p, const float (&v)[16], float f) {
    v4u a, b; a.x = pk2(v[0] * f, v[1] * f); a.y = pk2(v[2] * f, v[3] * f); a.z = pk2(v[4] * f, v[5] * f); a.w = pk2(v[6] * f, v[7] * f);
    b.x = pk2(v[8] * f, v[9] * f); b.y = pk2(v[10] * f, v[11] * f); b.z = pk2(v[12] * f, v[13] * f); b.w = pk2(v[14] * f, v[15] * f);
    *(GAS v4u*)p = a; *(GAS v4u*)(p + 8) = b;
}
__device__ __forceinline__ void attn_run(const bf16* PROJ, int rowb, int t, int d, int nk, int kcol, int vcol, const float (&q)[16], float (&o)[16], float& mx, float& l) {
    for (int k = 0; k < nk; ++k) {
        const int j = t - d * k; if (j < 0) break;
        const bf16* kr = PROJ + (size_t)(rowb + j) * INW;
        float kv[16]; ld16bf(kr + kcol, kv);
        float s = 0.f;
#pragma unroll
        for (int i = 0; i < 16; ++i) s += q[i] * kv[i];
        s += swz_xor<1>(s); s += swz_xor<2>(s);
        if (s > mx) { const float sc = __builtin_amdgcn_exp2f(mx - s); l *= sc;
#pragma unroll
            for (int i = 0; i < 16; ++i) o[i] *= sc;
            mx = s; }
        const float p = __builtin_amdgcn_exp2f(s - mx); l += p;
        float vv[16]; ld16bf(kr + vcol, vv);
#pragma unroll
        for (int i = 0; i < 16; ++i) o[i] += p * vv[i];
    }
}
__device__ __forceinline__ void attn_naive(const Ctx& C, const bf16* PROJ, bf16* OPART, float* LSE, const float* sinks) {
    const int grp = (blockIdx.x * 512 + C.tid) >> 2, sub = C.tid & 3, ngrp = gridDim.x * 128;
    for (int it = grp; it < M * 16; it += ngrp) {
        const int hh = it / M, row = it % M, t = row & (S - 1), rowb = row - t;
        if (hh < 8) {
            float q[16]; ld16bf(PROJ + (size_t)row * INW + QA_OFF + hh * 64 + sub * 16, q);
#pragma unroll 1
            for (int br = 0; br < 3; ++br) {
                const int d = (br == 0) ? 1 : (br == 1) ? 4 : 16;
                float o[16]; float mx = -INFINITY, l = 0.f;
#pragma unroll
                for (int i = 0; i < 16; ++i) o[i] = 0.f;
                attn_run(PROJ, rowb, t, d, 129, KA_OFF + hh * 64 + sub * 16, VA_OFF + hh * 64 + sub * 16, q, o, mx, l);
                st16bf(OPART + ((size_t)br * M + row) * 512 + hh * 64 + sub * 16, o, 1.0f / l);
                if (sub == 0) LSE[((size_t)br * M + row) * 8 + hh] = mx + __builtin_amdgcn_logf(l);
            }
        } else {
            const int hq = hh - 8, kvh = hq >> 2;
            float q[16]; ld16bf(PROJ + (size_t)row * INW + QB_OFF + hq * 64 + sub * 16, q);
            float o[16]; float mx = -INFINITY, l = 0.f;
#pragma unroll
            for (int i = 0; i < 16; ++i) o[i] = 0.f;
            attn_run(PROJ, rowb, t, 1, 128, KB_OFF + kvh * 64 + sub * 16, VB_OFF + kvh * 64 + sub * 16, q, o, mx, l);
            const float sk = sinks[hq] * LOG2E, m2 = fmaxf(mx, sk), sc = __builtin_amdgcn_exp2f(mx - m2);
            l = l * sc + __builtin_amdgcn_exp2f(sk - m2);
            st16bf(OPART + ((size_t)3 * M + row) * 512 + hq * 64 + sub * 16, o, sc / l);
        }
    }
}


namespace att {
typedef short bf16x8 __attribute__((ext_vector_type(8)));
typedef short s16x4 __attribute__((ext_vector_type(4)));
typedef float f32x16 __attribute__((ext_vector_type(16)));
typedef unsigned u32x4 __attribute__((ext_vector_type(4)));
constexpr int LK = 0, LV = 49152, LWS = 98304, LOST = 100352, LEND = 133120;
static_assert(LEND <= LDSCTL_OFF, "attention LDS");
__device__ __forceinline__ int crow(int r, int hi) { return (r & 3) + 8 * (r >> 2) + 4 * hi; }
__device__ __forceinline__ void glds16(const void* gsrc, unsigned lds_dst) { unsigned keep;
    asm volatile("s_mov_b32 %0, m0\n\ts_mov_b32 m0, %2\n\ts_nop 0\n\tglobal_load_lds_dwordx4 %1, off\n\ts_mov_b32 m0, %0" : "=&s"(keep) : "v"(gsrc), "s"(lds_dst) : "memory"); }
__device__ __forceinline__ unsigned cvtpk(float lo, float hi) { unsigned r; asm("v_cvt_pk_bf16_f32 %0, %1, %2" : "=v"(r) : "v"(lo), "v"(hi)); return r; }
__device__ __forceinline__ float xhalf_max(float m) { return xor32_max(m); }
__device__ __forceinline__ float xhalf_sum(float m) { return xor32_sum(m); }
__device__ __forceinline__ f32x16 qk32(const LAS unsigned char* ktile, int half, const bf16x8 (&qr)[4], int r32, int hi) {
    const LAS unsigned char* kb = ktile + (r32 + 32 * half) * 128; const int sw = (r32 >> 1) & 7;
    f32x16 p = {0.f, 0.f, 0.f, 0.f, 0.f, 0.f, 0.f, 0.f, 0.f, 0.f, 0.f, 0.f, 0.f, 0.f, 0.f, 0.f};
#pragma unroll
    for (int d0 = 0; d0 < 4; ++d0) { const bf16x8 kf = *(const LAS bf16x8*)(kb + (((2 * d0 + hi) ^ sw) << 4)); p = __builtin_amdgcn_mfma_f32_32x32x16_bf16(kf, qr[d0], p, 0, 0, 0); }
    return p;
}
typedef short v4i16_t __attribute__((ext_vector_type(4)));
__device__ __forceinline__ s16x4 vtr(const LAS unsigned char* p) { return __builtin_bit_cast(s16x4, __builtin_amdgcn_ds_read_tr16_b64_v4i16((LAS v4i16_t*)p)); }
__device__ __forceinline__ void pv32(f32x16 (&o)[2], const LAS unsigned char* vb, int half, bf16x8 pa0, bf16x8 pa1) {
#pragma unroll
    for (int d0 = 0; d0 < 2; ++d0) {
        const LAS unsigned char* p = vb + d0 * 512 + half * 4096;
        const s16x4 l0 = vtr(p), h0 = vtr(p + 1024), l1 = vtr(p + 2048), h1 = vtr(p + 3072);
        const bf16x8 v0 = {l0[0], l0[1], l0[2], l0[3], h0[0], h0[1], h0[2], h0[3]}, v1 = {l1[0], l1[1], l1[2], l1[3], h1[0], h1[1], h1[2], h1[3]};
        o[d0] = __builtin_amdgcn_mfma_f32_32x32x16_bf16(pa0, v0, o[d0], 0, 0, 0);
        o[d0] = __builtin_amdgcn_mfma_f32_32x32x16_bf16(pa1, v1, o[d0], 0, 0, 0);
    }
}
}

struct AttUnit { int br, Pc, d, nq, kcol, vcol, qcol0, token0, rot; };
__device__ __forceinline__ AttUnit att_decode(int ui) {
    AttUnit U;
    if (ui < 12) { const int a = blockIdx.x * 12 + ui, u = a & 31, h = (a >> 5) & 7, b = (a >> 8) & 3; U.br = a >> 10; U.d = (U.br == 0) ? 1 : (U.br == 1) ? 4 : 16;
        const int per = 32 / U.d, r = u / per; U.Pc = u % per; U.rot = (u & 1) ? 4 : 0; U.nq = 1; U.kcol = KA_OFF + 64 * h; U.vcol = VA_OFF + 64 * h; U.qcol0 = QA_OFF + 64 * h; U.token0 = b * S + r; }
    else { const int w = blockIdx.x, kvh = (w >> 5) & 1; U.Pc = w & 31; U.rot = 0; U.d = 1; U.br = 3; U.nq = 4; U.kcol = KB_OFF + 64 * kvh; U.vcol = VB_OFF + 64 * kvh; U.qcol0 = QB_OFF + 256 * kvh; U.token0 = (w >> 6) * S; }
    return U;
}
__device__ __forceinline__ void attn_mfma(const Ctx& C, const bf16* PROJ, bf16* OPART, float* LSE, const float* sinks) {
    using namespace att;
    const int lane = C.lane, r32 = lane & 31, hi = lane >> 5, wid = C.wave;
    LAS unsigned char* shm = C.lds;
    const unsigned lds0 = (unsigned)(uintptr_t)shm;
    LAS float* wsf = (LAS float*)(shm + LWS) + wid * 64;
    LAS bf16* stg = (LAS bf16*)(shm + LOST) + wid * 2048;
    const LAS unsigned char* vlane = shm + LV + ((lane >> 4) & 1) * 32 + (lane & 3) * 8 + (4 * hi + ((lane & 15) >> 2)) * 64;
#define ATT_ISSUE_K(U) do { const int m0k_ = 256 * (U).Pc - 128, kr_ = 8 * wid + (lane >> 3), kc_ = (lane & 7) ^ ((kr_ >> 1) & 7); _Pragma("unroll") for (int T = 0; T < 6; ++T) { if ((U).rot && T < 2) continue; int mk = m0k_ + 64 * T + kr_; mk = mk < 0 ? 0 : mk; const int sl_ = (T + (U).rot) % 6; \
        glds16(PROJ + (size_t)((U).token0 + (U).d * mk) * INW + (U).kcol + kc_ * 8, (unsigned)__builtin_amdgcn_readfirstlane(lds0 + LK + sl_ * 8192 + wid * 1024)); } } while (0)
#define ATT_ISSUE_V(U) do { const int m0k_ = 256 * (U).Pc - 128; _Pragma("unroll") for (int T = 0; T < 6; ++T) { if ((U).rot && T < 2) continue; int mv = m0k_ + 64 * T + 8 * wid + ((lane >> 2) & 7); mv = mv < 0 ? 0 : mv; const int sl_ = (T + (U).rot) % 6; \
        glds16(PROJ + (size_t)((U).token0 + (U).d * mv) * INW + (U).vcol + (lane >> 5) * 32 + (lane & 3) * 8, (unsigned)__builtin_amdgcn_readfirstlane(lds0 + LV + sl_ * 8192 + wid * 1024)); } } while (0)
#define ATT_LOAD_Q(U, hq, dst) do { const bf16* Qrow_ = PROJ + (size_t)((U).token0 + (U).d * (256 * (U).Pc + 32 * wid + r32)) * INW + (U).qcol0 + 64 * (hq); \
        _Pragma("unroll") for (int d0 = 0; d0 < 4; ++d0) dst[d0] = *(const GAS bf16x8*)(Qrow_ + d0 * 16 + hi * 8); } while (0)
    bf16x8 qr[4];
    { const AttUnit U0 = att_decode(0); ATT_ISSUE_K(U0); ATT_LOAD_Q(U0, 0, qr);
      asm volatile("s_waitcnt vmcnt(0)" ::: "memory"); __builtin_amdgcn_s_barrier(); asm volatile("" ::: "memory");
      ATT_ISSUE_V(U0); }
#pragma unroll 1
    for (int ui = 0; ui < 13; ++ui) {
        const AttUnit U = att_decode(ui);
        const int Pc = U.Pc, br = U.br, d = U.d, token0 = U.token0, qcol0 = U.qcol0;
#pragma unroll 1
        for (int hq = 0; hq < U.nq; ++hq) {
            if (hq > 0) ATT_LOAD_Q(U, hq, qr);
            const int qm = 256 * Pc + 32 * wid + r32;
            f32x16 sc[5];
#pragma unroll
            for (int kb = 0; kb < 5; ++kb) {
                const int j0 = 32 * wid + 32 * kb;
                if (Pc == 0 && j0 < 128) { sc[kb] = (f32x16){-INFINITY, -INFINITY, -INFINITY, -INFINITY, -INFINITY, -INFINITY, -INFINITY, -INFINITY, -INFINITY, -INFINITY, -INFINITY, -INFINITY, -INFINITY, -INFINITY, -INFINITY, -INFINITY}; }
                else sc[kb] = qk32(shm + LK + (((j0 >> 6) + U.rot) % 6) * 8192, (j0 >> 5) & 1, qr, r32, hi);
            }
            const int lowlim = r32 + (br == 3 ? 1 : 0);
#pragma unroll
            for (int rr = 0; rr < 16; ++rr) { const int c = crow(rr, hi); if (c < lowlim) sc[0][rr] = -INFINITY; if (c > r32) sc[4][rr] = -INFINITY; }
            float mx = -INFINITY;
#pragma unroll
            for (int kb = 0; kb < 5; ++kb)
#pragma unroll
                for (int rr = 0; rr < 16; ++rr) mx = fmaxf(mx, sc[kb][rr]);
            mx = xhalf_max(mx);
            float sk2 = 0.f;
            if (br == 3) { sk2 = sinks[(qcol0 - QB_OFF) / 64 + hq] * LOG2E; mx = fmaxf(mx, sk2); }
            float l = 0.f;
#pragma unroll
            for (int kb = 0; kb < 5; ++kb)
#pragma unroll
                for (int rr = 0; rr < 16; ++rr) { const float p = __builtin_amdgcn_exp2f(sc[kb][rr] - mx); sc[kb][rr] = p; l += p; }
            l = xhalf_sum(l);
            if (br == 3) l += __builtin_amdgcn_exp2f(sk2 - mx);
            if (hq == 0) {
                asm volatile("s_waitcnt vmcnt(0)" ::: "memory"); __builtin_amdgcn_s_barrier(); asm volatile("" ::: "memory");
                if (U.nq == 1 && ui + 1 < 13) { const AttUnit Un = att_decode(ui + 1); ATT_ISSUE_K(Un); ATT_LOAD_Q(Un, 0, qr); }
            }
            f32x16 o[2];
#pragma unroll
            for (int i = 0; i < 16; ++i) { o[0][i] = 0.f; o[1][i] = 0.f; }
#pragma unroll
            for (int kb = 0; kb < 5; ++kb) {
                const int j0 = 32 * wid + 32 * kb;
                if (!(Pc == 0 && j0 < 128)) {
                    u32x4 w0, w1;
                    w0.x = cvtpk(sc[kb][0], sc[kb][1]); w0.y = cvtpk(sc[kb][2], sc[kb][3]); w0.z = cvtpk(sc[kb][4], sc[kb][5]); w0.w = cvtpk(sc[kb][6], sc[kb][7]);
                    w1.x = cvtpk(sc[kb][8], sc[kb][9]); w1.y = cvtpk(sc[kb][10], sc[kb][11]); w1.z = cvtpk(sc[kb][12], sc[kb][13]); w1.w = cvtpk(sc[kb][14], sc[kb][15]);
                    pv32(o, vlane + (((j0 >> 6) + U.rot) % 6) * 8192, (j0 >> 5) & 1, __builtin_bit_cast(bf16x8, w0), __builtin_bit_cast(bf16x8, w1));
                }
            }
            if (hi == 0) wsf[r32] = l;
            asm volatile("s_waitcnt lgkmcnt(0)" ::: "memory");
#pragma unroll
            for (int rr = 0; rr < 16; ++rr) { const int orow = crow(rr, hi); const float rl = __builtin_amdgcn_rcpf(wsf[orow]);
                stg[orow * 64 + r32] = (bf16)f2bf(o[0][rr] * rl); stg[orow * 64 + 32 + r32] = (bf16)f2bf(o[1][rr] * rl); }
            asm volatile("s_waitcnt lgkmcnt(0)" ::: "memory");
            const int hcol = (br == 3) ? (qcol0 - QB_OFF) + 64 * hq : (qcol0 - QA_OFF);
            bf16* Ob = OPART + ((size_t)br * M) * 512 + hcol;
            if (br < 3 && hi == 0) LSE[((size_t)br * M + (token0 + d * qm)) * 8 + (qcol0 - QA_OFF) / 64] = mx + __builtin_amdgcn_logf(l);
#pragma unroll
            for (int i = 0; i < 4; ++i) { const int row = i * 8 + (lane >> 3), ch = lane & 7; const v4u v = *(const LAS v4u*)(stg + row * 64 + ch * 8);
                const int tok = token0 + d * (256 * Pc + 32 * wid + row);
                *(GAS v4u*)(Ob + (size_t)tok * 512 + ch * 8) = v; }
            asm volatile("s_waitcnt lgkmcnt(0)" ::: "memory");
        }
        if (ui + 1 < 13) {
            asm volatile("s_waitcnt vmcnt(4)" : "+v"(qr[0]), "+v"(qr[1]), "+v"(qr[2]), "+v"(qr[3]) :: "memory"); __builtin_amdgcn_s_barrier(); asm volatile("" ::: "memory");
            const AttUnit Un = att_decode(ui + 1); ATT_ISSUE_V(Un);
        }
    }
    asm volatile("s_waitcnt vmcnt(0) lgkmcnt(0)" ::: "memory"); __builtin_amdgcn_s_barrier(); asm volatile("" ::: "memory");
#undef ATT_ISSUE_K
#undef ATT_ISSUE_V
#undef ATT_LOAD_Q
}

__device__ __forceinline__ void ld8bf(const bf16* p, float (&v)[8]) {
    const v4u a = *(const GAS v4u*)p;
    v[0] = bflo(a.x); v[1] = bfhi(a.x); v[2] = bflo(a.y); v[3] = bfhi(a.y); v[4] = bflo(a.z); v[5] = bfhi(a.z); v[6] = bflo(a.w); v[7] = bfhi(a.w);
}
__device__ __forceinline__ void unpack8(const v4u a, float (&v)[8]) {
    v[0] = bflo(a.x); v[1] = bfhi(a.x); v[2] = bflo(a.y); v[3] = bfhi(a.y); v[4] = bflo(a.z); v[5] = bfhi(a.z); v[6] = bflo(a.w); v[7] = bfhi(a.w);
}
constexpr int UNR = 4;
__device__ __forceinline__ void combine_phase(const Ctx& C, const bf16* OPART, const float* LSE, const float* gna, const float* gnb, bf16* MIX) {
    const int h = C.lane >> 3;
    float ga[8], gb[8];
#pragma unroll
    for (int i = 0; i < 8; ++i) { ga[i] = gna[8 * C.lane + i]; gb[i] = gnb[8 * C.lane + i]; }
    for (int row0 = C.gw; row0 < M; row0 += UNR * C.ngw) {
        v4u q0[UNR], q1[UNR], q2[UNR], q3[UNR]; float l0[UNR], l1[UNR], l2[UNR];
#pragma unroll
        for (int k = 0; k < UNR; ++k) { const int row = row0 + k * C.ngw;
            l0[k] = LSE[((size_t)0 * M + row) * 8 + h]; l1[k] = LSE[((size_t)1 * M + row) * 8 + h]; l2[k] = LSE[((size_t)2 * M + row) * 8 + h];
            q0[k] = *(const GAS v4u*)(OPART + ((size_t)0 * M + row) * 512 + 8 * C.lane); q1[k] = *(const GAS v4u*)(OPART + ((size_t)1 * M + row) * 512 + 8 * C.lane);
            q2[k] = *(const GAS v4u*)(OPART + ((size_t)2 * M + row) * 512 + 8 * C.lane); q3[k] = *(const GAS v4u*)(OPART + ((size_t)3 * M + row) * 512 + 8 * C.lane); }
#pragma unroll
        for (int k = 0; k < UNR; ++k) { const int row = row0 + k * C.ngw;
            const float mx = fmaxf(l0[k], fmaxf(l1[k], l2[k]));
            float w0 = __builtin_amdgcn_exp2f(l0[k] - mx), w1 = __builtin_amdgcn_exp2f(l1[k] - mx), w2 = __builtin_amdgcn_exp2f(l2[k] - mx);
            const float inv = 1.0f / (w0 + w1 + w2); w0 *= inv; w1 *= inv; w2 *= inv;
            float a0[8], a1[8], a2[8], b[8]; unpack8(q0[k], a0); unpack8(q1[k], a1); unpack8(q2[k], a2); unpack8(q3[k], b);
            float sa = 0.f, sb = 0.f;
#pragma unroll
            for (int i = 0; i < 8; ++i) { a0[i] = w0 * a0[i] + w1 * a1[i] + w2 * a2[i]; sa += a0[i] * a0[i]; sb += b[i] * b[i]; }
            sa = wave_sum(sa); sb = wave_sum(sb);
            const float ra = __builtin_amdgcn_rsqf(sa * (1.0f / 512.0f) + EPS), rb = __builtin_amdgcn_rsqf(sb * (1.0f / 512.0f) + EPS);
            v4u oa, ob;
            oa.x = pk2(a0[0] * ra * ga[0], a0[1] * ra * ga[1]); oa.y = pk2(a0[2] * ra * ga[2], a0[3] * ra * ga[3]); oa.z = pk2(a0[4] * ra * ga[4], a0[5] * ra * ga[5]); oa.w = pk2(a0[6] * ra * ga[6], a0[7] * ra * ga[7]);
            ob.x = pk2(b[0] * rb * gb[0], b[1] * rb * gb[1]); ob.y = pk2(b[2] * rb * gb[2], b[3] * rb * gb[3]); ob.z = pk2(b[4] * rb * gb[4], b[5] * rb * gb[5]); ob.w = pk2(b[6] * rb * gb[6], b[7] * rb * gb[7]);
            *(GAS v4u*)(MIX + (size_t)row * D + 8 * C.lane) = oa; *(GAS v4u*)(MIX + (size_t)row * D + 512 + 8 * C.lane) = ob; }
    }
}

__device__ __forceinline__ void row_load(const float* p, int lane, f32x4 (&v)[4]) {
#pragma unroll
    for (int j = 0; j < 4; ++j) v[j] = *(const GAS f32x4*)(p + 4 * lane + 256 * j);
}
__device__ __forceinline__ float row_ssq(const f32x4 (&v)[4]) {
    float s = 0.f;
#pragma unroll
    for (int j = 0; j < 4; ++j) s += (v[j][0] * v[j][0] + v[j][1] * v[j][1]) + (v[j][2] * v[j][2] + v[j][3] * v[j][3]);
    return wave_sum(s);
}
__device__ __forceinline__ void row_store_bf16(bf16* p, int lane, const f32x4 (&v)[4]) {
#pragma unroll
    for (int j = 0; j < 4; ++j) { u32x2v w; w.x = pk2(v[j][0], v[j][1]); w.y = pk2(v[j][2], v[j][3]); *(GAS u32x2v*)(p + 4 * lane + 256 * j) = w; }
}
__device__ __forceinline__ void row_load_bf16(const bf16* p, int lane, f32x4 (&v)[4]) {
#pragma unroll
    for (int j = 0; j < 4; ++j) { const u32x2v a = *(const GAS u32x2v*)(p + 4 * lane + 256 * j); v[j][0] = bflo(a.x); v[j][1] = bfhi(a.x); v[j][2] = bflo(a.y); v[j][3] = bfhi(a.y); }
}
__device__ __forceinline__ void xn_rows(const Ctx& C, const float* x, bf16* XN, float* ssq) {
    for (int row0 = C.gw; row0 < M; row0 += UNR * C.ngw) {
        f32x4 v[UNR][4];
#pragma unroll
        for (int k = 0; k < UNR; ++k) row_load(x + (size_t)(row0 + k * C.ngw) * D, C.lane, v[k]);
#pragma unroll
        for (int k = 0; k < UNR; ++k) { const int row = row0 + k * C.ngw;
            const float s = row_ssq(v[k]);
            row_store_bf16(XN + (size_t)row * D, C.lane, v[k]);
            if (C.lane < 16) ssq[(size_t)row * 16 + C.lane] = (C.lane == 0) ? s : 0.f; }
    }
}

struct Route { int e0, e1; float g0, g1, rs; int p0, p1, pad; };
__device__ __forceinline__ void router_phase(const Ctx& C, const bf16* x1, const float* router, const float* gain, Route* RT, int* blkcnt) {
    LAS float* GRt = (LAS float*)(C.lds + RING_OFF);
    LAS unsigned* tokE = (LAS unsigned*)(C.lds + RING_OFF + 32768);
    for (int i = C.tid; i < 1024 * 8; i += 512) { const int c = i >> 3, e = i & 7; GRt[e * 1024 + c] = router[i] * gain[c]; }
    __syncthreads();
    const int tok0 = blockIdx.x * 128 + C.wave * 16;
#pragma unroll 1
    for (int tt = 0; tt < 16; tt += UNR) {
        f32x4 v[UNR][4];
#pragma unroll
        for (int k = 0; k < UNR; ++k) row_load_bf16(x1 + (size_t)(tok0 + tt + k) * D, C.lane, v[k]);
        float ss[UNR], lg[UNR][8];
#pragma unroll
        for (int k = 0; k < UNR; ++k) { ss[k] = 0.f;
#pragma unroll
            for (int e = 0; e < 8; ++e) lg[k][e] = 0.f; }
#pragma unroll
        for (int j = 0; j < 4; ++j) {
#pragma unroll
            for (int k = 0; k < UNR; ++k) ss[k] += (v[k][j][0] * v[k][j][0] + v[k][j][1] * v[k][j][1]) + (v[k][j][2] * v[k][j][2] + v[k][j][3] * v[k][j][3]);
#pragma unroll
            for (int e = 0; e < 8; ++e) { const f32x4 r = *(const LAS f32x4*)(GRt + e * 1024 + 4 * C.lane + 256 * j);
#pragma unroll
                for (int k = 0; k < UNR; ++k) lg[k][e] += (v[k][j][0] * r[0] + v[k][j][1] * r[1]) + (v[k][j][2] * r[2] + v[k][j][3] * r[3]); } }
#pragma unroll
        for (int k = 0; k < UNR; ++k) {
            const int tok = tok0 + tt + k;
            const float sk = wave_sum(ss[k]);
            const float rs = __builtin_amdgcn_rsqf(sk * (1.0f / D) + EPS);
            float l8[8];
#pragma unroll
            for (int e = 0; e < 8; ++e) l8[e] = wave_sum(lg[k][e]) * rs;
            int e0 = 0; float v0 = l8[0];
#pragma unroll
            for (int e = 1; e < 8; ++e) if (l8[e] > v0) { v0 = l8[e]; e0 = e; }
            int e1 = -1; float v1 = -INFINITY;
#pragma unroll
            for (int e = 0; e < 8; ++e) if (e != e0 && l8[e] > v1) { v1 = l8[e]; e1 = e; }
            const float ex = __expf(v1 - v0), g0 = 1.0f / (1.0f + ex), g1 = ex * g0;
            if (C.lane == 0) { Route r; r.e0 = e0; r.e1 = e1; r.g0 = g0; r.g1 = g1; r.rs = rs; r.p0 = 0; r.p1 = 0; r.pad = 0; RT[tok] = r; tokE[C.wave * 16 + tt + k] = (unsigned)e0 | ((unsigned)e1 << 8); }
        }
    }
    __syncthreads();
    if (C.tid < 8) { int cnt = 0; for (int t = 0; t < 128; ++t) { const unsigned w = tokE[t]; cnt += ((w & 255u) == (unsigned)C.tid) + ((w >> 8) == (unsigned)C.tid); } blkcnt[blockIdx.x * 8 + C.tid] = cnt; }
    __syncthreads();
}
__device__ __forceinline__ void scatter_phase(const Ctx& C, const bf16* x1, const float* gain, Route* RT, const int* blkcnt, bf16* AP, float* rowgate, volatile LAS int* SEGB) {
    LAS int* LTOT = (LAS int*)(C.lds + RING_OFF);
    LAS int* LPRE = LTOT + 8;
    LAS unsigned* tokE = (LAS unsigned*)(LTOT + 16);
    LAS int* POS = (LAS int*)(LTOT + 16 + 128);
    { const int e = C.wave; int st = 0, sp = 0;
#pragma unroll
      for (int j = 0; j < 4; ++j) { const int b = C.lane + 64 * j; const int c = blkcnt[b * 8 + e]; st += c; if (b < (int)blockIdx.x) sp += c; }
      st = wave_sum_i(st); sp = wave_sum_i(sp);
      if (C.lane == 0) { LTOT[e] = st; LPRE[e] = sp; } }
    if (C.tid < 128) { const Route r = RT[blockIdx.x * 128 + C.tid]; tokE[C.tid] = (unsigned)r.e0 | ((unsigned)r.e1 << 8); }
    __syncthreads();
    if (C.tid == 0) { int base = 0; for (int e = 0; e < 8; ++e) { SEGB[e] = base; base += (LTOT[e] + 255) & ~255; } SEGB[8] = base; }
    __syncthreads();
    if (C.tid < 8) { const int e = C.tid; int run = SEGB[e] + LPRE[e];
        for (int t = 0; t < 128; ++t) { const unsigned w = tokE[t]; if ((int)(w & 255u) == e) POS[2 * t] = run++; if ((int)(w >> 8) == e) POS[2 * t + 1] = run++; } }
    __syncthreads();
    float gn[4][4];
#pragma unroll
    for (int j = 0; j < 4; ++j) { const f32x4 g = *(const GAS f32x4*)(gain + 4 * C.lane + 256 * j); gn[j][0] = g[0]; gn[j][1] = g[1]; gn[j][2] = g[2]; gn[j][3] = g[3]; }
#pragma unroll 1
    for (int tt = 0; tt < 16; tt += UNR) {
        f32x4 v[UNR][4]; Route r[UNR];
#pragma unroll
        for (int k = 0; k < UNR; ++k) { const int tok = blockIdx.x * 128 + C.wave * 16 + tt + k; r[k] = RT[tok]; row_load_bf16(x1 + (size_t)tok * D, C.lane, v[k]); }
#pragma unroll
        for (int k = 0; k < UNR; ++k) { const int tl = C.wave * 16 + tt + k, tok = blockIdx.x * 128 + tl;
            const int p0 = POS[2 * tl], p1 = POS[2 * tl + 1];
            if (C.lane == 0) { RT[tok].p0 = p0; RT[tok].p1 = p1; rowgate[p0] = r[k].g0; rowgate[p1] = r[k].g1; }
#pragma unroll
            for (int j = 0; j < 4; ++j) { v[k][j][0] *= r[k].rs * gn[j][0]; v[k][j][1] *= r[k].rs * gn[j][1]; v[k][j][2] *= r[k].rs * gn[j][2]; v[k][j][3] *= r[k].rs * gn[j][3]; }
            row_store_bf16(AP + (size_t)p0 * D, C.lane, v[k]); row_store_bf16(AP + (size_t)p1 * D, C.lane, v[k]); }
    }
    if (blockIdx.x < 8) { const int e = blockIdx.x; const int lo = SEGB[e] + LTOT[e], hi = SEGB[e + 1];
        for (int rr = lo + C.wave; rr < hi; rr += NWAVES) {
#pragma unroll
            for (int j = 0; j < 4; ++j) { u32x2v z; z.x = 0u; z.y = 0u; *(GAS u32x2v*)(AP + (size_t)rr * D + 4 * C.lane + 256 * j) = z; }
            if (C.lane == 0) rowgate[rr] = 0.f; } }
    __syncthreads();
}
__device__ __forceinline__ void moe_tail_row(const bf16* PTp, int p, float gate, int lane, u32x2v (&y)[4]) {
    f32x4 t[4];
#pragma unroll
    for (int j = 0; j < 4; ++j) t[j] = (f32x4){0.f, 0.f, 0.f, 0.f};
#pragma unroll 1
    for (int s = 0; s < KSPLIT; ++s) {
#pragma unroll
        for (int j = 0; j < 4; ++j) { const u32x2v a = *(const GAS u32x2v*)(PTp + ((size_t)s * TAILROWS + (p - MAINROWS)) * D + 4 * lane + 256 * j);
            t[j][0] += bflo(a.x); t[j][1] += bfhi(a.x); t[j][2] += bflo(a.y); t[j][3] += bfhi(a.y); } }
#pragma unroll
    for (int j = 0; j < 4; ++j) { y[j].x = pk2(t[j][0] * gate, t[j][1] * gate); y[j].y = pk2(t[j][2] * gate, t[j][3] * gate); }
}
__device__ __forceinline__ void moe_combine(const Ctx& C, float* xout, const Route* RT, const bf16* Y, const bf16* PTp, bf16* XN, float* ssq, const float* final_gain) {
    for (int row0 = C.gw; row0 < M; row0 += UNR * C.ngw) {
        int p0[UNR], p1[UNR]; float g0[UNR], g1[UNR];
#pragma unroll
        for (int k = 0; k < UNR; ++k) { const Route rt = RT[row0 + k * C.ngw]; p0[k] = rt.p0; p1[k] = rt.p1; g0[k] = rt.g0; g1[k] = rt.g1; }
        u32x2v xr[UNR][4], ya[UNR][4], yb[UNR][4];
#pragma unroll
        for (int k = 0; k < UNR; ++k)
#pragma unroll
            for (int j = 0; j < 4; ++j) { xr[k][j] = *(const GAS u32x2v*)(XN + (size_t)(row0 + k * C.ngw) * D + 4 * C.lane + 256 * j);
                ya[k][j] = *(const GAS u32x2v*)(Y + (size_t)p0[k] * D + 4 * C.lane + 256 * j); yb[k][j] = *(const GAS u32x2v*)(Y + (size_t)p1[k] * D + 4 * C.lane + 256 * j); }
#pragma unroll
        for (int k = 0; k < UNR; ++k) { const int row = row0 + k * C.ngw;
            if (p0[k] >= MAINROWS) moe_tail_row(PTp, p0[k], g0[k], C.lane, ya[k]);
            if (p1[k] >= MAINROWS) moe_tail_row(PTp, p1[k], g1[k], C.lane, yb[k]);
            f32x4 v[4];
#pragma unroll
            for (int j = 0; j < 4; ++j) { v[j][0] = bflo(xr[k][j].x) + bflo(ya[k][j].x) + bflo(yb[k][j].x); v[j][1] = bfhi(xr[k][j].x) + bfhi(ya[k][j].x) + bfhi(yb[k][j].x);
                v[j][2] = bflo(xr[k][j].y) + bflo(ya[k][j].y) + bflo(yb[k][j].y); v[j][3] = bfhi(xr[k][j].y) + bfhi(ya[k][j].y) + bfhi(yb[k][j].y); }
            const float s = row_ssq(v);
            if (final_gain) {
                const float rs = __builtin_amdgcn_rsqf(s * (1.0f / D) + EPS);
#pragma unroll
                for (int j = 0; j < 4; ++j) { const f32x4 g = *(const GAS f32x4*)(final_gain + 4 * C.lane + 256 * j); *(GAS f32x4*)(xout + (size_t)row * D + 4 * C.lane + 256 * j) = v[j] * rs * g; }
            } else {
                row_store_bf16(XN + (size_t)row * D, C.lane, v);
                if (C.lane < 16) ssq[(size_t)row * 16 + C.lane] = (C.lane == 0) ? s : 0.f;
            } }
    }
}

struct Args { const void* in[17]; float* out; unsigned char* ws; };
__global__ void __launch_bounds__(NWAVES * 64, 2) trunk_fwd(Args args) {
    extern __shared__ __attribute__((aligned(16))) unsigned char lds[];
    const int G = gridDim.x;
    const int wave_s = __builtin_amdgcn_readfirstlane(threadIdx.x >> 6);
#define TIDX() ({ unsigned z_ = 0u; asm volatile("" : "+v"(z_)); wave_s * 64 + (int)__builtin_amdgcn_mbcnt_hi(~0u, __builtin_amdgcn_mbcnt_lo(~0u, z_)); })
#define MKCTX() Ctx C; { int t_ = TIDX(); C.lds = (LAS unsigned char*)lds; C.tid = t_; C.lane = t_ & 63; C.wave = __builtin_amdgcn_readfirstlane(t_ >> 6); C.gw = blockIdx.x * NWAVES + C.wave; C.ngw = G * NWAVES; } \
    GAS unsigned char* wsl = (GAS unsigned char*)ws; int bid = blockIdx.x; asm volatile("" : "+s"(wsl), "+s"(bid));
    LAS unsigned char* const ldsb = (LAS unsigned char*)lds;
    volatile LAS unsigned* MISC = (volatile LAS unsigned*)(ldsb + MISC_OFF);
    volatile LAS int* SEGB = (volatile LAS int*)(ldsb + MISC_OFF + 64);
    unsigned char* ws = args.ws;
    gu32* ctl = (gu32*)(ws + WS_CTL);
    for (int u = threadIdx.x; u < (LDS_BYTES - LDSCTL_OFF) / 4; u += NWAVES * 64) ((LAS unsigned*)(ldsb + LDSCTL_OFF))[u] = 0u;
    __syncthreads();
    XcdBarrier bar = xcd_barrier_post((unsigned*)(ctl + CW_BAR), MISC + 8, (int)threadIdx.x);
#define GRID_BAR_RAW() do { XcdBarrier b_ = bar; GAS unsigned* p_ = (GAS unsigned*)bar.bar; asm volatile("" : "+s"(b_.x), "+s"(p_)); b_.bar = (unsigned*)p_; xcd_barrier(b_, TIDX()); } while (0)
#if PROBE_T
#define TBEG(id) do { if ((id) == PROBE_T && blockIdx.x == 0 && TIDX() == 0) MISC[33] = (unsigned)__builtin_amdgcn_s_memrealtime(); } while (0)
#define TEND(id) do { if ((id) == PROBE_T && blockIdx.x == 0 && TIDX() == 0) MISC[32] = MISC[32] + ((unsigned)__builtin_amdgcn_s_memrealtime() - MISC[33]); } while (0)
#else
#define TBEG(id) do {} while (0)
#define TEND(id) do {} while (0)
#endif
#define GRID_BAR() do { TBEG(1); GRID_BAR_RAW(); TEND(1); } while (0)

    const float* x_in = (const float*)args.in[0]; const int* positions = (const int*)args.in[1];
    const float* attn_norm = (const float*)args.in[2]; const float* w_in = (const float*)args.in[3];
    const float* mix_norm_a = (const float*)args.in[4]; const float* mix_norm_b = (const float*)args.in[5];
    const float* sinks = (const float*)args.in[6]; const float* w_out = (const float*)args.in[7];
    const float* ffn_norm = (const float*)args.in[8]; const float* dwg = (const float*)args.in[9];
    const float* dwu = (const float*)args.in[10]; const float* dwd = (const float*)args.in[11];
    const float* router = (const float*)args.in[12]; const float* mwg = (const float*)args.in[13];
    const float* mwu = (const float*)args.in[14]; const float* mwd = (const float*)args.in[15];
    const float* final_norm = (const float*)args.in[16];
    float* xout = args.out;
#define ROPE ((float*)(GAS float*)(wsl + WS_ROPE))
#define SSQA ((float*)(GAS float*)(wsl + WS_SSQA))
#define SSQF ((float*)(GAS float*)(wsl + WS_SSQF))
#define RT ((Route*)(GAS Route*)(wsl + WS_ROUTE))
#define BLKCNT ((int*)(GAS int*)(wsl + WS_BLKCNT))
#define ROWGATE ((float*)(GAS float*)(wsl + WS_ROWGATE))
#define WIN ((bf16*)(GAS bf16*)(wsl + WS_WIN))
#define WOUT ((bf16*)(GAS bf16*)(wsl + WS_WOUT))
#define WGU ((bf16*)(GAS bf16*)(wsl + WS_WGU))
#define WDN ((bf16*)(GAS bf16*)(wsl + WS_WDN))
#define MGU ((bf16*)(GAS bf16*)(wsl + WS_MGU))
#define MDN ((bf16*)(GAS bf16*)(wsl + WS_MDN))
#define XN ((bf16*)(GAS bf16*)(wsl + WS_XN))
#define PROJ ((bf16*)(GAS bf16*)(wsl + WS_PROJ))
#define OPART ((bf16*)(GAS bf16*)(wsl + WS_OPART))
#define LSE ((float*)(GAS float*)(wsl + WS_LSE))
#define MIX ((bf16*)(GAS bf16*)(wsl + WS_MIX))
#define HB ((bf16*)(GAS bf16*)(wsl + WS_H))
#define AP ((bf16*)(GAS bf16*)(wsl + WS_AP))
#define PT ((bf16*)(GAS bf16*)(wsl + WS_PT))

    TBEG(2);
    { MKCTX();
    { ConvSrc S{w_in, w_out, attn_norm, ffn_norm, dwg, dwu, dwd, WIN, WOUT, WGU, WDN}; convert_prologue(C, S); }
    convert_moe_layer(C, mwg, mwu, mwd, MGU, MDN);
    for (int i = blockIdx.x * 512 + C.tid; i < S * 32; i += G * 512) {
        const int s = i >> 5, f = i & 31;
        const float inv = __builtin_amdgcn_exp2f(-(float)f * (13.287712379549449f / 32.0f));
        const float ang = (float)positions[s] * inv;
        const double rev = (double)ang * 0.15915494309189535; const float fr = (float)(rev - __builtin_rint(rev));
        ROPE[i] = __builtin_amdgcn_cosf(fr); ROPE[S * 32 + i] = __builtin_amdgcn_sinf(fr);
    }
    xn_rows(C, x_in, XN, SSQA); }
    TEND(2);
    GRID_BAR();

#pragma unroll 1
    for (int l = 0; l < DEPTH; ++l) {
        TBEG(3);
        { MKCTX(); pg8::Gemm g{XN, WIN + (size_t)l * INW * D, M, INW, D, 0, D}; pg8::StaticOrder So; So.init(M, INW, G, bid);
          pg8::EpiRope E{PROJ, SSQA, ROPE};
          pg8::gemm_phase<pg8::EpiRope, pg8::StaticOrder, true, true>(C.lds + RING_OFF, g, So, E, C.tid);
        }
        TEND(3);
        GRID_BAR();
        TBEG(4);
        { MKCTX(); attn_mfma(C, PROJ, OPART, LSE, sinks + l * 8); }
        TEND(4);
        GRID_BAR();
        TBEG(5);
        { MKCTX(); combine_phase(C, OPART, LSE, mix_norm_a + l * 512, mix_norm_b + l * 512, MIX); }
        TEND(5);
        GRID_BAR();
        TBEG(6);
        { MKCTX(); pg8::Gemm g{MIX, WOUT + (size_t)l * D * D, M, D, D, 0, D}; pg8::StaticOrder So; So.init(M, D, G, bid);
          pg8::EpiResid E{XN, SSQF};
          pg8::gemm_phase<pg8::EpiResid, pg8::StaticOrder, true, true>(C.lds + RING_OFF, g, So, E, C.tid); }
        TEND(6);
        GRID_BAR();
        if ((l & 1) == 0) {
            const int j = l >> 1;
            TBEG(7);
            { MKCTX(); pg8::Gemm g{XN, WGU + (size_t)j * 2 * FF * D, M, 2 * FF, D, 0, D}; pg8::StaticOrder So; So.init(M, 2 * FF, G, bid);
              pg8::EpiSwiglu<true> E{HB, SSQF};
              pg8::gemm_phase<pg8::EpiSwiglu<true>, pg8::StaticOrder, true, true>(C.lds + RING_OFF, g, So, E, C.tid);
            }
            TEND(7);
            GRID_BAR();
            TBEG(8);
            { MKCTX(); pg8::Gemm g{HB, WDN + (size_t)j * D * FF, M, D, FF, 0, FF}; pg8::StaticOrder So; So.init(M, D, G, bid);
              pg8::EpiResid E{XN, SSQA};
              pg8::gemm_phase<pg8::EpiResid, pg8::StaticOrder, true, true>(C.lds + RING_OFF, g, So, E, C.tid); }
            TEND(8);
            GRID_BAR();
        } else {
            const int j = l >> 1;
            TBEG(9);
            { MKCTX(); router_phase(C, XN, router + (size_t)j * D * NE, ffn_norm + l * D, RT, BLKCNT); }
            TEND(9);
            GRID_BAR();
            TBEG(10);
            { MKCTX(); scatter_phase(C, XN, ffn_norm + l * D, RT, BLKCNT, AP, ROWGATE, SEGB); }
            TEND(10);
            GRID_BAR();
            const int nrows = SEGB[8];
            TBEG(11);
            { MKCTX(); pg8::Gemm g{AP, MGU, nrows, 2 * FF, D, (size_t)2 * FF * D * 2, D}; pg8::GroupedOrder So; So.init(nrows, 2 * FF, G, bid); So.segb = (const LAS int*)(C.lds + MISC_OFF + 64);
              pg8::EpiSwiglu<false> E{HB, nullptr};
              pg8::gemm_phase<pg8::EpiSwiglu<false>, pg8::GroupedOrder, true, true>(C.lds + RING_OFF, g, So, E, C.tid);
            }
            TEND(11);
            GRID_BAR();
            TBEG(12);
            { MKCTX(); const int nmain = nrows < MAINROWS ? nrows : MAINROWS;
              pg8::Gemm g{HB, MDN, nmain, D, FF, (size_t)D * FF * 2, FF}; pg8::GroupedOrder So; So.init(nmain, D, G, bid); So.segb = (const LAS int*)(C.lds + MISC_OFF + 64);
              pg8::EpiY E{AP, ROWGATE};
              pg8::gemm_phase<pg8::EpiY, pg8::GroupedOrder, true, true>(C.lds + RING_OFF, g, So, E, C.tid);
              pg8::Gemm gt{HB, MDN, nrows, D, FF / KSPLIT, (size_t)D * FF * 2, FF}; pg8::TailOrder St; St.npair = (nrows - nmain) / 256 * 4; St.G = G; St.c = bid; St.segb = (const LAS int*)(C.lds + MISC_OFF + 64);
              pg8::EpiPart Ep{PT};
              pg8::gemm_phase<pg8::EpiPart, pg8::TailOrder, true, true>(C.lds + RING_OFF, gt, St, Ep, C.tid);
            }
            TEND(12);
            GRID_BAR();
            TBEG(13);
            { MKCTX(); moe_combine(C, xout, RT, AP, PT, XN, SSQA, l == DEPTH - 1 ? final_norm : nullptr);
            if (l == 1) convert_moe_layer(C, mwg + (size_t)NE * D * FF, mwu + (size_t)NE * D * FF, mwd + (size_t)NE * FF * D, MGU, MDN); }
            TEND(13);
            if (l != DEPTH - 1) GRID_BAR();
        }
    }
#if PROBE_T == 200
    for (int i_ = 0; i_ < 20; ++i_) GRID_BAR_RAW();
#endif
#if PROBE_T
    if (blockIdx.x == 0 && TIDX() == 0) { const unsigned long long t0 = __builtin_amdgcn_s_memrealtime(); const unsigned long long dt = MISC[32];
        while (__builtin_amdgcn_s_memrealtime() - t0 < dt) __builtin_amdgcn_s_sleep(8); }
#endif
}

extern "C" void kernel_launch(void* const* d_in, const int* in_sizes, int n_in, void* d_out, int out_size, void* d_ws, size_t ws_size, hipStream_t stream) {
    static int grid = 0;
    if (grid == 0) {
        if (n_in != 17 || in_sizes[0] != M * D || out_size != M * D || ws_size < WS_END) {
            fprintf(stderr, "kernel_launch: unexpected shapes / workspace (n_in %d, in0 %d, out %d, ws %zu, need %zu); nothing launched\n", n_in, n_in > 0 ? in_sizes[0] : -1, out_size, ws_size, (size_t)WS_END); grid = -1; return; }
        int dev = 0, cus = 0, per_cu = 0;
        if (hipGetDevice(&dev) != hipSuccess || hipDeviceGetAttribute(&cus, hipDeviceAttributeMultiprocessorCount, dev) != hipSuccess) { grid = -1; return; }
        if (hipFuncSetAttribute((const void*)trunk_fwd, hipFuncAttributeMaxDynamicSharedMemorySize, LDS_BYTES) != hipSuccess) { fprintf(stderr, "kernel_launch: hipFuncSetAttribute failed\n"); grid = -1; return; }
        if (hipOccupancyMaxActiveBlocksPerMultiprocessor(&per_cu, (const void*)trunk_fwd, NWAVES * 64, LDS_BYTES) != hipSuccess || per_cu < 1) { fprintf(stderr, "kernel_launch: occupancy query reports %d blocks per CU\n", per_cu); }
        (void)hipGetLastError();
        grid = cus;
        if (grid != 256) { fprintf(stderr, "kernel_launch: built for 256 CUs, device has %d; nothing launched\n", cus); grid = -1; return; }
    }
    if (grid < 0) return;
    if (hipMemsetAsync((char*)d_ws + WS_CTL, 0, CTL_ZERO_BYTES, stream) != hipSuccess) return;
    Args a{};
    for (int i = 0; i < 17; ++i) a.in[i] = d_in[i];
    a.out = (float*)d_out; a.ws = (unsigned char*)d_ws;
    hipLaunchKernelGGL(trunk_fwd, dim3(grid), dim3(NWAVES * 64), LDS_BYTES, stream, a);
}
```

```cpp
#include <hip/hip_runtime.h>
#include <cstdio>
#include <cstdint>

#ifndef PROBE_T
#define PROBE_T 0
#endif
namespace cfg {
constexpr int D = 1024, NB = 4, S = 8192, M = NB * S, DEPTH = 4, HD = 64, INW = 2304, FF = 3584, NE = 8;
constexpr int QA_OFF = 0, KA_OFF = 512, VA_OFF = 1024, QB_OFF = 1536, KB_OFF = 2048, VB_OFF = 2176;
constexpr float EPS = 1e-5f;
constexpr float LOG2E = 1.4426950408889634f;
constexpr float C2 = 0.125f * LOG2E;
constexpr int MAXROWS = 2 * M + NE * 256;
constexpr int MAINROWS = 2 * M;
constexpr int TAILROWS = 7 * 256, KSPLIT = 7;
}

template <int K> __device__ __forceinline__ float swz_xor(float v) { return __builtin_bit_cast(float, __builtin_amdgcn_ds_swizzle(__builtin_bit_cast(int, v), (K << 10) | 0x1f)); }
__device__ __forceinline__ void pl32_swap(float& a, float& b) { asm volatile("s_nop 1\n\tv_permlane32_swap_b32 %0, %1" : "+v"(a), "+v"(b)); }
__device__ __forceinline__ float xor32_sum(float v) { float a = v, b = v; pl32_swap(a, b); return a + b; }
__device__ __forceinline__ float xor32_max(float v) { float a = v, b = v; pl32_swap(a, b); return fmaxf(a, b); }
__device__ __forceinline__ float fq_sum(float s) { s += swz_xor<16>(s); return xor32_sum(s); }
namespace pg8 {
#define PG8_LAS __attribute__((address_space(3)))
typedef unsigned short bf16_t;
typedef short bf16x8 __attribute__((ext_vector_type(8)));
typedef float f32x4 __attribute__((ext_vector_type(4)));
typedef unsigned u32x4 __attribute__((ext_vector_type(4)));
constexpr int BM = 256, BK = 64, HALF = 128, HTB = HALF * BK * 2  , STAGE_BYTES = 8 * HTB, NXCD = 8, WGM = 8;

__host__ __device__ __forceinline__ int lds_byte(int r, int c) { const int st = (r >> 4) * 2 + (c >> 5), rr = r & 15, cc = c & 31, ob = rr * 64 + cc * 2; return st * 1024 + (ob ^ (((ob >> 9) & 1) << 5)); }
__host__ __device__ __forceinline__ void stage_rc(int b, int& R, int& C) { const int st = b / 1024, sb = b % 1024, swz = sb ^ (((sb >> 9) & 1) << 5); R = (st >> 1) * 16 + swz / 64; C = (st & 1) * 32 + (swz % 64) / 2; }
__host__ __device__ __forceinline__ int perm32(int rho) { const int n = rho >> 4, i = rho & 15; return 8 * (i >> 2) + 4 * n + (i & 3); }

struct Unit { int pm, pn, eb, ko; };
struct Gemm { const bf16_t* A; const bf16_t* Bt; int M, N, K; size_t bstride; int ld; };

struct StaticOrder {
    int nM, nN, nwg, G, c;
    __host__ __device__ void init(int M, int N, int G_, int c_) { nM = M / BM; nN = N / BM; nwg = nM * nN; G = G_; c = c_; }
    __host__ __device__ bool next(int i, Unit& u) const {
        const long L = (long)i * G + c; if (L >= nwg) return false;
        int wgid = (int)L; { const int q = nwg / NXCD, r = nwg % NXCD, xcd = wgid % NXCD, off = wgid / NXCD; wgid = (xcd < r ? xcd * (q + 1) : r * (q + 1) + (xcd - r) * q) + off; }
        const int nig = WGM * nN, gid = wgid / nig, fm = gid * WGM, gsz = (nM - fm) < WGM ? (nM - fm) : WGM;
        u.pm = fm + ((wgid % nig) % gsz); u.pn = (wgid % nig) / gsz; u.eb = 0; u.ko = 0; return true;
    }
    __device__ __forceinline__ void a_ready(const Unit&) const {}
    __device__ __forceinline__ void done(const Unit&) const {}
    __device__ __forceinline__ void pre(int) const {}
    __device__ __forceinline__ void post(int) const {}
};


__device__ __forceinline__ unsigned cvt_pk_bf16(float lo, float hi) { unsigned r; asm volatile("v_cvt_pk_bf16_f32 %0, %1, %2" : "=v"(r) : "v"(lo), "v"(hi)); return r; }
typedef unsigned u32x2 __attribute__((ext_vector_type(2)));
__device__ __forceinline__ void row_rs8_load(const float* ssq, int row0, int fq, f32x4 (&p)[2][4]) {
#pragma unroll
    for (int ai = 0; ai < 2; ++ai)
#pragma unroll
        for (int m = 0; m < 4; ++m) p[ai][m] = *(const f32x4*)(ssq + (size_t)(row0 + ai * HALF + m * 16) * 16 + 4 * fq);
}
__device__ __forceinline__ void row_rs8_reduce(const f32x4 (&p)[2][4], float (&rs)[2][4]) {
#pragma unroll
    for (int ai = 0; ai < 2; ++ai)
#pragma unroll
        for (int m = 0; m < 4; ++m) { float s = (p[ai][m][0] + p[ai][m][1]) + (p[ai][m][2] + p[ai][m][3]); s = fq_sum(s); rs[ai][m] = __builtin_amdgcn_rsqf(s * (1.0f / cfg::D) + cfg::EPS); }
}
__device__ __forceinline__ void row_rs8(const float* ssq, int row0, int fq, float (&rs)[2][4]) {
#pragma unroll
    for (int ai = 0; ai < 2; ++ai)
#pragma unroll
        for (int m = 0; m < 4; ++m) { const f32x4 p = *(const f32x4*)(ssq + (size_t)(row0 + ai * HALF + m * 16) * 16 + 4 * fq);
            float s = (p[0] + p[1]) + (p[2] + p[3]); s = fq_sum(s);
            rs[ai][m] = __builtin_amdgcn_rsqf(s * (1.0f / cfg::D) + cfg::EPS); }
}
template <bool DO_ROPE = true, bool DO_RS = true> struct EpiRopeT {
    static constexpr bool PERM = true, AFTER_DRAIN = false;
    bf16_t* O; const float* ssq; const float* rope;
    static __device__ __forceinline__ void store_pair(bf16_t* p, const f32x4 v0, const f32x4 v1) {
        float a0 = __builtin_bit_cast(float, cvt_pk_bf16(v0[0], v0[1])), a1 = __builtin_bit_cast(float, cvt_pk_bf16(v0[2], v0[3]));
        float b0 = __builtin_bit_cast(float, cvt_pk_bf16(v1[0], v1[1])), b1 = __builtin_bit_cast(float, cvt_pk_bf16(v1[2], v1[3]));
        pl32_swap(a0, b0); pl32_swap(a1, b1);
        u32x4 w; w.x = __builtin_bit_cast(unsigned, a0); w.y = __builtin_bit_cast(unsigned, a1); w.z = __builtin_bit_cast(unsigned, b0); w.w = __builtin_bit_cast(unsigned, b1);
        *(u32x4*)p = w;
    }
    __device__ __forceinline__ void operator()(const f32x4 (&acc)[2][2][4][2], const Unit& u, int wr, int wc, int fr, int fq) const {
        const int row0 = u.pm * BM + wr * 64 + fr;
        const int q8 = (wc & 1) * 4 + 2 * (fq & 1) + (fq >> 1);
        const int cst = (fq >> 1) * 32 + 8 * (2 * (wc & 1) + (fq & 1));
        const bool any_rope = DO_ROPE && ((u.pn < 4) || (u.pn >= 6));
        f32x4 praw[2][4]; if (DO_RS) row_rs8_load(ssq, row0, fq, praw);
        f32x4 coa[2][4], sia[2][4];
#define ROPE_LOAD(ai_) do { if (any_rope) { _Pragma("unroll") for (int m = 0; m < 4; ++m) { const int r = row0 + (ai_) * HALF + m * 16; const float* cs = rope + (size_t)(r & (cfg::S - 1)) * 32 + 4 * q8; \
            coa[ai_][m] = *(const f32x4*)cs; sia[ai_][m] = *(const f32x4*)(cs + cfg::S * 32); } } } while (0)
        ROPE_LOAD(0);
        float rs[2][4];
        if (DO_RS) row_rs8_reduce(praw, rs); else { _Pragma("unroll") for (int a_ = 0; a_ < 2; ++a_) _Pragma("unroll") for (int m_ = 0; m_ < 4; ++m_) rs[a_][m_] = 1.0f; }
        ROPE_LOAD(1);
#undef ROPE_LOAD
#pragma unroll
        for (int ai = 0; ai < 2; ++ai) {
            const f32x4 (&co)[4] = coa[ai]; const f32x4 (&si)[4] = sia[ai];
#pragma unroll
            for (int bj = 0; bj < 2; ++bj) {
                const int hb = u.pn * 4 + bj * 2 + (wc >> 1);
                const bool roped = DO_ROPE && ((hb < 16) || (hb >= 24 && hb < 34));
                const bool isq = (hb < 8) || (hb >= 24 && hb < 32);
                const float sc = isq ? cfg::C2 : 1.0f;
                bf16_t* pb = O + (size_t)(row0 + ai * HALF) * cfg::INW + hb * 64 + cst;
                if (roped) {
#pragma unroll
                    for (int m = 0; m < 4; ++m) { const float f = rs[ai][m] * sc; const f32x4 v0 = acc[ai][bj][m][0] * f, v1 = acc[ai][bj][m][1] * f;
                        store_pair(pb + (size_t)m * 16 * cfg::INW, v0 * co[m] - v1 * si[m], v1 * co[m] + v0 * si[m]); }
                } else {
#pragma unroll
                    for (int m = 0; m < 4; ++m) { const float f = rs[ai][m] * sc; store_pair(pb + (size_t)m * 16 * cfg::INW, acc[ai][bj][m][0] * f, acc[ai][bj][m][1] * f); }
                }
            }
        }
    }
};
typedef EpiRopeT<true, true> EpiRope;
struct EpiResid {
    static constexpr bool PERM = true, AFTER_DRAIN = false;
    bf16_t* x; float* ssq;
    __device__ __forceinline__ void operator()(const f32x4 (&acc)[2][2][4][2], const Unit& u, int wr, int wc, int fr, int fq) const {
        const int row0 = u.pm * BM + wr * 64 + fr, col0 = u.pn * BM + wc * 32 + 8 * fq;
#pragma unroll
        for (int ai = 0; ai < 2; ++ai) {
            u32x4 b[4][2];
#pragma unroll
            for (int m = 0; m < 4; ++m) { const bf16_t* p = x + (size_t)(row0 + ai * HALF + m * 16) * cfg::D + col0; b[m][0] = *(const u32x4*)p; b[m][1] = *(const u32x4*)(p + HALF); }
#pragma unroll
            for (int m = 0; m < 4; ++m) { const int r = row0 + ai * HALF + m * 16; bf16_t* p = x + (size_t)r * cfg::D + col0; float s = 0.f;
#pragma unroll
                for (int bj = 0; bj < 2; ++bj) { const u32x4 bb = b[m][bj]; const f32x4 a0 = acc[ai][bj][m][0], a1 = acc[ai][bj][m][1];
                    const float o0 = __builtin_bit_cast(float, bb.x << 16) + a0[0], o1 = __builtin_bit_cast(float, bb.x & 0xffff0000u) + a0[1], o2 = __builtin_bit_cast(float, bb.y << 16) + a0[2], o3 = __builtin_bit_cast(float, bb.y & 0xffff0000u) + a0[3];
                    const float o4 = __builtin_bit_cast(float, bb.z << 16) + a1[0], o5 = __builtin_bit_cast(float, bb.z & 0xffff0000u) + a1[1], o6 = __builtin_bit_cast(float, bb.w << 16) + a1[2], o7 = __builtin_bit_cast(float, bb.w & 0xffff0000u) + a1[3];
                    s += ((o0 * o0 + o1 * o1) + (o2 * o2 + o3 * o3)) + ((o4 * o4 + o5 * o5) + (o6 * o6 + o7 * o7));
                    u32x4 w; w.x = cvt_pk_bf16(o0, o1); w.y = cvt_pk_bf16(o2, o3); w.z = cvt_pk_bf16(o4, o5); w.w = cvt_pk_bf16(o6, o7);
                    *(u32x4*)(p + bj * HALF) = w; }
                s = fq_sum(s);
                if (fq == 0) ssq[(size_t)r * 16 + u.pn * 4 + wc] = s; }
        }
    }
};
typedef float f32x2 __attribute__((ext_vector_type(2)));
__device__ __forceinline__ f32x2 silu_mul2(f32x2 gs, f32x2 gu) {
    f32x2 e; e.x = __builtin_amdgcn_exp2f(gs.x); e.y = __builtin_amdgcn_exp2f(gs.y);
    const f32x2 d = e + 1.0f; f32x2 r; r.x = __builtin_amdgcn_rcpf(d.x); r.y = __builtin_amdgcn_rcpf(d.y);
    return gu * r;
}
template <bool RS> struct EpiSwiglu {
    static constexpr bool PERM = true, AFTER_DRAIN = false;
    bf16_t* H; const float* ssq;
    __device__ __forceinline__ void operator()(const f32x4 (&acc)[2][2][4][2], const Unit& u, int wr, int wc, int fr, int fq) const {
        const int row0 = u.pm * BM + wr * 64 + fr, col0 = u.pn * HALF + wc * 32 + 8 * fq;
        float rs[2][4];
        if (RS) row_rs8(ssq, row0, fq, rs);
#pragma unroll
        for (int ai = 0; ai < 2; ++ai)
#pragma unroll
            for (int m = 0; m < 4; ++m) { const int r = row0 + ai * HALF + m * 16; const float f = RS ? rs[ai][m] : 1.0f, fe = -cfg::LOG2E * f, ff = f * f;
                unsigned w[4];
#pragma unroll
                for (int n = 0; n < 2; ++n) { const f32x4 g = acc[ai][0][m][n], up = acc[ai][1][m][n];
                    const f32x2 ga = {g[0], g[1]}, gb = {g[2], g[3]}, ua = {up[0], up[1]}, ub = {up[2], up[3]};
                    const f32x2 ha = silu_mul2(ga * fe, RS ? (ga * ua) * ff : ga * ua), hb = silu_mul2(gb * fe, RS ? (gb * ub) * ff : gb * ub);
                    w[2 * n] = cvt_pk_bf16(ha.x, ha.y); w[2 * n + 1] = cvt_pk_bf16(hb.x, hb.y); }
                u32x4 wv; wv.x = w[0]; wv.y = w[1]; wv.z = w[2]; wv.w = w[3];
                *(u32x4*)(H + (size_t)r * cfg::FF + col0) = wv; }
    }
};
struct EpiY {
    static constexpr bool PERM = true, AFTER_DRAIN = false;
    bf16_t* Y; const float* gate;
    __device__ __forceinline__ void operator()(const f32x4 (&acc)[2][2][4][2], const Unit& u, int wr, int wc, int fr, int fq) const {
        const int row0 = u.pm * BM + wr * 64 + fr, col0 = u.pn * BM + wc * 32 + 8 * fq;
        float gt[2][4];
#pragma unroll
        for (int ai = 0; ai < 2; ++ai)
#pragma unroll
            for (int m = 0; m < 4; ++m) gt[ai][m] = gate[row0 + ai * HALF + m * 16];
#pragma unroll
        for (int ai = 0; ai < 2; ++ai)
#pragma unroll
            for (int m = 0; m < 4; ++m) { const int r = row0 + ai * HALF + m * 16; const float f = gt[ai][m];
#pragma unroll
                for (int bj = 0; bj < 2; ++bj) { const f32x4 v0 = acc[ai][bj][m][0] * f, v1 = acc[ai][bj][m][1] * f;
                    u32x4 w; w.x = cvt_pk_bf16(v0[0], v0[1]); w.y = cvt_pk_bf16(v0[2], v0[3]); w.z = cvt_pk_bf16(v1[0], v1[1]); w.w = cvt_pk_bf16(v1[2], v1[3]);
                    *(u32x4*)(Y + (size_t)r * cfg::D + col0 + bj * HALF) = w; } }
    }
};
struct EpiNull {
    static constexpr bool PERM = true, AFTER_DRAIN = false;
    __device__ __forceinline__ void operator()(const f32x4 (&acc)[2][2][4][2], const Unit& u, int wr, int wc, int fr, int fq) const {
#pragma unroll
        for (int ai = 0; ai < 2; ++ai)
#pragma unroll
            for (int bj = 0; bj < 2; ++bj)
#pragma unroll
                for (int m = 0; m < 4; ++m)
#pragma unroll
                    for (int n = 0; n < 2; ++n) asm volatile("" :: "v"(acc[ai][bj][m][n]));
    }
};
struct EpiRaw {
    static constexpr bool PERM = true, AFTER_DRAIN = false;
    bf16_t* H;
    __device__ __forceinline__ void operator()(const f32x4 (&acc)[2][2][4][2], const Unit& u, int wr, int wc, int fr, int fq) const {
        const int row0 = u.pm * BM + wr * 64 + fr, col0 = u.pn * HALF + wc * 32 + 8 * fq;
#pragma unroll
        for (int ai = 0; ai < 2; ++ai)
#pragma unroll
            for (int m = 0; m < 4; ++m) { const int r = row0 + ai * HALF + m * 16;
                const f32x4 g0 = acc[ai][0][m][0] + acc[ai][1][m][0], g1 = acc[ai][0][m][1] + acc[ai][1][m][1];
                u32x4 w; w.x = cvt_pk_bf16(g0[0], g0[1]); w.y = cvt_pk_bf16(g0[2], g0[3]); w.z = cvt_pk_bf16(g1[0], g1[1]); w.w = cvt_pk_bf16(g1[2], g1[3]);
                *(u32x4*)(H + (size_t)r * cfg::FF + col0) = w; }
    }
};
struct GroupedOrder : StaticOrder {
    const PG8_LAS int* segb;
    __device__ __forceinline__ bool next(int i, Unit& u) const {
        if (!StaticOrder::next(i, u)) return false;
        const int r = u.pm * BM; int e = 0;
#pragma unroll
        for (int k = 1; k < 8; ++k) e += (r >= segb[k]) ? 1 : 0;
        u.eb = e; return true;
    }
};

struct TailOrder {
    int npair, G, c; const PG8_LAS int* segb;
    __device__ __forceinline__ bool next(int i, Unit& u) const {
        const int L = i * G + c; if (L >= npair * cfg::KSPLIT) return false;
        const int q = L / cfg::KSPLIT, s = L % cfg::KSPLIT; u.pm = cfg::MAINROWS / BM + (q >> 2); u.pn = q & 3; u.ko = s * (cfg::FF / cfg::KSPLIT);
        const int r = u.pm * BM; int e = 0;
#pragma unroll
        for (int k = 1; k < 8; ++k) e += (r >= segb[k]) ? 1 : 0;
        u.eb = e; return true;
    }
    __device__ __forceinline__ void a_ready(const Unit&) const {}
    __device__ __forceinline__ void done(const Unit&) const {}
    __device__ __forceinline__ void pre(int) const {}
    __device__ __forceinline__ void post(int) const {}
};
struct EpiPart {
    static constexpr bool PERM = true, AFTER_DRAIN = false;
    bf16_t* PT;
    __device__ __forceinline__ void operator()(const f32x4 (&acc)[2][2][4][2], const Unit& u, int wr, int wc, int fr, int fq) const {
        const int row0 = u.pm * BM - cfg::MAINROWS + wr * 64 + fr, col0 = u.pn * BM + wc * 32 + 8 * fq, s = u.ko / (cfg::FF / cfg::KSPLIT);
        bf16_t* base = PT + (size_t)s * cfg::TAILROWS * cfg::D;
#pragma unroll
        for (int ai = 0; ai < 2; ++ai)
#pragma unroll
            for (int m = 0; m < 4; ++m) { const int r = row0 + ai * HALF + m * 16;
#pragma unroll
                for (int bj = 0; bj < 2; ++bj) { const f32x4 v0 = acc[ai][bj][m][0], v1 = acc[ai][bj][m][1];
                    u32x4 w; w.x = cvt_pk_bf16(v0[0], v0[1]); w.y = cvt_pk_bf16(v0[2], v0[3]); w.z = cvt_pk_bf16(v1[0], v1[1]); w.w = cvt_pk_bf16(v1[2], v1[3]);
                    *(u32x4*)(base + (size_t)r * cfg::D + col0 + bj * HALF) = w; } }
    }
};

template <class Epi, class Sched, bool ALIGN_EPI = false, bool SP2 = false>
__device__ __forceinline__ void gemm_phase(PG8_LAS unsigned char* lds, const Gemm g, const Sched& S, const Epi& E, const int tid_in) {
    const int tid = tid_in, wid = __builtin_amdgcn_readfirstlane(tid >> 6), lane = tid & 63, wr = wid >> 2, wc = wid & 3, fr = lane & 15, fq = lane >> 4;
    const int K = g.K, nt = K / BK, LD = g.ld;
    unsigned voffA[2], voffB[2];
#pragma unroll
    for (int i = 0; i < 2; ++i) { int R, C; stage_rc(tid * 16 + i * 8192, R, C); const int Rb = Epi::PERM ? ((R & ~31) + perm32(R & 31)) : R;
        voffA[i] = (unsigned)(R * LD + C) * 2u; voffB[i] = (unsigned)(Rb * LD + C) * 2u; }
    const size_t kstep = (size_t)(BK * 2);
    const size_t hstep = (size_t)HALF * LD * 2;
    const size_t tstep = 2 * hstep;
    const unsigned ldsw = (unsigned)wid * 1024u;
    const int aoff = lds_byte(wr * 64 + fr, fq * 8), boff = lds_byte(wc * 32 + fr, fq * 8);
#define PG8_SA(b, h) (((b) * 2 + (h)) * HTB)
#define PG8_SB(b, h) ((4 + (b) * 2 + (h)) * HTB)
#define PG8_STAGE(bufoff, gbase, voff) do { _Pragma("unroll") for (int _i = 0; _i < 2; ++_i) \
        __builtin_amdgcn_global_load_lds((const unsigned*)((const char*)(gbase) + (voff)[_i]), (PG8_LAS unsigned*)(lds + (bufoff) + ldsw + _i * 8192), 16, 0, 0); } while (0)
#define PG8_LDA(dst, b, h) do { _Pragma("unroll") for (int m = 0; m < 4; ++m) _Pragma("unroll") for (int k = 0; k < 2; ++k) dst[m][k] = *(const PG8_LAS bf16x8*)(lds + PG8_SA(b, h) + aoff + m * 2048 + k * 1024); } while (0)
#define PG8_LDB(dst, b, h) do { _Pragma("unroll") for (int n = 0; n < 2; ++n) _Pragma("unroll") for (int k = 0; k < 2; ++k) dst[n][k] = *(const PG8_LAS bf16x8*)(lds + PG8_SB(b, h) + boff + n * 2048 + k * 1024); } while (0)
#define PG8_MMA(ai, bj, At, Bt) do { __builtin_amdgcn_s_setprio(1); _Pragma("unroll") for (int m = 0; m < 4; ++m) _Pragma("unroll") for (int n = 0; n < 2; ++n) _Pragma("unroll") for (int k = 0; k < 2; ++k) \
        acc[ai][bj][m][n] = __builtin_amdgcn_mfma_f32_16x16x32_bf16(Bt[n][k], At[m][k], acc[ai][bj][m][n], 0, 0, 0); __builtin_amdgcn_s_setprio(0); } while (0)
#define PG8_WAIT_V(n) asm volatile("s_waitcnt vmcnt(" #n ")" ::: "memory")
#define PG8_WAIT_L(n) asm volatile("s_waitcnt lgkmcnt(" #n ")" ::: "memory")
#define PG8_BAR __builtin_amdgcn_s_barrier()
#define PG8_SCHED __builtin_amdgcn_sched_barrier(0)
    Unit cur, nxt; int ui = 0;
    if (!S.next(0, cur)) return;
    f32x4 acc[2][2][4][2];
#pragma unroll
    for (int a = 0; a < 2; ++a)
#pragma unroll
        for (int b = 0; b < 2; ++b)
#pragma unroll
            for (int m = 0; m < 4; ++m)
#pragma unroll
                for (int n = 0; n < 2; ++n) acc[a][b][m][n] = (f32x4){0.f, 0.f, 0.f, 0.f};
    bf16x8 At[4][2], B0[2][2], B1[2][2];
    const char* cA = (const char*)g.A + (size_t)cur.pm * tstep + (size_t)cur.ko * 2; const char* cB = (const char*)g.Bt + (size_t)cur.eb * g.bstride + (size_t)cur.pn * tstep + (size_t)cur.ko * 2;
    S.a_ready(cur);
    if constexpr (SP2) {
        PG8_STAGE(PG8_SB(0, 0), cB, voffB); PG8_STAGE(PG8_SB(0, 1), cB + hstep, voffB); PG8_STAGE(PG8_SA(0, 0), cA, voffA); PG8_STAGE(PG8_SA(0, 1), cA + hstep, voffA);
        if (wr == 1) PG8_BAR;
        PG8_WAIT_V(2); PG8_BAR;
        PG8_STAGE(PG8_SB(1, 0), cB + kstep, voffB); PG8_STAGE(PG8_SA(1, 0), cA + kstep, voffA); PG8_STAGE(PG8_SB(1, 1), cB + hstep + kstep, voffB);
        PG8_WAIT_V(6); PG8_BAR;
    } else {
        PG8_STAGE(PG8_SB(0, 0), cB, voffB); PG8_STAGE(PG8_SA(0, 0), cA, voffA); PG8_STAGE(PG8_SB(0, 1), cB + hstep, voffB); PG8_STAGE(PG8_SA(0, 1), cA + hstep, voffA);
        if (wr == 1) PG8_BAR;
        PG8_WAIT_V(4); PG8_BAR;
        PG8_STAGE(PG8_SB(1, 0), cB + kstep, voffB); PG8_STAGE(PG8_SA(1, 0), cA + kstep, voffA); PG8_STAGE(PG8_SB(1, 1), cB + hstep + kstep, voffB);
        PG8_WAIT_V(6); PG8_BAR;
    }
    for (;;) {
        const bool has_next = S.next(ui + 1, nxt);
        const char* nA = has_next ? (const char*)g.A + (size_t)nxt.pm * tstep + (size_t)nxt.ko * 2 : cA; const char* nB = has_next ? (const char*)g.Bt + (size_t)nxt.eb * g.bstride + (size_t)nxt.pn * tstep + (size_t)nxt.ko * 2 : cB;
        for (int t = 0; t < nt; t += 2) {
            const bool last = (t == nt - 2);
            const char* a1 = cA + (size_t)(t + 1) * kstep;
            const char* a2 = last ? nA : cA + (size_t)(t + 2) * kstep; const char* b2 = last ? nB : cB + (size_t)(t + 2) * kstep;
            const char* a3 = a2 + kstep; const char* b3 = b2 + kstep;
            if (last && has_next) S.a_ready(nxt);
            if constexpr (SP2) {
            PG8_LDB(B0, 0, 0); PG8_LDB(B1, 0, 1); PG8_SCHED; PG8_LDA(At, 0, 0); PG8_STAGE(PG8_SA(1, 1), a1 + hstep, voffA);
            PG8_WAIT_V(8); PG8_WAIT_L(0); PG8_BAR; PG8_MMA(0, 0, At, B0); PG8_MMA(0, 1, At, B1); PG8_BAR; PG8_SCHED;
            PG8_LDA(At, 0, 1); PG8_STAGE(PG8_SB(0, 0), b2, voffB); PG8_STAGE(PG8_SB(0, 1), b2 + hstep, voffB); PG8_STAGE(PG8_SA(0, 0), a2, voffA);
            PG8_WAIT_V(8); PG8_WAIT_L(0); PG8_BAR; PG8_MMA(1, 0, At, B0); PG8_MMA(1, 1, At, B1); PG8_BAR; PG8_SCHED;
            PG8_LDB(B0, 1, 0); PG8_LDB(B1, 1, 1); PG8_SCHED; PG8_LDA(At, 1, 0); PG8_STAGE(PG8_SA(0, 1), a2 + hstep, voffA);
            PG8_WAIT_V(8); PG8_WAIT_L(0); PG8_BAR; PG8_MMA(0, 0, At, B0); PG8_MMA(0, 1, At, B1); PG8_BAR; PG8_SCHED;
            PG8_LDA(At, 1, 1); PG8_STAGE(PG8_SB(1, 0), b3, voffB); PG8_STAGE(PG8_SB(1, 1), b3 + hstep, voffB); PG8_STAGE(PG8_SA(1, 0), a3, voffA);
            PG8_WAIT_V(8); PG8_WAIT_L(0); PG8_BAR; PG8_MMA(1, 0, At, B0); PG8_MMA(1, 1, At, B1); PG8_BAR; PG8_SCHED;
            } else {
            PG8_LDB(B0, 0, 0); PG8_SCHED; PG8_LDA(At, 0, 0); PG8_STAGE(PG8_SA(1, 1), a1 + hstep, voffA);
            PG8_WAIT_L(8); PG8_BAR; PG8_WAIT_L(0); PG8_MMA(0, 0, At, B0); PG8_BAR; PG8_SCHED;
            PG8_LDB(B1, 0, 1); PG8_STAGE(PG8_SB(0, 0), b2, voffB);
            PG8_BAR; PG8_WAIT_L(0); PG8_MMA(0, 1, At, B1); PG8_BAR;
            PG8_LDA(At, 0, 1); PG8_STAGE(PG8_SA(0, 0), a2, voffA);
            PG8_BAR; PG8_WAIT_L(0); PG8_MMA(1, 0, At, B0); PG8_BAR; PG8_SCHED;
            PG8_STAGE(PG8_SB(0, 1), b2 + hstep, voffB);
            PG8_WAIT_V(6); PG8_BAR; PG8_MMA(1, 1, At, B1); PG8_BAR;
            PG8_LDB(B0, 1, 0); PG8_SCHED; PG8_LDA(At, 1, 0); PG8_STAGE(PG8_SA(0, 1), a2 + hstep, voffA);
            PG8_WAIT_L(8); PG8_BAR; PG8_WAIT_L(0); PG8_MMA(0, 0, At, B0); PG8_BAR; PG8_SCHED;
            PG8_LDB(B1, 1, 1); PG8_STAGE(PG8_SB(1, 0), b3, voffB);
            PG8_BAR; PG8_WAIT_L(0); PG8_MMA(0, 1, At, B1); PG8_BAR;
            PG8_LDA(At, 1, 1); PG8_STAGE(PG8_SA(1, 0), a3, voffA);
            PG8_BAR; PG8_WAIT_L(0); PG8_MMA(1, 0, At, B0); PG8_BAR; PG8_SCHED;
            PG8_STAGE(PG8_SB(1, 1), b3 + hstep, voffB);
            PG8_WAIT_V(6); PG8_BAR; PG8_MMA(1, 1, At, B1); PG8_BAR;
            }
        }
        if constexpr (ALIGN_EPI) { if (wr == 0) PG8_BAR; }
        if constexpr (!Epi::AFTER_DRAIN) { S.pre(ui); E(acc, cur, wr, wc, fr, fq); S.post(ui); S.done(cur); }
        if (!has_next) break;
#pragma unroll
        for (int a = 0; a < 2; ++a)
#pragma unroll
            for (int b = 0; b < 2; ++b)
#pragma unroll
                for (int m = 0; m < 4; ++m)
#pragma unroll
                    for (int n = 0; n < 2; ++n) acc[a][b][m][n] = (f32x4){0.f, 0.f, 0.f, 0.f};
        cur = nxt; cA = nA; cB = nB; ++ui;
        if constexpr (ALIGN_EPI) { if (wr == 1) PG8_BAR; }
    }
    PG8_WAIT_V(0);
    if constexpr (!ALIGN_EPI) { if (wr == 0) PG8_BAR; }
    PG8_BAR;
    if constexpr (Epi::AFTER_DRAIN) { E.fused(acc, cur, wr, wc, fr, fq, lds, wid, lane); S.done(cur); }
#undef PG8_SA
#undef PG8_SB
#undef PG8_STAGE
#undef PG8_LDA
#undef PG8_LDB
#undef PG8_MMA
#undef PG8_WAIT_V
#undef PG8_WAIT_L
#undef PG8_BAR
#undef PG8_SCHED
}
}


using namespace cfg;
constexpr size_t MiB = 1u << 20;
constexpr size_t WS_CTL = 0, CTL_ZERO_BYTES = 1 * MiB;
constexpr size_t WS_ROPE = 1 * MiB;
constexpr size_t WS_SSQA = 3 * MiB;
constexpr size_t WS_SSQF = 5 * MiB;
constexpr size_t WS_ROUTE = 7 * MiB;
constexpr size_t WS_BLKCNT = 8 * MiB;
constexpr size_t WS_ROWGATE = 9 * MiB;
constexpr size_t WS_WIN = 16 * MiB;
constexpr size_t WS_WOUT = 34 * MiB;
constexpr size_t WS_WGU = 42 * MiB;
constexpr size_t WS_WDN = 70 * MiB;
constexpr size_t WS_MGU = 84 * MiB;
constexpr size_t WS_MDN = 196 * MiB;
constexpr size_t WS_XN = 252 * MiB;
constexpr size_t WS_PROJ = 316 * MiB;
constexpr size_t WS_OPART = 460 * MiB;
constexpr size_t WS_LSE = 588 * MiB;
constexpr size_t WS_MIX = 592 * MiB;
constexpr size_t WS_H = 316 * MiB;
constexpr size_t WS_AP = 778 * MiB;
constexpr size_t WS_PT = 910 * MiB;
constexpr size_t WS_END = WS_PT + (size_t)KSPLIT * TAILROWS * D * 2;
static_assert(WS_H + (size_t)MAXROWS * FF * 2 <= WS_AP && WS_AP + (size_t)MAXROWS * D * 2 <= WS_END && WS_MIX + (size_t)M * D * 2 <= WS_AP, "d_ws map");
static_assert(WS_ROWGATE + (size_t)MAXROWS * 4 <= WS_WIN && WS_LSE + (size_t)3 * M * 8 * 4 <= WS_MIX, "d_ws map 2");
constexpr int CW_BAR = 4096;
constexpr int LDS_BYTES = 147456;
constexpr int RING_OFF = 0, RING_BYTES = 131072;
constexpr int LDSCTL_OFF = LDS_BYTES - 1024, MISC_OFF = LDSCTL_OFF + 320;
constexpr int NWAVES = 8;

#define GAS __attribute__((address_space(1)))
#define LAS __attribute__((address_space(3)))
typedef unsigned short bf16;
typedef unsigned v4u __attribute__((ext_vector_type(4)));
typedef float f32x4 __attribute__((ext_vector_type(4)));
typedef short bf16x8 __attribute__((ext_vector_type(8)));
typedef GAS unsigned gu32;
typedef GAS unsigned long long gu64;
#define RLX_AGENT __ATOMIC_RELAXED, __HIP_MEMORY_SCOPE_AGENT
#define LDS_WAIT() asm volatile("s_waitcnt lgkmcnt(0)" ::: "memory")
#define VM_WAIT() asm volatile("s_waitcnt vmcnt(0)" ::: "memory")
__device__ __forceinline__ unsigned long long rt() { return __builtin_amdgcn_s_memrealtime(); }
__device__ __forceinline__ unsigned f2bf(float f) { unsigned u = __builtin_bit_cast(unsigned, f); return (u + 0x7fffu + ((u >> 16) & 1u)) >> 16; }
__device__ __forceinline__ unsigned pk2(float lo, float hi) { return f2bf(lo) | (f2bf(hi) << 16); }

#define XB_TMO      128
#define XB_XCNT(j)  (256  + 64 * (j))
#define XB_XSUB(j)  (1280 + 64 * (j))
#define XB_XGEN(j)  (2304 + 64 * (j))
#define XB_TOP      3328
#define XB_TOPGEN   3392
#define XCD_BAR_WORDS 3456
#define XB_SPIN_CAP (1u << 18)

__device__ __forceinline__ unsigned xb_ld(unsigned* p)              { return __hip_atomic_load(p, __ATOMIC_RELAXED, __HIP_MEMORY_SCOPE_AGENT); }
__device__ __forceinline__ unsigned xb_add(unsigned* p, unsigned v) { return __hip_atomic_fetch_add(p, v, __ATOMIC_RELAXED, __HIP_MEMORY_SCOPE_AGENT); }
__device__ __forceinline__ unsigned xb_xcc_id() { return (unsigned)__builtin_amdgcn_s_getreg((3 << 11) | 20) & 0xFu; }
#define XB_SPIN(cond, bar) do { unsigned _sp = 0; while (cond) { __builtin_amdgcn_s_sleep(1); \
    if ((++_sp & 255u) == 0u) { if (xb_ld(&(bar)[XB_TMO])) break; if (_sp > XB_SPIN_CAP) { atomicAdd(&(bar)[XB_TMO], 1u); break; } } } } while (0)

struct XcdBarrier {
    unsigned* bar; unsigned x;
    volatile LAS unsigned* st;
};

__device__ __forceinline__ XcdBarrier xcd_barrier_post(unsigned* bar, volatile LAS unsigned* st, const int tidx) {
    XcdBarrier b; b.bar = bar; b.x = xb_xcc_id(); b.st = st;
    if (tidx == 0) (void)xb_add(&bar[XB_XCNT(b.x)], 1u);
    return b;
}
__device__ __forceinline__ void xcd_barrier_complete(unsigned* bar, unsigned x, unsigned& nloc, unsigned& nx) {
    const unsigned G = gridDim.x * gridDim.y * gridDim.z;
    unsigned sum, cnt, mine, sp = 0u;
    for (;;) {
        sum = 0u; cnt = 0u; mine = 0u;
#pragma unroll
        for (unsigned j = 0; j < 16; ++j) { const unsigned c = xb_ld(&bar[XB_XCNT(j)]); sum += c; cnt += (c > 0u) ? 1u : 0u; mine = (j == x) ? c : mine; }
        if (sum == G) break;
        __builtin_amdgcn_s_sleep(1);
        if ((++sp & 255u) == 0u) { if (xb_ld(&bar[XB_TMO])) break; if (sp > XB_SPIN_CAP) { atomicAdd(&bar[XB_TMO], 1u); break; } }
    }
    nloc = mine > 0u ? mine : 1u; nx = cnt > 0u ? cnt : 1u;
}

__device__ __forceinline__ void xcd_barrier(const XcdBarrier& b, const int tidx) {
    asm volatile("s_waitcnt vmcnt(0)" ::: "memory");
    __syncthreads();
    if (tidx == 0) {
        unsigned* bar = b.bar;
        __builtin_amdgcn_s_waitcnt(0);
        unsigned nloc = b.st[0], nx = b.st[1];
        if (nloc == 0u) { xcd_barrier_complete(bar, b.x, nloc, nx); b.st[0] = nloc; b.st[1] = nx; }
        const unsigned old = xb_add(&bar[XB_XSUB(b.x)], 1u);
        const unsigned gen = old / nloc;
        if (old + 1u == (gen + 1u) * nloc) {
            __builtin_amdgcn_fence(__ATOMIC_RELEASE, "agent");
            asm volatile("s_waitcnt vmcnt(0)" ::: "memory");
            const unsigned og = xb_add(&bar[XB_TOP], 1u);
            const unsigned tg = og / nx;
            if (og + 1u == (tg + 1u) * nx) xb_add(&bar[XB_TOPGEN], 1u);
            else XB_SPIN(xb_ld(&bar[XB_TOPGEN]) == tg, bar);
            __builtin_amdgcn_fence(__ATOMIC_ACQUIRE, "agent");
            xb_add(&bar[XB_XGEN(b.x)], 1u);
            asm volatile("s_waitcnt vmcnt(0)" ::: "memory");
        } else {
            XB_SPIN(xb_ld(&bar[XB_XGEN(b.x)]) == gen, bar);
            __builtin_amdgcn_fence(__ATOMIC_ACQUIRE, "agent");
            asm volatile("s_waitcnt vmcnt(0)" ::: "memory");
        }
    }
    __syncthreads();
}


__device__ __forceinline__ float wave_sum(float v) {
    v += swz_xor<1>(v); v += swz_xor<2>(v); v += swz_xor<4>(v); v += swz_xor<8>(v); v += swz_xor<16>(v);
    return xor32_sum(v);
}
__device__ __forceinline__ int wave_sum_i(int v) {
    return (int)(wave_sum((float)v) + 0.5f);
}
__device__ __forceinline__ float bf2f(unsigned short b) { return __builtin_bit_cast(float, (unsigned)b << 16); }
__device__ __forceinline__ float bflo(unsigned w) { return __builtin_bit_cast(float, w << 16); }
__device__ __forceinline__ float bfhi(unsigned w) { return __builtin_bit_cast(float, w & 0xffff0000u); }
typedef unsigned u32x2v __attribute__((ext_vector_type(2)));

struct Ctx { LAS unsigned char* lds; int tid, lane, wave, gw, ngw; };

__device__ __forceinline__ int rowmap(int mode, int n) {
    if (mode == 1) { const int hb = n >> 6, w = n & 63, nn = w >> 5, i = w & 31, gi = i >> 2, fq = ((gi & 1) << 1) | ((gi >> 1) & 1);
        return (hb << 6) + 32 * (gi >> 2) + 8 * fq + 4 * nn + (i & 3); }
    if (mode == 2) return 256 * (n >> 7) + (n & 127);
    if (mode == 3) return 256 * (n >> 7) + 128 + (n & 127);
    return n;
}
struct ConvJob { const float* W; bf16* WT; const float* gain; int K, N, mode, item; };
__device__ __forceinline__ void tr_load(const ConvJob& J, int lane, f32x4 (&v)[8]) {
    const int nblk = J.N / 32, kb = J.item / nblk, nb = J.item % nblk, k0 = 64 * kb, n0 = 32 * nb, lr = lane >> 3, lc = lane & 7;
#pragma unroll
    for (int i = 0; i < 8; ++i) v[i] = *(const GAS f32x4*)(J.W + (size_t)(k0 + 8 * i + lr) * J.N + n0 + 4 * lc);
    if (J.gain) {
#pragma unroll
        for (int i = 0; i < 8; ++i) v[i] = v[i] * J.gain[k0 + 8 * i + lr];
    }
}
__device__ __forceinline__ void tr_store(const ConvJob& J, int lane, LAS float* scr, const f32x4 (&v)[8]) {
    const int nblk = J.N / 32, kb = J.item / nblk, nb = J.item % nblk, k0 = 64 * kb, n0 = 32 * nb, lr = lane >> 3, lc = lane & 7;
#pragma unroll
    for (int i = 0; i < 8; ++i) { LAS float* d = scr + (8 * i + lr) * 33 + 4 * lc; d[0] = v[i][0]; d[1] = v[i][1]; d[2] = v[i][2]; d[3] = v[i][3]; }
    LDS_WAIT(); asm volatile("" ::: "memory");
    const int c = lane & 7;
#pragma unroll
    for (int j = 0; j < 4; ++j) { const int n = (lane >> 3) + 8 * j; const LAS float* s = scr + (8 * c) * 33 + n;
        v4u o; o.x = pk2(s[0 * 33], s[1 * 33]); o.y = pk2(s[2 * 33], s[3 * 33]); o.z = pk2(s[4 * 33], s[5 * 33]); o.w = pk2(s[6 * 33], s[7 * 33]);
        *(GAS v4u*)(J.WT + (size_t)rowmap(J.mode, n0 + n) * J.K + k0 + 8 * c) = o; }
    LDS_WAIT(); asm volatile("" ::: "memory");
}
constexpr int IT_FF = (D / 64) * (FF / 32), IT_IN = (D / 64) * (INW / 32), IT_OUT = (D / 64) * (D / 32);
static_assert((FF / 64) * (D / 32) == IT_FF, "items");
constexpr int MOE_ITEMS = NE * 3 * IT_FF, PRO_ITEMS = DEPTH * (IT_IN + IT_OUT) + 6 * IT_FF;
struct ConvSrc { const float *w_in, *w_out, *attn_norm, *ffn_norm, *dwg, *dwu, *dwd; bf16 *WIN_, *WOUT_, *WGU_, *WDN_; };
__device__ __forceinline__ ConvJob conv_decode_moe(int f, const float* wg, const float* wu, const float* wd, bf16* MGU_, bf16* MDN_) {
    const int job = f / IT_FF, e = job / 3, which = job % 3; ConvJob J; J.item = f % IT_FF; J.gain = nullptr;
    if (which == 2) { J.W = wd + (size_t)e * FF * D; J.WT = MDN_ + (size_t)e * D * FF; J.K = FF; J.N = D; J.mode = 0; }
    else { J.W = (which ? wu : wg) + (size_t)e * D * FF; J.WT = MGU_ + (size_t)e * 2 * FF * D; J.K = D; J.N = FF; J.mode = 2 + which; }
    return J;
}
__device__ __forceinline__ ConvJob conv_decode_pro(int f, const ConvSrc& S) {
    ConvJob J;
    if (f < DEPTH * IT_IN) { const int l = f / IT_IN; J.item = f % IT_IN; J.W = S.w_in + (size_t)l * D * INW; J.WT = S.WIN_ + (size_t)l * INW * D; J.gain = S.attn_norm + l * D; J.K = D; J.N = INW; J.mode = 1; return J; }
    f -= DEPTH * IT_IN;
    if (f < DEPTH * IT_OUT) { const int l = f / IT_OUT; J.item = f % IT_OUT; J.W = S.w_out + (size_t)l * D * D; J.WT = S.WOUT_ + (size_t)l * D * D; J.gain = nullptr; J.K = D; J.N = D; J.mode = 0; return J; }
    f -= DEPTH * IT_OUT;
    const int job = f / IT_FF, j = job / 3, which = job % 3; J.item = f % IT_FF;
    if (which == 2) { J.W = S.dwd + (size_t)j * FF * D; J.WT = S.WDN_ + (size_t)j * D * FF; J.gain = nullptr; J.K = FF; J.N = D; J.mode = 0; }
    else { J.W = (which ? S.dwu : S.dwg) + (size_t)j * D * FF; J.WT = S.WGU_ + (size_t)j * 2 * FF * D; J.gain = S.ffn_norm + (2 * j) * D; J.K = D; J.N = FF; J.mode = 2 + which; }
    return J;
}
#define CONV_LOOP(total, DECODE) do { LAS float* scr_ = (LAS float*)(C.lds + RING_OFF + C.wave * 17408); \
    for (int f_ = C.gw; f_ < (total); f_ += 2 * C.ngw) { f32x4 va_[8], vb_[8]; const bool two_ = f_ + C.ngw < (total); \
        const ConvJob Ja_ = DECODE(f_); tr_load(Ja_, C.lane, va_); \
        ConvJob Jb_ = Ja_; if (two_) { Jb_ = DECODE(f_ + C.ngw); tr_load(Jb_, C.lane, vb_); } \
        tr_store(Ja_, C.lane, scr_, va_); if (two_) tr_store(Jb_, C.lane, scr_ + 2176, vb_); } } while (0)
__device__ __forceinline__ void convert_moe_layer(const Ctx& C, const float* wg, const float* wu, const float* wd, bf16* MGU_, bf16* MDN_) {
#define DEC_MOE(f) conv_decode_moe((f), wg, wu, wd, MGU_, MDN_)
    CONV_LOOP(MOE_ITEMS, DEC_MOE);
#undef DEC_MOE
}
__device__ __forceinline__ void convert_prologue(const Ctx& C, const ConvSrc& S) {
#define DEC_PRO(f) conv_decode_pro((f), S)
    CONV_LOOP(PRO_ITEMS, DEC_PRO);
#undef DEC_PRO
}

__device__ __forceinline__ void ld16bf(const bf16* p, float (&v)[16]) {
    const v4u a = *(const GAS v4u*)p, b = *(const GAS v4u*)(p + 8);
    v[0] = bflo(a.x); v[1] = bfhi(a.x); v[2] = bflo(a.y); v[3] = bfhi(a.y); v[4] = bflo(a.z); v[5] = bfhi(a.z); v[6] = bflo(a.w); v[7] = bfhi(a.w);
    v[8] = bflo(b.x); v[9] = bfhi(b.x); v[10] = bflo(b.y); v[11] = bfhi(b.y); v[12] = bflo(b.z); v[13] = bfhi(b.z); v[14] = bflo(b.w); v[15] = bfhi(b.w);
}
__device__ __forceinline__ void st16bf(bf16* p, const float (&v)[16], float f) {
    v4u a, b; a.x = pk2(v[0] * f, v[1] * f); a.y = pk2(v[2] * f, v[3] * f); a.z = pk2(v[4] * f, v[5] * f); a.w = pk2(v[6] * f, v[7] * f);
    b.x = pk2(v[8] * f, v[9] * f); b.y = pk2(v[10] * f, v[11] * f); b.z = pk2(v[12] * f, v[13] * f); b.w = pk2(v[14] * f, v[15] * f);
    *(GAS v4u*)p = a; *(GAS v4u*)(p + 8) = b;
}
__device__ __forceinline__ void attn_run(const bf16* PROJ, int rowb, int t, int d, int nk, int kcol, int vcol, const float (&q)[16], float (&o)[16], float& mx, float& l) {
    for (int k = 0; k < nk; ++k) {
        const int j = t - d * k; if (j < 0) break;
        const bf16* kr = PROJ + (size_t)(rowb + j) * INW;
        float kv[16]; ld16bf(kr + kcol, kv);
        float s = 0.f;
#pragma unroll
        for (int i = 0; i < 16; ++i) s += q[i] * kv[i];
        s += swz_xor<1>(s); s += swz_xor<2>(s);
        if (s > mx) { const float sc = __builtin_amdgcn_exp2f(mx - s); l *= sc;
#pragma unroll
            for (int i = 0; i < 16; ++i) o[i] *= sc;
            mx = s; }
        const float p = __builtin_amdgcn_exp2f(s - mx); l += p;
        float vv[16]; ld16bf(kr + vcol, vv);
#pragma unroll
        for (int i = 0; i < 16; ++i) o[i] += p * vv[i];
    }
}
__device__ __forceinline__ void attn_naive(const Ctx& C, const bf16* PROJ, bf16* OPART, float* LSE, const float* sinks) {
    const int grp = (blockIdx.x * 512 + C.tid) >> 2, sub = C.tid & 3, ngrp = gridDim.x * 128;
    for (int it = grp; it < M * 16; it += ngrp) {
        const int hh = it / M, row = it % M, t = row & (S - 1), rowb = row - t;
        if (hh < 8) {
            float q[16]; ld16bf(PROJ + (size_t)row * INW + QA_OFF + hh * 64 + sub * 16, q);
#pragma unroll 1
            for (int br = 0; br < 3; ++br) {
                const int d = (br == 0) ? 1 : (br == 1) ? 4 : 16;
                float o[16]; float mx = -INFINITY, l = 0.f;
#pragma unroll
                for (int i = 0; i < 16; ++i) o[i] = 0.f;
                attn_run(PROJ, rowb, t, d, 129, KA_OFF + hh * 64 + sub * 16, VA_OFF + hh * 64 + sub * 16, q, o, mx, l);
                st16bf(OPART + ((size_t)br * M + row) * 512 + hh * 64 + sub * 16, o, 1.0f / l);
                if (sub == 0) LSE[((size_t)br * M + row) * 8 + hh] = mx + __builtin_amdgcn_logf(l);
            }
        } else {
            const int hq = hh - 8, kvh = hq >> 2;
            float q[16]; ld16bf(PROJ + (size_t)row * INW + QB_OFF + hq * 64 + sub * 16, q);
            float o[16]; float mx = -INFINITY, l = 0.f;
#pragma unroll
            for (int i = 0; i < 16; ++i) o[i] = 0.f;
            attn_run(PROJ, rowb, t, 1, 128, KB_OFF + kvh * 64 + sub * 16, VB_OFF + kvh * 64 + sub * 16, q, o, mx, l);
            const float sk = sinks[hq] * LOG2E, m2 = fmaxf(mx, sk), sc = __builtin_amdgcn_exp2f(mx - m2);
            l = l * sc + __builtin_amdgcn_exp2f(sk - m2);
            st16bf(OPART + ((size_t)3 * M + row) * 512 + hq * 64 + sub * 16, o, sc / l);
        }
    }
}


namespace att {
typedef short bf16x8 __attribute__((ext_vector_type(8)));
typedef short s16x4 __attribute__((ext_vector_type(4)));
typedef float f32x16 __attribute__((ext_vector_type(16)));
typedef unsigned u32x4 __attribute__((ext_vector_type(4)));
constexpr int LK = 0, LV = 49152, LWS = 98304, LOST = 100352, LEND = 133120;
static_assert(LEND <= LDSCTL_OFF, "attention LDS");
__device__ __forceinline__ int crow(int r, int hi) { return (r & 3) + 8 * (r >> 2) + 4 * hi; }
__device__ __forceinline__ void glds16(const void* gsrc, unsigned lds_dst) { unsigned keep;
    asm volatile("s_mov_b32 %0, m0\n\ts_mov_b32 m0, %2\n\ts_nop 0\n\tglobal_load_lds_dwordx4 %1, off\n\ts_mov_b32 m0, %0" : "=&s"(keep) : "v"(gsrc), "s"(lds_dst) : "memory"); }
__device__ __forceinline__ unsigned cvtpk(float lo, float hi) { unsigned r; asm("v_cvt_pk_bf16_f32 %0, %1, %2" : "=v"(r) : "v"(lo), "v"(hi)); return r; }
__device__ __forceinline__ float xhalf_max(float m) { return xor32_max(m); }
__device__ __forceinline__ float xhalf_sum(float m) { return xor32_sum(m); }
__device__ __forceinline__ f32x16 qk32(const LAS unsigned char* ktile, int half, const bf16x8 (&qr)[4], int r32, int hi) {
    const LAS unsigned char* kb = ktile + (r32 + 32 * half) * 128; const int sw = (r32 >> 1) & 7;
    f32x16 p = {0.f, 0.f, 0.f, 0.f, 0.f, 0.f, 0.f, 0.f, 0.f, 0.f, 0.f, 0.f, 0.f, 0.f, 0.f, 0.f};
#pragma unroll
    for (int d0 = 0; d0 < 4; ++d0) { const bf16x8 kf = *(const LAS bf16x8*)(kb + (((2 * d0 + hi) ^ sw) << 4)); p = __builtin_amdgcn_mfma_f32_32x32x16_bf16(kf, qr[d0], p, 0, 0, 0); }
    return p;
}
typedef short v4i16_t __attribute__((ext_vector_type(4)));
__device__ __forceinline__ s16x4 vtr(const LAS unsigned char* p) { return __builtin_bit_cast(s16x4, __builtin_amdgcn_ds_read_tr16_b64_v4i16((LAS v4i16_t*)p)); }
__device__ __forceinline__ void pv32(f32x16 (&o)[2], const LAS unsigned char* vb, int half, bf16x8 pa0, bf16x8 pa1) {
#pragma unroll
    for (int d0 = 0; d0 < 2; ++d0) {
        const LAS unsigned char* p = vb + d0 * 512 + half * 4096;
        const s16x4 l0 = vtr(p), h0 = vtr(p + 1024), l1 = vtr(p + 2048), h1 = vtr(p + 3072);
        const bf16x8 v0 = {l0[0], l0[1], l0[2], l0[3], h0[0], h0[1], h0[2], h0[3]}, v1 = {l1[0], l1[1], l1[2], l1[3], h1[0], h1[1], h1[2], h1[3]};
        o[d0] = __builtin_amdgcn_mfma_f32_32x32x16_bf16(pa0, v0, o[d0], 0, 0, 0);
        o[d0] = __builtin_amdgcn_mfma_f32_32x32x16_bf16(pa1, v1, o[d0], 0, 0, 0);
    }
}
}

struct AttUnit { int br, Pc, d, nq, kcol, vcol, qcol0, token0, rot; };
__device__ __forceinline__ AttUnit att_decode(int ui) {
    AttUnit U;
    if (ui < 12) { const int a = blockIdx.x * 12 + ui, u = a & 31, h = (a >> 5) & 7, b = (a >> 8) & 3; U.br = a >> 10; U.d = (U.br == 0) ? 1 : (U.br == 1) ? 4 : 16;
        const int per = 32 / U.d, r = u / per; U.Pc = u % per; U.rot = (u & 1) ? 4 : 0; U.nq = 1; U.kcol = KA_OFF + 64 * h; U.vcol = VA_OFF + 64 * h; U.qcol0 = QA_OFF + 64 * h; U.token0 = b * S + r; }
    else { const int w = blockIdx.x, kvh = (w >> 5) & 1; U.Pc = w & 31; U.rot = 0; U.d = 1; U.br = 3; U.nq = 4; U.kcol = KB_OFF + 64 * kvh; U.vcol = VB_OFF + 64 * kvh; U.qcol0 = QB_OFF + 256 * kvh; U.token0 = (w >> 6) * S; }
    return U;
}
__device__ __forceinline__ void attn_mfma(const Ctx& C, const bf16* PROJ, bf16* OPART, float* LSE, const float* sinks) {
    using namespace att;
    const int lane = C.lane, r32 = lane & 31, hi = lane >> 5, wid = C.wave;
    LAS unsigned char* shm = C.lds;
    const unsigned lds0 = (unsigned)(uintptr_t)shm;
    LAS float* wsf = (LAS float*)(shm + LWS) + wid * 64;
    LAS bf16* stg = (LAS bf16*)(shm + LOST) + wid * 2048;
    const LAS unsigned char* vlane = shm + LV + ((lane >> 4) & 1) * 32 + (lane & 3) * 8 + (4 * hi + ((lane & 15) >> 2)) * 64;
#define ATT_ISSUE_K(U) do { const int m0k_ = 256 * (U).Pc - 128, kr_ = 8 * wid + (lane >> 3), kc_ = (lane & 7) ^ ((kr_ >> 1) & 7); _Pragma("unroll") for (int T = 0; T < 6; ++T) { if ((U).rot && T < 2) continue; int mk = m0k_ + 64 * T + kr_; mk = mk < 0 ? 0 : mk; const int sl_ = (T + (U).rot) % 6; \
        glds16(PROJ + (size_t)((U).token0 + (U).d * mk) * INW + (U).kcol + kc_ * 8, (unsigned)__builtin_amdgcn_readfirstlane(lds0 + LK + sl_ * 8192 + wid * 1024)); } } while (0)
#define ATT_ISSUE_V(U) do { const int m0k_ = 256 * (U).Pc - 128; _Pragma("unroll") for (int T = 0; T < 6; ++T) { if ((U).rot && T < 2) continue; int mv = m0k_ + 64 * T + 8 * wid + ((lane >> 2) & 7); mv = mv < 0 ? 0 : mv; const int sl_ = (T + (U).rot) % 6; \
        glds16(PROJ + (size_t)((U).token0 + (U).d * mv) * INW + (U).vcol + (lane >> 5) * 32 + (lane & 3) * 8, (unsigned)__builtin_amdgcn_readfirstlane(lds0 + LV + sl_ * 8192 + wid * 1024)); } } while (0)
#define ATT_LOAD_Q(U, hq, dst) do { const bf16* Qrow_ = PROJ + (size_t)((U).token0 + (U).d * (256 * (U).Pc + 32 * wid + r32)) * INW + (U).qcol0 + 64 * (hq); \
        _Pragma("unroll") for (int d0 = 0; d0 < 4; ++d0) dst[d0] = *(const GAS bf16x8*)(Qrow_ + d0 * 16 + hi * 8); } while (0)
    bf16x8 qr[4];
    { const AttUnit U0 = att_decode(0); ATT_ISSUE_K(U0); ATT_LOAD_Q(U0, 0, qr);
      asm volatile("s_waitcnt vmcnt(0)" ::: "memory"); __builtin_amdgcn_s_barrier(); asm volatile("" ::: "memory");
      ATT_ISSUE_V(U0); }
#pragma unroll 1
    for (int ui = 0; ui < 13; ++ui) {
        const AttUnit U = att_decode(ui);
        const int Pc = U.Pc, br = U.br, d = U.d, token0 = U.token0, qcol0 = U.qcol0;
#pragma unroll 1
        for (int hq = 0; hq < U.nq; ++hq) {
            if (hq > 0) ATT_LOAD_Q(U, hq, qr);
            const int qm = 256 * Pc + 32 * wid + r32;
            f32x16 sc[5];
#pragma unroll
            for (int kb = 0; kb < 5; ++kb) {
                const int j0 = 32 * wid + 32 * kb;
                if (Pc == 0 && j0 < 128) { sc[kb] = (f32x16){-INFINITY, -INFINITY, -INFINITY, -INFINITY, -INFINITY, -INFINITY, -INFINITY, -INFINITY, -INFINITY, -INFINITY, -INFINITY, -INFINITY, -INFINITY, -INFINITY, -INFINITY, -INFINITY}; }
                else sc[kb] = qk32(shm + LK + (((j0 >> 6) + U.rot) % 6) * 8192, (j0 >> 5) & 1, qr, r32, hi);
            }
            const int lowlim = r32 + (br == 3 ? 1 : 0);
#pragma unroll
            for (int rr = 0; rr < 16; ++rr) { const int c = crow(rr, hi); if (c < lowlim) sc[0][rr] = -INFINITY; if (c > r32) sc[4][rr] = -INFINITY; }
            float mx = -INFINITY;
#pragma unroll
            for (int kb = 0; kb < 5; ++kb)
#pragma unroll
                for (int rr = 0; rr < 16; ++rr) mx = fmaxf(mx, sc[kb][rr]);
            mx = xhalf_max(mx);
            float sk2 = 0.f;
            if (br == 3) { sk2 = sinks[(qcol0 - QB_OFF) / 64 + hq] * LOG2E; mx = fmaxf(mx, sk2); }
            float l = 0.f;
#pragma unroll
            for (int kb = 0; kb < 5; ++kb)
#pragma unroll
                for (int rr = 0; rr < 16; ++rr) { const float p = __builtin_amdgcn_exp2f(sc[kb][rr] - mx); sc[kb][rr] = p; l += p; }
            l = xhalf_sum(l);
            if (br == 3) l += __builtin_amdgcn_exp2f(sk2 - mx);
            if (hq == 0) {
                asm volatile("s_waitcnt vmcnt(0)" ::: "memory"); __builtin_amdgcn_s_barrier(); asm volatile("" ::: "memory");
                if (U.nq == 1 && ui + 1 < 13) { const AttUnit Un = att_decode(ui + 1); ATT_ISSUE_K(Un); ATT_LOAD_Q(Un, 0, qr); }
            }
            f32x16 o[2];
#pragma unroll
            for (int i = 0; i < 16; ++i) { o[0][i] = 0.f; o[1][i] = 0.f; }
#pragma unroll
            for (int kb = 0; kb < 5; ++kb) {
                const int j0 = 32 * wid + 32 * kb;
                if (!(Pc == 0 && j0 < 128)) {
                    u32x4 w0, w1;
                    w0.x = cvtpk(sc[kb][0], sc[kb][1]); w0.y = cvtpk(sc[kb][2], sc[kb][3]); w0.z = cvtpk(sc[kb][4], sc[kb][5]); w0.w = cvtpk(sc[kb][6], sc[kb][7]);
                    w1.x = cvtpk(sc[kb][8], sc[kb][9]); w1.y = cvtpk(sc[kb][10], sc[kb][11]); w1.z = cvtpk(sc[kb][12], sc[kb][13]); w1.w = cvtpk(sc[kb][14], sc[kb][15]);
                    pv32(o, vlane + (((j0 >> 6) + U.rot) % 6) * 8192, (j0 >> 5) & 1, __builtin_bit_cast(bf16x8, w0), __builtin_bit_cast(bf16x8, w1));
                }
            }
            if (hi == 0) wsf[r32] = l;
            asm volatile("s_waitcnt lgkmcnt(0)" ::: "memory");
#pragma unroll
            for (int rr = 0; rr < 16; ++rr) { const int orow = crow(rr, hi); const float rl = __builtin_amdgcn_rcpf(wsf[orow]);
                stg[orow * 64 + r32] = (bf16)f2bf(o[0][rr] * rl); stg[orow * 64 + 32 + r32] = (bf16)f2bf(o[1][rr] * rl); }
            asm volatile("s_waitcnt lgkmcnt(0)" ::: "memory");
            const int hcol = (br == 3) ? (qcol0 - QB_OFF) + 64 * hq : (qcol0 - QA_OFF);
            bf16* Ob = OPART + ((size_t)br * M) * 512 + hcol;
            if (br < 3 && hi == 0) LSE[((size_t)br * M + (token0 + d * qm)) * 8 + (qcol0 - QA_OFF) / 64] = mx + __builtin_amdgcn_logf(l);
#pragma unroll
            for (int i = 0; i < 4; ++i) { const int row = i * 8 + (lane >> 3), ch = lane & 7; const v4u v = *(const LAS v4u*)(stg + row * 64 + ch * 8);
                const int tok = token0 + d * (256 * Pc + 32 * wid + row);
                *(GAS v4u*)(Ob + (size_t)tok * 512 + ch * 8) = v; }
            asm volatile("s_waitcnt lgkmcnt(0)" ::: "memory");
        }
        if (ui + 1 < 13) {
            asm volatile("s_waitcnt vmcnt(4)" : "+v"(qr[0]), "+v"(qr[1]), "+v"(qr[2]), "+v"(qr[3]) :: "memory"); __builtin_amdgcn_s_barrier(); asm volatile("" ::: "memory");
            const AttUnit Un = att_decode(ui + 1); ATT_ISSUE_V(Un);
        }
    }
    asm volatile("s_waitcnt vmcnt(0) lgkmcnt(0)" ::: "memory"); __builtin_amdgcn_s_barrier(); asm volatile("" ::: "memory");
#undef ATT_ISSUE_K
#undef ATT_ISSUE_V
#undef ATT_LOAD_Q
}

__device__ __forceinline__ void ld8bf(const bf16* p, float (&v)[8]) {
    const v4u a = *(const GAS v4u*)p;
    v[0] = bflo(a.x); v[1] = bfhi(a.x); v[2] = bflo(a.y); v[3] = bfhi(a.y); v[4] = bflo(a.z); v[5] = bfhi(a.z); v[6] = bflo(a.w); v[7] = bfhi(a.w);
}
__device__ __forceinline__ void unpack8(const v4u a, float (&v)[8]) {
    v[0] = bflo(a.x); v[1] = bfhi(a.x); v[2] = bflo(a.y); v[3] = bfhi(a.y); v[4] = bflo(a.z); v[5] = bfhi(a.z); v[6] = bflo(a.w); v[7] = bfhi(a.w);
}
constexpr int UNR = 4;
__device__ __forceinline__ void combine_phase(const Ctx& C, const bf16* OPART, const float* LSE, const float* gna, const float* gnb, bf16* MIX) {
    const int h = C.lane >> 3;
    float ga[8], gb[8];
#pragma unroll
    for (int i = 0; i < 8; ++i) { ga[i] = gna[8 * C.lane + i]; gb[i] = gnb[8 * C.lane + i]; }
    for (int row0 = C.gw; row0 < M; row0 += UNR * C.ngw) {
        v4u q0[UNR], q1[UNR], q2[UNR], q3[UNR]; float l0[UNR], l1[UNR], l2[UNR];
#pragma unroll
        for (int k = 0; k < UNR; ++k) { const int row = row0 + k * C.ngw;
            l0[k] = LSE[((size_t)0 * M + row) * 8 + h]; l1[k] = LSE[((size_t)1 * M + row) * 8 + h]; l2[k] = LSE[((size_t)2 * M + row) * 8 + h];
            q0[k] = *(const GAS v4u*)(OPART + ((size_t)0 * M + row) * 512 + 8 * C.lane); q1[k] = *(const GAS v4u*)(OPART + ((size_t)1 * M + row) * 512 + 8 * C.lane);
            q2[k] = *(const GAS v4u*)(OPART + ((size_t)2 * M + row) * 512 + 8 * C.lane); q3[k] = *(const GAS v4u*)(OPART + ((size_t)3 * M + row) * 512 + 8 * C.lane); }
#pragma unroll
        for (int k = 0; k < UNR; ++k) { const int row = row0 + k * C.ngw;
            const float mx = fmaxf(l0[k], fmaxf(l1[k], l2[k]));
            float w0 = __builtin_amdgcn_exp2f(l0[k] - mx), w1 = __builtin_amdgcn_exp2f(l1[k] - mx), w2 = __builtin_amdgcn_exp2f(l2[k] - mx);
            const float inv = 1.0f / (w0 + w1 + w2); w0 *= inv; w1 *= inv; w2 *= inv;
            float a0[8], a1[8], a2[8], b[8]; unpack8(q0[k], a0); unpack8(q1[k], a1); unpack8(q2[k], a2); unpack8(q3[k], b);
            float sa = 0.f, sb = 0.f;
#pragma unroll
            for (int i = 0; i < 8; ++i) { a0[i] = w0 * a0[i] + w1 * a1[i] + w2 * a2[i]; sa += a0[i] * a0[i]; sb += b[i] * b[i]; }
            sa = wave_sum(sa); sb = wave_sum(sb);
            const float ra = __builtin_amdgcn_rsqf(sa * (1.0f / 512.0f) + EPS), rb = __builtin_amdgcn_rsqf(sb * (1.0f / 512.0f) + EPS);
            v4u oa, ob;
            oa.x = pk2(a0[0] * ra * ga[0], a0[1] * ra * ga[1]); oa.y = pk2(a0[2] * ra * ga[2], a0[3] * ra * ga[3]); oa.z = pk2(a0[4] * ra * ga[4], a0[5] * ra * ga[5]); oa.w = pk2(a0[6] * ra * ga[6], a0[7] * ra * ga[7]);
            ob.x = pk2(b[0] * rb * gb[0], b[1] * rb * gb[1]); ob.y = pk2(b[2] * rb * gb[2], b[3] * rb * gb[3]); ob.z = pk2(b[4] * rb * gb[4], b[5] * rb * gb[5]); ob.w = pk2(b[6] * rb * gb[6], b[7] * rb * gb[7]);
            *(GAS v4u*)(MIX + (size_t)row * D + 8 * C.lane) = oa; *(GAS v4u*)(MIX + (size_t)row * D + 512 + 8 * C.lane) = ob; }
    }
}

#define COLQ(lane, q) (8 * (lane) + 512 * ((q) >> 1) + 4 * ((q) & 1))
__device__ __forceinline__ void row_load(const float* p, int lane, f32x4 (&v)[4]) {
#pragma unroll
    for (int j = 0; j < 4; ++j) v[j] = *(const GAS f32x4*)(p + COLQ(lane, j));
}
__device__ __forceinline__ float row_ssq(const f32x4 (&v)[4]) {
    float s = 0.f;
#pragma unroll
    for (int j = 0; j < 4; ++j) s += (v[j][0] * v[j][0] + v[j][1] * v[j][1]) + (v[j][2] * v[j][2] + v[j][3] * v[j][3]);
    return wave_sum(s);
}
__device__ __forceinline__ void row_store_bf16(bf16* p, int lane, const f32x4 (&v)[4]) {
#pragma unroll
    for (int j = 0; j < 2; ++j) { v4u w; w.x = pk2(v[2 * j][0], v[2 * j][1]); w.y = pk2(v[2 * j][2], v[2 * j][3]); w.z = pk2(v[2 * j + 1][0], v[2 * j + 1][1]); w.w = pk2(v[2 * j + 1][2], v[2 * j + 1][3]); *(GAS v4u*)(p + 8 * lane + 512 * j) = w; }
}
__device__ __forceinline__ void row_load_bf16(const bf16* p, int lane, f32x4 (&v)[4]) {
#pragma unroll
    for (int j = 0; j < 2; ++j) { const v4u a = *(const GAS v4u*)(p + 8 * lane + 512 * j); v[2 * j][0] = bflo(a.x); v[2 * j][1] = bfhi(a.x); v[2 * j][2] = bflo(a.y); v[2 * j][3] = bfhi(a.y);
        v[2 * j + 1][0] = bflo(a.z); v[2 * j + 1][1] = bfhi(a.z); v[2 * j + 1][2] = bflo(a.w); v[2 * j + 1][3] = bfhi(a.w); }
}
__device__ __forceinline__ void xn_rows(const Ctx& C, const float* x, bf16* XN, float* ssq) {
    for (int row0 = C.gw; row0 < M; row0 += UNR * C.ngw) {
        f32x4 v[UNR][4];
#pragma unroll
        for (int k = 0; k < UNR; ++k) row_load(x + (size_t)(row0 + k * C.ngw) * D, C.lane, v[k]);
#pragma unroll
        for (int k = 0; k < UNR; ++k) { const int row = row0 + k * C.ngw;
            const float s = row_ssq(v[k]);
            row_store_bf16(XN + (size_t)row * D, C.lane, v[k]);
            if (C.lane < 16) ssq[(size_t)row * 16 + C.lane] = (C.lane == 0) ? s : 0.f; }
    }
}

struct Route { int e0, e1; float g0, g1, rs; int p0, p1, pad; };
__device__ __forceinline__ void router_phase(const Ctx& C, const bf16* x1, const float* router, const float* gain, Route* RT, int* blkcnt) {
    LAS float* GRt = (LAS float*)(C.lds + RING_OFF);
    LAS unsigned* tokE = (LAS unsigned*)(C.lds + RING_OFF + 32768);
    for (int i = C.tid; i < 1024 * 8; i += 512) { const int c = i >> 3, e = i & 7; GRt[e * 1024 + c] = router[i] * gain[c]; }
    __syncthreads();
    const int tok0 = blockIdx.x * 128 + C.wave * 16;
#pragma unroll 1
    for (int tt = 0; tt < 16; tt += UNR) {
        f32x4 v[UNR][4];
#pragma unroll
        for (int k = 0; k < UNR; ++k) row_load_bf16(x1 + (size_t)(tok0 + tt + k) * D, C.lane, v[k]);
        float ss[UNR], lg[UNR][8];
#pragma unroll
        for (int k = 0; k < UNR; ++k) { ss[k] = 0.f;
#pragma unroll
            for (int e = 0; e < 8; ++e) lg[k][e] = 0.f; }
#pragma unroll
        for (int j = 0; j < 4; ++j) {
#pragma unroll
            for (int k = 0; k < UNR; ++k) ss[k] += (v[k][j][0] * v[k][j][0] + v[k][j][1] * v[k][j][1]) + (v[k][j][2] * v[k][j][2] + v[k][j][3] * v[k][j][3]);
#pragma unroll
            for (int e = 0; e < 8; ++e) { const f32x4 r = *(const LAS f32x4*)(GRt + e * 1024 + COLQ(C.lane, j));
#pragma unroll
                for (int k = 0; k < UNR; ++k) lg[k][e] += (v[k][j][0] * r[0] + v[k][j][1] * r[1]) + (v[k][j][2] * r[2] + v[k][j][3] * r[3]); } }
#pragma unroll
        for (int k = 0; k < UNR; ++k) {
            const int tok = tok0 + tt + k;
            const float sk = wave_sum(ss[k]);
            const float rs = __builtin_amdgcn_rsqf(sk * (1.0f / D) + EPS);
            float l8[8];
#pragma unroll
            for (int e = 0; e < 8; ++e) l8[e] = wave_sum(lg[k][e]) * rs;
            int e0 = 0; float v0 = l8[0];
#pragma unroll
            for (int e = 1; e < 8; ++e) if (l8[e] > v0) { v0 = l8[e]; e0 = e; }
            int e1 = -1; float v1 = -INFINITY;
#pragma unroll
            for (int e = 0; e < 8; ++e) if (e != e0 && l8[e] > v1) { v1 = l8[e]; e1 = e; }
            const float ex = __expf(v1 - v0), g0 = 1.0f / (1.0f + ex), g1 = ex * g0;
            if (C.lane == 0) { Route r; r.e0 = e0; r.e1 = e1; r.g0 = g0; r.g1 = g1; r.rs = rs; r.p0 = 0; r.p1 = 0; r.pad = 0; RT[tok] = r; tokE[C.wave * 16 + tt + k] = (unsigned)e0 | ((unsigned)e1 << 8); }
        }
    }
    __syncthreads();
    if (C.tid < 8) { int cnt = 0; for (int t = 0; t < 128; ++t) { const unsigned w = tokE[t]; cnt += ((w & 255u) == (unsigned)C.tid) + ((w >> 8) == (unsigned)C.tid); } blkcnt[blockIdx.x * 8 + C.tid] = cnt; }
    __syncthreads();
}
__device__ __forceinline__ void scatter_phase(const Ctx& C, const bf16* x1, const float* gain, Route* RT, const int* blkcnt, bf16* AP, float* rowgate, volatile LAS int* SEGB) {
    LAS int* LTOT = (LAS int*)(C.lds + RING_OFF);
    LAS int* LPRE = LTOT + 8;
    LAS unsigned* tokE = (LAS unsigned*)(LTOT + 16);
    LAS int* POS = (LAS int*)(LTOT + 16 + 128);
    { const int e = C.wave; int st = 0, sp = 0;
#pragma unroll
      for (int j = 0; j < 4; ++j) { const int b = C.lane + 64 * j; const int c = blkcnt[b * 8 + e]; st += c; if (b < (int)blockIdx.x) sp += c; }
      st = wave_sum_i(st); sp = wave_sum_i(sp);
      if (C.lane == 0) { LTOT[e] = st; LPRE[e] = sp; } }
    if (C.tid < 128) { const Route r = RT[blockIdx.x * 128 + C.tid]; tokE[C.tid] = (unsigned)r.e0 | ((unsigned)r.e1 << 8); }
    __syncthreads();
    if (C.tid == 0) { int base = 0; for (int e = 0; e < 8; ++e) { SEGB[e] = base; base += (LTOT[e] + 255) & ~255; } SEGB[8] = base; }
    __syncthreads();
    if (C.tid < 8) { const int e = C.tid; int run = SEGB[e] + LPRE[e];
        for (int t = 0; t < 128; ++t) { const unsigned w = tokE[t]; if ((int)(w & 255u) == e) POS[2 * t] = run++; if ((int)(w >> 8) == e) POS[2 * t + 1] = run++; } }
    __syncthreads();
    float gn[4][4];
#pragma unroll
    for (int j = 0; j < 4; ++j) { const f32x4 g = *(const GAS f32x4*)(gain + COLQ(C.lane, j)); gn[j][0] = g[0]; gn[j][1] = g[1]; gn[j][2] = g[2]; gn[j][3] = g[3]; }
#pragma unroll 1
    for (int tt = 0; tt < 16; tt += UNR) {
        f32x4 v[UNR][4]; Route r[UNR];
#pragma unroll
        for (int k = 0; k < UNR; ++k) { const int tok = blockIdx.x * 128 + C.wave * 16 + tt + k; r[k] = RT[tok]; row_load_bf16(x1 + (size_t)tok * D, C.lane, v[k]); }
#pragma unroll
        for (int k = 0; k < UNR; ++k) { const int tl = C.wave * 16 + tt + k, tok = blockIdx.x * 128 + tl;
            const int p0 = POS[2 * tl], p1 = POS[2 * tl + 1];
            if (C.lane == 0) { RT[tok].p0 = p0; RT[tok].p1 = p1; rowgate[p0] = r[k].g0; rowgate[p1] = r[k].g1; }
#pragma unroll
            for (int j = 0; j < 4; ++j) { v[k][j][0] *= r[k].rs * gn[j][0]; v[k][j][1] *= r[k].rs * gn[j][1]; v[k][j][2] *= r[k].rs * gn[j][2]; v[k][j][3] *= r[k].rs * gn[j][3]; }
            row_store_bf16(AP + (size_t)p0 * D, C.lane, v[k]); row_store_bf16(AP + (size_t)p1 * D, C.lane, v[k]); }
    }
    if (blockIdx.x < 8) { const int e = blockIdx.x; const int lo = SEGB[e] + LTOT[e], hi = SEGB[e + 1];
        for (int rr = lo + C.wave; rr < hi; rr += NWAVES) {
#pragma unroll
            for (int j = 0; j < 2; ++j) { v4u z; z.x = 0u; z.y = 0u; z.z = 0u; z.w = 0u; *(GAS v4u*)(AP + (size_t)rr * D + 8 * C.lane + 512 * j) = z; }
            if (C.lane == 0) rowgate[rr] = 0.f; } }
    __syncthreads();
}
__device__ __forceinline__ void moe_tail_row(const bf16* PTp, int p, float gate, int lane, u32x2v (&y)[4]) {
    f32x4 t[4];
#pragma unroll
    for (int j = 0; j < 4; ++j) t[j] = (f32x4){0.f, 0.f, 0.f, 0.f};
#pragma unroll 1
    for (int s = 0; s < KSPLIT; ++s) {
#pragma unroll
        for (int j = 0; j < 2; ++j) { const v4u a = *(const GAS v4u*)(PTp + ((size_t)s * TAILROWS + (p - MAINROWS)) * D + 8 * lane + 512 * j);
            t[2 * j][0] += bflo(a.x); t[2 * j][1] += bfhi(a.x); t[2 * j][2] += bflo(a.y); t[2 * j][3] += bfhi(a.y);
            t[2 * j + 1][0] += bflo(a.z); t[2 * j + 1][1] += bfhi(a.z); t[2 * j + 1][2] += bflo(a.w); t[2 * j + 1][3] += bfhi(a.w); } }
#pragma unroll
    for (int j = 0; j < 4; ++j) { y[j].x = pk2(t[j][0] * gate, t[j][1] * gate); y[j].y = pk2(t[j][2] * gate, t[j][3] * gate); }
}
__device__ __forceinline__ void moe_combine(const Ctx& C, float* xout, const Route* RT, const bf16* Y, const bf16* PTp, bf16* XN, float* ssq, const float* final_gain) {
    for (int row0 = C.gw; row0 < M; row0 += UNR * C.ngw) {
        int p0[UNR], p1[UNR]; float g0[UNR], g1[UNR];
#pragma unroll
        for (int k = 0; k < UNR; ++k) { const Route rt = RT[row0 + k * C.ngw]; p0[k] = rt.p0; p1[k] = rt.p1; g0[k] = rt.g0; g1[k] = rt.g1; }
        u32x2v xr[UNR][4], ya[UNR][4], yb[UNR][4];
#pragma unroll
        for (int k = 0; k < UNR; ++k)
#pragma unroll
            for (int j = 0; j < 2; ++j) { const v4u x_ = *(const GAS v4u*)(XN + (size_t)(row0 + k * C.ngw) * D + 8 * C.lane + 512 * j);
                const v4u a_ = *(const GAS v4u*)(Y + (size_t)p0[k] * D + 8 * C.lane + 512 * j), b_ = *(const GAS v4u*)(Y + (size_t)p1[k] * D + 8 * C.lane + 512 * j);
                xr[k][2 * j].x = x_.x; xr[k][2 * j].y = x_.y; xr[k][2 * j + 1].x = x_.z; xr[k][2 * j + 1].y = x_.w;
                ya[k][2 * j].x = a_.x; ya[k][2 * j].y = a_.y; ya[k][2 * j + 1].x = a_.z; ya[k][2 * j + 1].y = a_.w;
                yb[k][2 * j].x = b_.x; yb[k][2 * j].y = b_.y; yb[k][2 * j + 1].x = b_.z; yb[k][2 * j + 1].y = b_.w; }
#pragma unroll
        for (int k = 0; k < UNR; ++k) { const int row = row0 + k * C.ngw;
            if (p0[k] >= MAINROWS) moe_tail_row(PTp, p0[k], g0[k], C.lane, ya[k]);
            if (p1[k] >= MAINROWS) moe_tail_row(PTp, p1[k], g1[k], C.lane, yb[k]);
            f32x4 v[4];
#pragma unroll
            for (int j = 0; j < 4; ++j) { v[j][0] = bflo(xr[k][j].x) + bflo(ya[k][j].x) + bflo(yb[k][j].x); v[j][1] = bfhi(xr[k][j].x) + bfhi(ya[k][j].x) + bfhi(yb[k][j].x);
                v[j][2] = bflo(xr[k][j].y) + bflo(ya[k][j].y) + bflo(yb[k][j].y); v[j][3] = bfhi(xr[k][j].y) + bfhi(ya[k][j].y) + bfhi(yb[k][j].y); }
            const float s = row_ssq(v);
            if (final_gain) {
                const float rs = __builtin_amdgcn_rsqf(s * (1.0f / D) + EPS);
#pragma unroll
                for (int j = 0; j < 4; ++j) { const f32x4 g = *(const GAS f32x4*)(final_gain + COLQ(C.lane, j)); *(GAS f32x4*)(xout + (size_t)row * D + COLQ(C.lane, j)) = v[j] * rs * g; }
            } else {
                row_store_bf16(XN + (size_t)row * D, C.lane, v);
                if (C.lane < 16) ssq[(size_t)row * 16 + C.lane] = (C.lane == 0) ? s : 0.f;
            } }
    }
}

struct Args { const void* in[17]; float* out; unsigned char* ws; };
__global__ void __launch_bounds__(NWAVES * 64, 2) trunk_fwd(Args args) {
    extern __shared__ __attribute__((aligned(16))) unsigned char lds[];
    const int G = gridDim.x;
    const int wave_s = __builtin_amdgcn_readfirstlane(threadIdx.x >> 6);
#define TIDX() ({ unsigned z_ = 0u; asm volatile("" : "+v"(z_)); wave_s * 64 + (int)__builtin_amdgcn_mbcnt_hi(~0u, __builtin_amdgcn_mbcnt_lo(~0u, z_)); })
#define MKCTX() Ctx C; { int t_ = TIDX(); C.lds = (LAS unsigned char*)lds; C.tid = t_; C.lane = t_ & 63; C.wave = __builtin_amdgcn_readfirstlane(t_ >> 6); C.gw = blockIdx.x * NWAVES + C.wave; C.ngw = G * NWAVES; } \
    GAS unsigned char* wsl = (GAS unsigned char*)ws; int bid = blockIdx.x; asm volatile("" : "+s"(wsl), "+s"(bid));
    LAS unsigned char* const ldsb = (LAS unsigned char*)lds;
    volatile LAS unsigned* MISC = (volatile LAS unsigned*)(ldsb + MISC_OFF);
    volatile LAS int* SEGB = (volatile LAS int*)(ldsb + MISC_OFF + 64);
    unsigned char* ws = args.ws;
    gu32* ctl = (gu32*)(ws + WS_CTL);
    for (int u = threadIdx.x; u < (LDS_BYTES - LDSCTL_OFF) / 4; u += NWAVES * 64) ((LAS unsigned*)(ldsb + LDSCTL_OFF))[u] = 0u;
    __syncthreads();
    XcdBarrier bar = xcd_barrier_post((unsigned*)(ctl + CW_BAR), MISC + 8, (int)threadIdx.x);
#define GRID_BAR_RAW() do { XcdBarrier b_ = bar; GAS unsigned* p_ = (GAS unsigned*)bar.bar; asm volatile("" : "+s"(b_.x), "+s"(p_)); b_.bar = (unsigned*)p_; xcd_barrier(b_, TIDX()); } while (0)
#if PROBE_T
#define TBEG(id) do { if ((id) == PROBE_T && blockIdx.x == 0 && TIDX() == 0) MISC[33] = (unsigned)__builtin_amdgcn_s_memrealtime(); } while (0)
#define TEND(id) do { if ((id) == PROBE_T && blockIdx.x == 0 && TIDX() == 0) MISC[32] = MISC[32] + ((unsigned)__builtin_amdgcn_s_memrealtime() - MISC[33]); } while (0)
#else
#define TBEG(id) do {} while (0)
#define TEND(id) do {} while (0)
#endif
#define GRID_BAR() do { TBEG(1); GRID_BAR_RAW(); TEND(1); } while (0)

    const float* x_in = (const float*)args.in[0]; const int* positions = (const int*)args.in[1];
    const float* attn_norm = (const float*)args.in[2]; const float* w_in = (const float*)args.in[3];
    const float* mix_norm_a = (const float*)args.in[4]; const float* mix_norm_b = (const float*)args.in[5];
    const float* sinks = (const float*)args.in[6]; const float* w_out = (const float*)args.in[7];
    const float* ffn_norm = (const float*)args.in[8]; const float* dwg = (const float*)args.in[9];
    const float* dwu = (const float*)args.in[10]; const float* dwd = (const float*)args.in[11];
    const float* router = (const float*)args.in[12]; const float* mwg = (const float*)args.in[13];
    const float* mwu = (const float*)args.in[14]; const float* mwd = (const float*)args.in[15];
    const float* final_norm = (const float*)args.in[16];
    float* xout = args.out;
#define ROPE ((float*)(GAS float*)(wsl + WS_ROPE))
#define SSQA ((float*)(GAS float*)(wsl + WS_SSQA))
#define SSQF ((float*)(GAS float*)(wsl + WS_SSQF))
#define RT ((Route*)(GAS Route*)(wsl + WS_ROUTE))
#define BLKCNT ((int*)(GAS int*)(wsl + WS_BLKCNT))
#define ROWGATE ((float*)(GAS float*)(wsl + WS_ROWGATE))
#define WIN ((bf16*)(GAS bf16*)(wsl + WS_WIN))
#define WOUT ((bf16*)(GAS bf16*)(wsl + WS_WOUT))
#define WGU ((bf16*)(GAS bf16*)(wsl + WS_WGU))
#define WDN ((bf16*)(GAS bf16*)(wsl + WS_WDN))
#define MGU ((bf16*)(GAS bf16*)(wsl + WS_MGU))
#define MDN ((bf16*)(GAS bf16*)(wsl + WS_MDN))
#define XN ((bf16*)(GAS bf16*)(wsl + WS_XN))
#define PROJ ((bf16*)(GAS bf16*)(wsl + WS_PROJ))
#define OPART ((bf16*)(GAS bf16*)(wsl + WS_OPART))
#define LSE ((float*)(GAS float*)(wsl + WS_LSE))
#define MIX ((bf16*)(GAS bf16*)(wsl + WS_MIX))
#define HB ((bf16*)(GAS bf16*)(wsl + WS_H))
#define AP ((bf16*)(GAS bf16*)(wsl + WS_AP))
#define PT ((bf16*)(GAS bf16*)(wsl + WS_PT))

    TBEG(2);
    { MKCTX();
    { ConvSrc S{w_in, w_out, attn_norm, ffn_norm, dwg, dwu, dwd, WIN, WOUT, WGU, WDN}; convert_prologue(C, S); }
    convert_moe_layer(C, mwg, mwu, mwd, MGU, MDN);
    for (int i = blockIdx.x * 512 + C.tid; i < S * 32; i += G * 512) {
        const int s = i >> 5, f = i & 31;
        const float inv = __builtin_amdgcn_exp2f(-(float)f * (13.287712379549449f / 32.0f));
        const float ang = (float)positions[s] * inv;
        const double rev = (double)ang * 0.15915494309189535; const float fr = (float)(rev - __builtin_rint(rev));
        ROPE[i] = __builtin_amdgcn_cosf(fr); ROPE[S * 32 + i] = __builtin_amdgcn_sinf(fr);
    }
    xn_rows(C, x_in, XN, SSQA); }
    TEND(2);
    GRID_BAR();

#pragma unroll 1
    for (int l = 0; l < DEPTH; ++l) {
        TBEG(3);
        { MKCTX(); pg8::Gemm g{XN, WIN + (size_t)l * INW * D, M, INW, D, 0, D}; pg8::StaticOrder So; So.init(M, INW, G, bid);
          pg8::EpiRope E{PROJ, SSQA, ROPE};
          pg8::gemm_phase<pg8::EpiRope, pg8::StaticOrder, true, true>(C.lds + RING_OFF, g, So, E, C.tid);
        }
        TEND(3);
        GRID_BAR();
        TBEG(4);
        { MKCTX(); attn_mfma(C, PROJ, OPART, LSE, sinks + l * 8); }
        TEND(4);
        GRID_BAR();
        TBEG(5);
        { MKCTX(); combine_phase(C, OPART, LSE, mix_norm_a + l * 512, mix_norm_b + l * 512, MIX); }
        TEND(5);
        GRID_BAR();
        TBEG(6);
        { MKCTX(); pg8::Gemm g{MIX, WOUT + (size_t)l * D * D, M, D, D, 0, D}; pg8::StaticOrder So; So.init(M, D, G, bid);
          pg8::EpiResid E{XN, SSQF};
          pg8::gemm_phase<pg8::EpiResid, pg8::StaticOrder, true, true>(C.lds + RING_OFF, g, So, E, C.tid); }
        TEND(6);
        GRID_BAR();
        if ((l & 1) == 0) {
            const int j = l >> 1;
            TBEG(7);
            { MKCTX(); pg8::Gemm g{XN, WGU + (size_t)j * 2 * FF * D, M, 2 * FF, D, 0, D}; pg8::StaticOrder So; So.init(M, 2 * FF, G, bid);
              pg8::EpiSwiglu<true> E{HB, SSQF};
              pg8::gemm_phase<pg8::EpiSwiglu<true>, pg8::StaticOrder, true, true>(C.lds + RING_OFF, g, So, E, C.tid);
            }
            TEND(7);
            GRID_BAR();
            TBEG(8);
            { MKCTX(); pg8::Gemm g{HB, WDN + (size_t)j * D * FF, M, D, FF, 0, FF}; pg8::StaticOrder So; So.init(M, D, G, bid);
              pg8::EpiResid E{XN, SSQA};
              pg8::gemm_phase<pg8::EpiResid, pg8::StaticOrder, true, true>(C.lds + RING_OFF, g, So, E, C.tid); }
            TEND(8);
            GRID_BAR();
        } else {
            const int j = l >> 1;
            TBEG(9);
            { MKCTX(); router_phase(C, XN, router + (size_t)j * D * NE, ffn_norm + l * D, RT, BLKCNT); }
            TEND(9);
            GRID_BAR();
            TBEG(10);
            { MKCTX(); scatter_phase(C, XN, ffn_norm + l * D, RT, BLKCNT, AP, ROWGATE, SEGB); }
            TEND(10);
            GRID_BAR();
            const int nrows = SEGB[8];
            TBEG(11);
            { MKCTX(); pg8::Gemm g{AP, MGU, nrows, 2 * FF, D, (size_t)2 * FF * D * 2, D}; pg8::GroupedOrder So; So.init(nrows, 2 * FF, G, bid); So.segb = (const LAS int*)(C.lds + MISC_OFF + 64);
              pg8::EpiSwiglu<false> E{HB, nullptr};
              pg8::gemm_phase<pg8::EpiSwiglu<false>, pg8::GroupedOrder, true, true>(C.lds + RING_OFF, g, So, E, C.tid);
            }
            TEND(11);
            GRID_BAR();
            TBEG(12);
            { MKCTX(); const int nmain = nrows < MAINROWS ? nrows : MAINROWS;
              pg8::Gemm g{HB, MDN, nmain, D, FF, (size_t)D * FF * 2, FF}; pg8::GroupedOrder So; So.init(nmain, D, G, bid); So.segb = (const LAS int*)(C.lds + MISC_OFF + 64);
              pg8::EpiY E{AP, ROWGATE};
              pg8::gemm_phase<pg8::EpiY, pg8::GroupedOrder, true, true>(C.lds + RING_OFF, g, So, E, C.tid);
              pg8::Gemm gt{HB, MDN, nrows, D, FF / KSPLIT, (size_t)D * FF * 2, FF}; pg8::TailOrder St; St.npair = (nrows - nmain) / 256 * 4; St.G = G; St.c = bid; St.segb = (const LAS int*)(C.lds + MISC_OFF + 64);
              pg8::EpiPart Ep{PT};
              pg8::gemm_phase<pg8::EpiPart, pg8::TailOrder, true, true>(C.lds + RING_OFF, gt, St, Ep, C.tid);
            }
            TEND(12);
            GRID_BAR();
            TBEG(13);
            { MKCTX(); moe_combine(C, xout, RT, AP, PT, XN, SSQA, l == DEPTH - 1 ? final_norm : nullptr);
            if (l == 1) convert_moe_layer(C, mwg + (size_t)NE * D * FF, mwu + (size_t)NE * D * FF, mwd + (size_t)NE * FF * D, MGU, MDN); }
            TEND(13);
            if (l != DEPTH - 1) GRID_BAR();
        }
    }
#if PROBE_T == 200
    for (int i_ = 0; i_ < 20; ++i_) GRID_BAR_RAW();
#endif
#if PROBE_T
    if (blockIdx.x == 0 && TIDX() == 0) { const unsigned long long t0 = __builtin_amdgcn_s_memrealtime(); const unsigned long long dt = MISC[32];
        while (__builtin_amdgcn_s_memrealtime() - t0 < dt) __builtin_amdgcn_s_sleep(8); }
#endif
}

extern "C" void kernel_launch(void* const* d_in, const int* in_sizes, int n_in, void* d_out, int out_size, void* d_ws, size_t ws_size, hipStream_t stream) {
    static int grid = 0;
    if (grid == 0) {
        if (n_in != 17 || in_sizes[0] != M * D || out_size != M * D || ws_size < WS_END) {
            fprintf(stderr, "kernel_launch: unexpected shapes / workspace (n_in %d, in0 %d, out %d, ws %zu, need %zu); nothing launched\n", n_in, n_in > 0 ? in_sizes[0] : -1, out_size, ws_size, (size_t)WS_END); grid = -1; return; }
        int dev = 0, cus = 0, per_cu = 0;
        if (hipGetDevice(&dev) != hipSuccess || hipDeviceGetAttribute(&cus, hipDeviceAttributeMultiprocessorCount, dev) != hipSuccess) { grid = -1; return; }
        if (hipFuncSetAttribute((const void*)trunk_fwd, hipFuncAttributeMaxDynamicSharedMemorySize, LDS_BYTES) != hipSuccess) { fprintf(stderr, "kernel_launch: hipFuncSetAttribute failed\n"); grid = -1; return; }
        if (hipOccupancyMaxActiveBlocksPerMultiprocessor(&per_cu, (const void*)trunk_fwd, NWAVES * 64, LDS_BYTES) != hipSuccess || per_cu < 1) { fprintf(stderr, "kernel_launch: occupancy query reports %d blocks per CU\n", per_cu); }
        (void)hipGetLastError();
        grid = cus;
        if (grid != 256) { fprintf(stderr, "kernel_launch: built for 256 CUs, device has %d; nothing launched\n", cus); grid = -1; return; }
    }
    if (grid < 0) return;
    if (hipMemsetAsync((char*)d_ws + WS_CTL, 0, CTL_ZERO_BYTES, stream) != hipSuccess) return;
    Args a{};
    for (int i = 0; i < 17; ++i) a.in[i] = d_in[i];
    a.out = (float*)d_out; a.ws = (unsigned char*)d_ws;
    hipLaunchKernelGGL(trunk_fwd, dim3(grid), dim3(NWAVES * 64), LDS_BYTES, stream, a);
}
```
